# Optimizing an MI355X kernel written in HIP

```python
import math
import jax, jax.numpy as jnp
from jax import lax
import numpy as np

D_MODEL = 2048
BATCH = 16
SEQ = 256
DEPTH = 4
DEC_BATCH = 8
DEC_SEQ = 2048
PAST_LEN = 512

GRID_W = 64
HEAD_DIM = 128
ATTN_Q_HEADS = 8
ATTN_KV_HEADS = 2
DIFF_HEADS = 4
DIFF_QK_DIM = 64
DIFF_V_DIM = 128
FOURIER_GROUPS = 4
FOURIER_GROUP_DIM = 128
MIX_WIDTH = ATTN_Q_HEADS * HEAD_DIM + DIFF_HEADS * DIFF_V_DIM + FOURIER_GROUPS * FOURIER_GROUP_DIM
D_FF = 4 * D_MODEL
ROPE_THETA = 10000.0
Q_BLOCK = 128
EPS = 1e-6
N_MOD = 6

W_QA = ATTN_Q_HEADS * HEAD_DIM
W_KA = ATTN_KV_HEADS * HEAD_DIM
W_VA = ATTN_KV_HEADS * HEAD_DIM
W_QB = DIFF_HEADS * 2 * DIFF_QK_DIM
W_KB = DIFF_HEADS * 2 * DIFF_QK_DIM
W_VB = DIFF_HEADS * DIFF_V_DIM
W_F = FOURIER_GROUPS * FOURIER_GROUP_DIM
IN_WIDTH = W_QA + W_KA + W_VA + W_QB + W_KB + W_VB + W_F

kernel_name = "hybrid_diffusion_prefix_trunk_step"


def rms_norm(x, g):
    xf = x.astype(jnp.float32)
    y = xf * lax.rsqrt(jnp.mean(jnp.square(xf), axis=-1, keepdims=True) + EPS)
    return (y * g.astype(jnp.float32)).astype(x.dtype)


def adaln(cond, w_ada_l, b_ada_l):
    m = jax.nn.silu(cond) @ w_ada_l + b_ada_l
    return jnp.split(m[:, None, :], N_MOD, axis=-1)


def axial_rope_tables(n_tokens, rot_dim):
    rows = n_tokens // GRID_W
    row = jnp.repeat(jnp.arange(rows), GRID_W).astype(jnp.float32)
    col = jnp.tile(jnp.arange(GRID_W), rows).astype(jnp.float32)
    nf = rot_dim // 4
    inv = ROPE_THETA ** (-jnp.arange(nf, dtype=jnp.float32) / nf)
    ang = jnp.concatenate([row[:, None] * inv, col[:, None] * inv], axis=-1)
    return jnp.cos(ang), jnp.sin(ang)


def apply_axial_rope(x, cos, sin):
    half = x.shape[-1] // 2
    nf = half // 2
    shape = (1, cos.shape[0]) + (1,) * (x.ndim - 3) + (half,)
    cos = cos.reshape(shape)
    sin = sin.reshape(shape)
    xf = x.astype(jnp.float32)

    def rot(xh, c, s):
        x1, x2 = xh[..., :nf], xh[..., nf:]
        return jnp.concatenate([x1 * c - x2 * s, x2 * c + x1 * s], axis=-1)

    out_r = rot(xf[..., :half], cos[..., :nf], sin[..., :nf])
    out_c = rot(xf[..., half:], cos[..., nf:], sin[..., nf:])
    return jnp.concatenate([out_r, out_c], axis=-1).astype(x.dtype)


def sweep_query_blocks(fn, q):
    b, t = q.shape[:2]
    nb = t // Q_BLOCK
    qb = jnp.moveaxis(q.reshape((b, nb, Q_BLOCK) + q.shape[2:]), 1, 0)
    ob = jnp.moveaxis(lax.map(fn, qb), 0, 1)
    return ob.reshape((b, t) + ob.shape[3:])


def gqa_attention(q, k, v):
    b, t, hq, d = q.shape
    hkv = k.shape[2]
    g = hq // hkv
    scale = d ** -0.5
    qg = q.reshape(b, t, hkv, g, d)

    def blk(qb):
        s = jnp.einsum('bqhgd,bkhd->bhgqk', qb, k).astype(jnp.float32) * scale
        p = jax.nn.softmax(s, axis=-1)
        return jnp.einsum('bhgqk,bkhd->bqhgd', p.astype(v.dtype), v)

    return sweep_query_blocks(blk, qg).reshape(b, t, hq * d)


def diff_attention(q, k, v, lam):
    scale = q.shape[-1] ** -0.5

    def blk(qb):
        s = jnp.einsum('bqhcd,bkhcd->bhcqk', qb, k).astype(jnp.float32) * scale
        p = jax.nn.softmax(s, axis=-1)
        pd = p[:, :, 0] - lam * p[:, :, 1]
        return jnp.einsum('bhqk,bkhd->bqhd', pd.astype(v.dtype), v)

    return sweep_query_blocks(blk, q)


def fourier_mix(f, w_fourier_l):
    b, t, _ = f.shape
    fg = f.reshape(b, t, FOURIER_GROUPS, FOURIER_GROUP_DIM).astype(jnp.float32)
    spec = jnp.fft.fft2(fg, axes=(1, 3), norm="ortho").real.astype(f.dtype)
    out = jnp.einsum('btgc,gcd->btgd', spec, w_fourier_l)
    return out.reshape(b, t, W_F)


def project(h, w_in_l, qn_a, kn_a, qn_b, kn_b):
    b, t, _ = h.shape
    z = h @ w_in_l
    i0 = W_QA
    i1 = i0 + W_KA
    i2 = i1 + W_VA
    i3 = i2 + W_QB
    i4 = i3 + W_KB
    i5 = i4 + W_VB
    qa = z[..., :i0].reshape(b, t, ATTN_Q_HEADS, HEAD_DIM)
    ka = z[..., i0:i1].reshape(b, t, ATTN_KV_HEADS, HEAD_DIM)
    va = z[..., i1:i2].reshape(b, t, ATTN_KV_HEADS, HEAD_DIM)
    qb = z[..., i2:i3].reshape(b, t, DIFF_HEADS, 2, DIFF_QK_DIM)
    kb = z[..., i3:i4].reshape(b, t, DIFF_HEADS, 2, DIFF_QK_DIM)
    vb = z[..., i4:i5].reshape(b, t, DIFF_HEADS, DIFF_V_DIM)
    f = z[..., i5:]
    return (rms_norm(qa, qn_a), rms_norm(ka, kn_a), va,
            rms_norm(qb, qn_b), rms_norm(kb, kn_b), vb, f)


def trunk_layer(x, cond, lambda_init, ctx, rope, lw):
    (w_ada_l, b_ada_l, norm_mix_g_l, norm_mlp_g_l, w_in_l, q_norm_a_l, k_norm_a_l,
     q_norm_b_l, k_norm_b_l, lambda_q1_l, lambda_k1_l, lambda_q2_l, lambda_k2_l,
     subln_g_l, w_fourier_l, w_out_l, w_mlp_in_l, w_mlp_out_l) = lw
    shift1, scale1, gate1, shift2, scale2, gate2 = adaln(cond, w_ada_l, b_ada_l)

    h = rms_norm(x, norm_mix_g_l) * (1.0 + scale1) + shift1
    qa, ka, va, qb, kb, vb, f = project(h, w_in_l, q_norm_a_l, k_norm_a_l, q_norm_b_l, k_norm_b_l)
    ctx_out = (ka, va, kb, vb)

    if ctx is None:
        keys_a, vals_a, keys_b, vals_b = ka, va, kb, vb
    else:
        (cos_a, sin_a), (cos_b, sin_b) = rope
        qa = apply_axial_rope(qa, cos_a, sin_a)
        qb = apply_axial_rope(qb, cos_b, sin_b)
        keys_a = jnp.concatenate([apply_axial_rope(ka, cos_a, sin_a), ctx[0].astype(ka.dtype)], axis=1)
        vals_a = jnp.concatenate([va, ctx[1].astype(va.dtype)], axis=1)
        keys_b = jnp.concatenate([apply_axial_rope(kb, cos_b, sin_b), ctx[2].astype(kb.dtype)], axis=1)
        vals_b = jnp.concatenate([vb, ctx[3].astype(vb.dtype)], axis=1)

    out_a = gqa_attention(qa, keys_a, vals_a)

    lam = (jnp.exp(jnp.sum(lambda_q1_l.astype(jnp.float32) * lambda_k1_l.astype(jnp.float32)))
           - jnp.exp(jnp.sum(lambda_q2_l.astype(jnp.float32) * lambda_k2_l.astype(jnp.float32)))
           + lambda_init)
    ob = diff_attention(qb, keys_b, vals_b, lam)
    ob = rms_norm(ob, subln_g_l) * (1.0 - lambda_init)
    out_b = ob.reshape(ob.shape[0], ob.shape[1], W_VB)

    out_c = fourier_mix(f, w_fourier_l)

    mix = jnp.concatenate([out_a, out_b, out_c], axis=-1) @ w_out_l
    x = x + gate1 * mix

    h2 = rms_norm(x, norm_mlp_g_l) * (1.0 + scale2) + shift2
    mlp = jnp.square(jax.nn.relu(h2 @ w_mlp_in_l)) @ w_mlp_out_l
    x = x + gate2 * mlp
    return x, ctx_out


def setup_inputs(seed: int = 0) -> dict:
    key = jax.random.key(seed)
    ks = jax.random.split(key, 32)
    f32 = jnp.float32
    nrm = lambda k, shape, s: jax.random.normal(k, shape, f32) * s
    gain = lambda k, shape: 1.0 + 0.02 * jax.random.normal(k, shape, f32)
    return {
        "x_prompt": nrm(ks[0], (BATCH, SEQ, D_MODEL), 1.0),
        "x_sample": nrm(ks[1], (DEC_BATCH, DEC_SEQ, D_MODEL), 1.0),
        "cache_attn_k": nrm(ks[2], (DEC_BATCH, DEPTH, PAST_LEN, ATTN_KV_HEADS, HEAD_DIM), 1.0),
        "cache_attn_v": nrm(ks[3], (DEC_BATCH, DEPTH, PAST_LEN, ATTN_KV_HEADS, HEAD_DIM), 1.0),
        "cache_diff_k": nrm(ks[4], (DEC_BATCH, DEPTH, PAST_LEN, DIFF_HEADS, 2, DIFF_QK_DIM), 1.0),
        "cache_diff_v": nrm(ks[5], (DEC_BATCH, DEPTH, PAST_LEN, DIFF_HEADS, DIFF_V_DIM), 1.0),
        "c": nrm(ks[6], (DEC_BATCH, D_MODEL), 1.0),
        "c_ctx": nrm(ks[7], (D_MODEL,), 1.0),
        "w_ada": nrm(ks[8], (DEPTH, D_MODEL, N_MOD * D_MODEL), D_MODEL ** -0.5),
        "b_ada": nrm(ks[9], (DEPTH, N_MOD * D_MODEL), 0.01),
        "norm_mix_g": gain(ks[10], (DEPTH, D_MODEL)),
        "norm_mlp_g": gain(ks[11], (DEPTH, D_MODEL)),
        "w_in": nrm(ks[12], (DEPTH, D_MODEL, IN_WIDTH), D_MODEL ** -0.5),
        "q_norm_a": gain(ks[13], (DEPTH, HEAD_DIM)),
        "k_norm_a": gain(ks[14], (DEPTH, HEAD_DIM)),
        "q_norm_b": gain(ks[15], (DEPTH, DIFF_QK_DIM)),
        "k_norm_b": gain(ks[16], (DEPTH, DIFF_QK_DIM)),
        "lambda_q1": nrm(ks[17], (DEPTH, DIFF_QK_DIM), 0.1),
        "lambda_k1": nrm(ks[18], (DEPTH, DIFF_QK_DIM), 0.1),
        "lambda_q2": nrm(ks[19], (DEPTH, DIFF_QK_DIM), 0.1),
        "lambda_k2": nrm(ks[20], (DEPTH, DIFF_QK_DIM), 0.1),
        "subln_g": gain(ks[21], (DEPTH, DIFF_V_DIM)),
        "w_fourier": nrm(ks[22], (DEPTH, FOURIER_GROUPS, FOURIER_GROUP_DIM, FOURIER_GROUP_DIM), FOURIER_GROUP_DIM ** -0.5),
        "w_out": nrm(ks[23], (DEPTH, MIX_WIDTH, D_MODEL), MIX_WIDTH ** -0.5),
        "w_mlp_in": nrm(ks[24], (DEPTH, D_MODEL, D_FF), D_MODEL ** -0.5),
        "w_mlp_out": nrm(ks[25], (DEPTH, D_FF, D_MODEL), D_FF ** -0.5),
    }


def reference(x_prompt, x_sample, cache_attn_k, cache_attn_v, cache_diff_k, cache_diff_v, c,
              c_ctx, w_ada, b_ada, norm_mix_g, norm_mlp_g, w_in, q_norm_a, k_norm_a, q_norm_b,
              k_norm_b, lambda_q1, lambda_k1, lambda_q2, lambda_k2, subln_g, w_fourier, w_out,
              w_mlp_in, w_mlp_out):
    n_lat = x_sample.shape[1]
    rope = (axial_rope_tables(n_lat, HEAD_DIM), axial_rope_tables(n_lat, DIFF_QK_DIM))
    cond_ctx = c_ctx[None, :]

    xp = x_prompt
    xs = x_sample
    ka_list, va_list, kb_list, vb_list = [], [], [], []
    for l in range(DEPTH):
        lw = (w_ada[l], b_ada[l], norm_mix_g[l], norm_mlp_g[l], w_in[l], q_norm_a[l], k_norm_a[l],
              q_norm_b[l], k_norm_b[l], lambda_q1[l], lambda_k1[l], lambda_q2[l], lambda_k2[l],
              subln_g[l], w_fourier[l], w_out[l], w_mlp_in[l], w_mlp_out[l])
        lambda_init = 0.8 - 0.6 * math.exp(-0.3 * l)
        xp, (ka, va, kb, vb) = trunk_layer(xp, cond_ctx, lambda_init, None, None, lw)
        ka_list.append(ka)
        va_list.append(va)
        kb_list.append(kb)
        vb_list.append(vb)
        ctx = (cache_attn_k[:, l], cache_attn_v[:, l], cache_diff_k[:, l], cache_diff_v[:, l])
        xs, _ = trunk_layer(xs, c, lambda_init, ctx, rope, lw)

    state_attn_k = jnp.stack(ka_list, axis=1)
    state_attn_v = jnp.stack(va_list, axis=1)
    state_diff_k = jnp.stack(kb_list, axis=1)
    state_diff_v = jnp.stack(vb_list, axis=1)
    return (xp, xs, state_attn_k, state_attn_v, state_diff_k, state_diff_v)
```

```cpp
#include <hip/hip_runtime.h>
#include <stdint.h>
#include <stdio.h>

typedef unsigned short bf16_t;
typedef short bf16x8 __attribute__((ext_vector_type(8)));
typedef float f32x4 __attribute__((ext_vector_type(4)));
typedef float f32x2 __attribute__((ext_vector_type(2)));
typedef unsigned u32x4 __attribute__((ext_vector_type(4)));
typedef unsigned u32x2 __attribute__((ext_vector_type(2)));

constexpr int D = 2048, NB_CTX = 16, T_CTX = 256, NB_LAT = 8, T_LAT = 2048, DEPTH = 4, PAST = 512;
constexpr int M_CTX = NB_CTX * T_CTX;
constexpr int M_LAT = NB_LAT * T_LAT;
constexpr int M_ALL = M_CTX + M_LAT;
constexpr int S_LAT = T_LAT + PAST;
constexpr int N_IN = 4096;
constexpr int N_INRAW = 3584;
constexpr int DFF = 8192;
constexpr int NMOD = 6 * D;
constexpr int NCOND = 9;
constexpr float EPS = 1e-6f;
constexpr size_t OUT_X = 0;
constexpr size_t OUT_SAK = (size_t)M_ALL * D;
constexpr size_t OUT_SAV = OUT_SAK + (size_t)NB_CTX * DEPTH * T_CTX * 256;
constexpr size_t OUT_SDK = OUT_SAV + (size_t)NB_CTX * DEPTH * T_CTX * 256;
constexpr size_t OUT_SDV = OUT_SDK + (size_t)NB_CTX * DEPTH * T_CTX * 512;
constexpr size_t OUT_END = OUT_SDV + (size_t)NB_CTX * DEPTH * T_CTX * 512;

constexpr size_t MiB = (size_t)1 << 20;
constexpr size_t WS_CTL = 0;
constexpr size_t WS_BT_IN = 1 * MiB;
constexpr size_t WS_BT_OUT = 65 * MiB;
constexpr size_t WS_BT_MI = 97 * MiB;
constexpr size_t WS_BT_MO = 225 * MiB;
constexpr size_t WS_DFT_L = 353 * MiB;
constexpr size_t WS_DFT_C = 369 * MiB;
constexpr size_t WS_MOD = 370 * MiB;
constexpr size_t WS_ROPE = 372 * MiB;
constexpr size_t WS_G = 374 * MiB;
constexpr size_t WS_LAM = 376 * MiB;
constexpr size_t WS_GAIN = WS_LAM + 4096;
constexpr size_t WS_H = 377 * MiB;
constexpr size_t WS_QA = 457 * MiB;
constexpr size_t WS_KAL = 497 * MiB;
constexpr size_t WS_VAL = 537 * MiB;
constexpr size_t WS_KAC = 577 * MiB;
constexpr size_t WS_VAC = 579 * MiB;
constexpr size_t WS_QB = 581 * MiB;
constexpr size_t WS_KBL = 601 * MiB;
constexpr size_t WS_VBL = 681 * MiB;
constexpr size_t WS_KBC = 761 * MiB;
constexpr size_t WS_VBC = 765 * MiB;
constexpr size_t WS_YTL = 769 * MiB;
constexpr size_t WS_YTC = 801 * MiB;
constexpr size_t WS_MIX = 809 * MiB;
constexpr size_t WS_HID = 889 * MiB;
constexpr size_t WS_OTMP = 1209 * MiB;
constexpr size_t WS_SS = 1273 * MiB;
constexpr size_t WS_BIAS_IN = 1279 * MiB;
constexpr size_t WS_BIAS_MI = 1280 * MiB;
constexpr size_t WS_END = 1282 * MiB;

__host__ __device__ __forceinline__ int map8(int p) { return (p & 96) | (((p >> 2) & 3) << 3) | (((p >> 4) & 1) << 2) | (p & 3); }
__host__ __device__ __forceinline__ int map8inv(int s) { return (s & 96) | (((s >> 2) & 1) << 4) | (((s >> 3) & 3) << 2) | (s & 3); }
__host__ __device__ __forceinline__ int sigma128(int s) { const int u = s >> 3, n = (s >> 2) & 1, e = s & 3; return (u < 8 ? 0 : 64) + 32 * n + 4 * (u & 7) + e; }
__host__ __device__ __forceinline__ int sigma64(int s) { const int u = s >> 3, n = (s >> 2) & 1, e = s & 3; return (u < 4 ? 0 : 32) + 16 * n + 4 * (u & 3) + e; }
__host__ __device__ __forceinline__ int in_logical_col(int t, int sc) {
    const int half = sc & 128, s = sc & 127;
    int l;
    if (t <= 4) l = sigma128(s);
    else if (t == 5 || t >= 10) l = s;
    else l = (s & 64) + sigma64(s & 63);
    return t * 256 + half + l;
}
__device__ __forceinline__ unsigned f2bf(float f) { unsigned u = __builtin_bit_cast(unsigned, f); return (u + 0x7fffu + ((u >> 16) & 1u)) >> 16; }
__device__ __forceinline__ float bf2f(unsigned short h) { return __builtin_bit_cast(float, (unsigned)h << 16); }
__device__ __forceinline__ unsigned pk2(float lo, float hi) { return f2bf(lo) | (f2bf(hi) << 16); }
__device__ __forceinline__ int cond_of_row(int row) { return row < M_CTX ? 0 : 1 + ((row - M_CTX) >> 11); }
__host__ __device__ __forceinline__ float lambda_init_of(int l) { return 0.8f - 0.6f * expf(-0.3f * (float)l); }

__device__ __forceinline__ void prep_transpose_vb(const float* __restrict__ W, int K, int ldw, size_t w_layer_stride, bf16_t* __restrict__ Bt, size_t bt_layer_stride, int mode, int vbx, int vby, int vbz, int t, float (*tile)[129], bool act) {
    const int k0 = vbx * 32, grp = vby, l = vbz;
    const float* Wl = W + (size_t)l * w_layer_stride; bf16_t* Bl = Bt + (size_t)l * bt_layer_stride;
    const int c0 = grp * 128;
    if (act) {   const int kk = t >> 3;
#pragma unroll
        for (int i = 0; i < 4; ++i) { const int c = ((t & 7) + 8 * i) * 4; const f32x4 v = *(const f32x4*)(Wl + (size_t)(k0 + kk) * ldw + c0 + c);
            tile[kk][c] = v[0]; tile[kk][c + 1] = v[1]; tile[kk][c + 2] = v[2]; tile[kk][c + 3] = v[3]; } }
    __syncthreads();
    if (act) {
    const int p = t >> 1, kh = (t & 1) * 16;
    int lc;
    if (mode == 0) lc = map8(p);
    else { const int tl = grp >> 1, half = (grp & 1) * 128; lc = in_logical_col(tl, half + map8(p)) - tl * 256 - half; }
    unsigned w[8];
#pragma unroll
    for (int j = 0; j < 8; ++j) w[j] = pk2(tile[kh + 2 * j][lc], tile[kh + 2 * j + 1][lc]);
    bf16_t* dst = Bl + (size_t)(c0 + p) * K + k0 + kh;
    *(u32x4*)dst = (u32x4){w[0], w[1], w[2], w[3]}; *(u32x4*)(dst + 8) = (u32x4){w[4], w[5], w[6], w[7]};
    }
    __syncthreads();
}
__global__ __launch_bounds__(256) void k_prep_transpose(const float* __restrict__ W, int K, int ldw, size_t w_layer_stride, bf16_t* __restrict__ Bt, size_t bt_layer_stride, int mode) {
    __shared__ float tile[32][129];
    prep_transpose_vb(W, K, ldw, w_layer_stride, Bt, bt_layer_stride, mode, blockIdx.x, blockIdx.y, blockIdx.z, threadIdx.x, tile, true);
}

__device__ __forceinline__ void prep_G_idx(const float* __restrict__ wf, float* __restrict__ G, size_t idx, const float* ct, const float* st) {
    const int d = idx & 127, c = (idx >> 7) & 127, cs = (idx >> 14) & 1, g = (idx >> 15) & 3, l = (int)(idx >> 17);
    const float* Wg = wf + ((size_t)(l * 4 + g) * 128) * 128;
    float acc = 0.f;
    for (int m = 0; m < 128; ++m) { const float tr = cs ? st[(m * c) & 127] : ct[(m * c) & 127]; acc += tr * Wg[(size_t)m * 128 + d]; }
    G[idx] = acc * 0.088388347648318440f;
}
__global__ __launch_bounds__(256) void k_prep_G(const float* __restrict__ wf, float* __restrict__ G) {
    __shared__ float ct[128], st[128];
    if (threadIdx.x < 128) { float s, c; sincospif((float)threadIdx.x / 64.0f, &s, &c); ct[threadIdx.x] = c; st[threadIdx.x] = s; }
    __syncthreads();
    prep_G_idx(wf, G, (size_t)blockIdx.x * 256 + threadIdx.x, ct, st);
}
__device__ __forceinline__ void prep_fold_vb(const float* __restrict__ w_in, const float* __restrict__ G, bf16_t* __restrict__ Bt_in, int vbx, int vby, int vbz, int t, float (*wt)[132], bool act) {
    const int j0 = vbx * 64, g = vby, l = vbz;
    const float* Wl = w_in + (size_t)l * D * N_INRAW;
    if (act) for (int i = t; i < 64 * 32; i += 256) { const int j = i >> 5, c4 = (i & 31) * 4; const f32x4 v = *(const f32x4*)(Wl + (size_t)(j0 + j) * N_INRAW + 3072 + 128 * g + c4);
        wt[j][c4] = v[0]; wt[j][c4 + 1] = v[1]; wt[j][c4 + 2] = v[2]; wt[j][c4 + 3] = v[3]; }
    __syncthreads();
    if (act) {
    const int cs = t >> 7, d = t & 127;
    const float* Gp = G + ((size_t)((l * 4 + g) * 2 + cs) * 128) * 128 + d;
    const int nl = cs * 512 + g * 128 + d;
    const int sc = nl & 255, pos = (nl & ~255) + (sc & 128) + map8inv(sc & 127);
    bf16_t* dst = Bt_in + (size_t)l * N_IN * D + (size_t)(3072 + pos) * D + j0;
    for (int jb = 0; jb < 64; jb += 8) {
        float a0 = 0, a1 = 0, a2 = 0, a3 = 0, a4 = 0, a5 = 0, a6 = 0, a7 = 0;
        for (int c = 0; c < 128; ++c) { const float gv = Gp[(size_t)c * 128];
            a0 += wt[jb + 0][c] * gv; a1 += wt[jb + 1][c] * gv; a2 += wt[jb + 2][c] * gv; a3 += wt[jb + 3][c] * gv;
            a4 += wt[jb + 4][c] * gv; a5 += wt[jb + 5][c] * gv; a6 += wt[jb + 6][c] * gv; a7 += wt[jb + 7][c] * gv; }
        *(u32x4*)(dst + jb) = (u32x4){pk2(a0, a1), pk2(a2, a3), pk2(a4, a5), pk2(a6, a7)};
    }
    }
    __syncthreads();
}
__global__ __launch_bounds__(256) void k_prep_fold(const float* __restrict__ w_in, const float* __restrict__ G, bf16_t* __restrict__ Bt_in) {
    __shared__ float wt[64][132];
    prep_fold_vb(w_in, G, Bt_in, blockIdx.x, blockIdx.y, blockIdx.z, threadIdx.x, wt, true);
}
__device__ __forceinline__ void prep_ada_vb(const float* __restrict__ c, const float* __restrict__ c_ctx, const float* __restrict__ w_ada, const float* __restrict__ b_ada, float* __restrict__ mod, int vbx, int vby, int t, float (*sv)[128], bool act) {
    const int j = vbx * 256 + t, l = vby;
    const float* W = w_ada + (size_t)l * D * NMOD + j;
    float acc[NCOND];
#pragma unroll
    for (int q = 0; q < NCOND; ++q) acc[q] = 0.f;
    for (int k0 = 0; k0 < D; k0 += 128) {
        __syncthreads();
        if (act) for (int i = t; i < NCOND * 128; i += 256) { const int q = i >> 7, kk = i & 127; const float v = (q == 0) ? c_ctx[k0 + kk] : c[(size_t)(q - 1) * D + k0 + kk]; sv[q][kk] = v / (1.f + expf(-v)); }
        __syncthreads();
        if (act) for (int kk = 0; kk < 128; ++kk) { const float w = W[(size_t)(k0 + kk) * NMOD];
#pragma unroll
            for (int q = 0; q < NCOND; ++q) acc[q] += sv[q][kk] * w; }
    }
    if (act) { const float bb = b_ada[(size_t)l * NMOD + j];
#pragma unroll
        for (int q = 0; q < NCOND; ++q) mod[((size_t)l * NCOND + q) * NMOD + j] = acc[q] + bb; }
    __syncthreads();
}
__global__ __launch_bounds__(256) void k_prep_ada(const float* __restrict__ c, const float* __restrict__ c_ctx, const float* __restrict__ w_ada, const float* __restrict__ b_ada, float* __restrict__ mod) {
    __shared__ float sv[NCOND][128];
    prep_ada_vb(c, c_ctx, w_ada, b_ada, mod, blockIdx.x, blockIdx.y, threadIdx.x, sv, true);
}
__device__ __forceinline__ void prep_tables_gs(float* __restrict__ rope, bf16_t* __restrict__ dftl, bf16_t* __restrict__ dftc, float* __restrict__ lam,
                                                     const float* lq1, const float* lk1, const float* lq2, const float* lk2,
                                                     float* __restrict__ gain, const float* qna, const float* kna, const float* qnb, const float* knb, size_t gid, size_t nth) {
    float* cosA = rope; float* sinA = rope + 2048 * 64; float* cosB = rope + 2 * 2048 * 64; float* sinB = cosB + 2048 * 32;
    for (size_t i = gid; i < (size_t)2048 * 64; i += nth) { const int tk = (int)(i >> 6), f = (int)(i & 63); const int fi = f & 31; const float pos = (f < 32) ? (float)(tk >> 6) : (float)(tk & 63);
        const float inv = powf(10000.0f, -(float)fi / 32.0f); const float ang = pos * inv; cosA[i] = cosf(ang); sinA[i] = sinf(ang); }
    for (size_t i = gid; i < (size_t)2048 * 32; i += nth) { const int tk = (int)(i >> 5), f = (int)(i & 31); const int fi = f & 15; const float pos = (f < 16) ? (float)(tk >> 6) : (float)(tk & 63);
        const float inv = powf(10000.0f, -(float)fi / 16.0f); const float ang = pos * inv; cosB[i] = cosf(ang); sinB[i] = sinf(ang); }
    for (size_t i = gid; i < (size_t)2048 * 4096; i += nth) { const int k = (int)(i >> 12), s = (int)(i & 4095); const int tt = s & 2047; const int ph = (k * tt) & 2047;
        float sn, cs; sincospif((float)ph / 1024.0f, &sn, &cs); const float v = (s < 2048 ? cs : -sn) * 0.022097086912079608f; dftl[i] = (bf16_t)f2bf(v); }
    for (size_t i = gid; i < (size_t)256 * 512; i += nth) { const int k = (int)(i >> 9), s = (int)(i & 511); const int tt = s & 255; const int ph = (k * tt) & 255;
        float sn, cs; sincospif((float)ph / 128.0f, &sn, &cs); const float v = (s < 256 ? cs : -sn) * 0.0625f; dftc[i] = (bf16_t)f2bf(v); }
    if (gid < DEPTH * 384) { const int l = (int)gid / 384, i = (int)gid % 384; gain[gid] = i < 128 ? qna[l * 128 + i] : i < 256 ? kna[l * 128 + i - 128] : i < 320 ? qnb[l * 64 + i - 256] : knb[l * 64 + i - 320]; }
    if (gid < DEPTH) { const int l = (int)gid; float s1 = 0.f, s2 = 0.f; for (int i = 0; i < 64; ++i) { s1 += lq1[l * 64 + i] * lk1[l * 64 + i]; s2 += lq2[l * 64 + i] * lk2[l * 64 + i]; }
        lam[l] = expf(s1) - expf(s2) + lambda_init_of(l); }
}
__global__ __launch_bounds__(256) void k_prep_tables(float* __restrict__ rope, bf16_t* __restrict__ dftl, bf16_t* __restrict__ dftc, float* __restrict__ lam,
                                                     const float* lq1, const float* lk1, const float* lq2, const float* lk2,
                                                     float* __restrict__ gain, const float* qna, const float* kna, const float* qnb, const float* knb) {
    prep_tables_gs(rope, dftl, dftc, lam, lq1, lk1, lq2, lk2, gain, qna, kna, qnb, knb, (size_t)blockIdx.x * 256 + threadIdx.x, (size_t)gridDim.x * 256);
}
__device__ __forceinline__ void prep_cache_gs(const float* __restrict__ cak, const float* __restrict__ cav, const float* __restrict__ cdk, const float* __restrict__ cdv,
                                                    bf16_t* __restrict__ KAL, bf16_t* __restrict__ VAL, bf16_t* __restrict__ KBL, bf16_t* __restrict__ VBL, size_t gid, size_t nth) {
    const size_t nrow = (size_t)NB_LAT * DEPTH * PAST;
    for (size_t i = gid; i < nrow * 32; i += nth) { const int it = (int)(i & 31); const size_t r = i >> 5; const int p = (int)(r & 511), l = (int)((r >> 9) & 3), b = (int)(r >> 11);
        const int head = it >> 4, s0 = (it & 15) * 8;
        const float* srck = cak + r * 256 + head * 128; const float* srcv = cav + r * 256 + head * 128;
        const int la = sigma128(s0), lb = sigma128(s0 + 4);
        const f32x4 ka = *(const f32x4*)(srck + la), kb = *(const f32x4*)(srck + lb), va = *(const f32x4*)(srcv + s0), vb = *(const f32x4*)(srcv + s0 + 4);
        const size_t orow = ((size_t)(l * NB_LAT + b) * S_LAT + T_LAT + p) * 256 + head * 128 + s0;
        *(u32x4*)(KAL + orow) = (u32x4){pk2(ka[0], ka[1]), pk2(ka[2], ka[3]), pk2(kb[0], kb[1]), pk2(kb[2], kb[3])};
        *(u32x4*)(VAL + orow) = (u32x4){pk2(va[0], va[1]), pk2(va[2], va[3]), pk2(vb[0], vb[1]), pk2(vb[2], vb[3])}; }
    for (size_t i = gid; i < nrow * 64; i += nth) { const int it = (int)(i & 63); const size_t r = i >> 6; const int p = (int)(r & 511), l = (int)((r >> 9) & 3), b = (int)(r >> 11);
        const int grp = it >> 3, s0 = (it & 7) * 8;
        const float* srck = cdk + r * 512 + grp * 64; const float* srcv = cdv + r * 512 + it * 8;
        const int la = sigma64(s0), lb = sigma64(s0 + 4);
        const f32x4 ka = *(const f32x4*)(srck + la), kb = *(const f32x4*)(srck + lb), va = *(const f32x4*)(srcv), vb = *(const f32x4*)(srcv + 4);
        const size_t orow = ((size_t)(l * NB_LAT + b) * S_LAT + T_LAT + p) * 512 + it * 8;
        *(u32x4*)(KBL + orow) = (u32x4){pk2(ka[0], ka[1]), pk2(ka[2], ka[3]), pk2(kb[0], kb[1]), pk2(kb[2], kb[3])};
        *(u32x4*)(VBL + orow) = (u32x4){pk2(va[0], va[1]), pk2(va[2], va[3]), pk2(vb[0], vb[1]), pk2(vb[2], vb[3])}; }
}
__global__ __launch_bounds__(256) void k_prep_cache(const float* __restrict__ cak, const float* __restrict__ cav, const float* __restrict__ cdk, const float* __restrict__ cdv,
                                                    bf16_t* __restrict__ KAL, bf16_t* __restrict__ VAL, bf16_t* __restrict__ KBL, bf16_t* __restrict__ VBL) {
    prep_cache_gs(cak, cav, cdk, cdv, KAL, VAL, KBL, VBL, (size_t)blockIdx.x * 256 + threadIdx.x, (size_t)gridDim.x * 256);
}

__device__ __forceinline__ float wave_sum(float v) {
#pragma unroll
    for (int o = 1; o < 64; o <<= 1) v += __shfl_xor(v, o);
    return v;
}
__device__ __forceinline__ void norm_row(const float* __restrict__ xrow, float* __restrict__ xcopy, const float* __restrict__ g, const float* __restrict__ shift, const float* __restrict__ scale, bf16_t* __restrict__ hrow, int lane) {
    f32x4 v[8]; float ss = 0.f;
#pragma unroll
    for (int j = 0; j < 8; ++j) { v[j] = *(const f32x4*)(xrow + lane * 4 + 256 * j); ss += (v[j][0] * v[j][0] + v[j][1] * v[j][1]) + (v[j][2] * v[j][2] + v[j][3] * v[j][3]); }
    if (xcopy) {
#pragma unroll
        for (int j = 0; j < 8; ++j) *(f32x4*)(xcopy + lane * 4 + 256 * j) = v[j]; }
    const float rinv = rsqrtf(wave_sum(ss) * (1.0f / D) + EPS);
#pragma unroll
    for (int j = 0; j < 8; ++j) { const int c = lane * 4 + 256 * j; const f32x4 gg = *(const f32x4*)(g + c), sc = *(const f32x4*)(scale + c), sh = *(const f32x4*)(shift + c);
        const f32x4 o = (v[j] * rinv) * gg * (sc + 1.0f) + sh;
        *(u32x2*)(hrow + c) = (u32x2){pk2(o[0], o[1]), pk2(o[2], o[3])}; }
}
__global__ __launch_bounds__(256) void k_norm(const float* __restrict__ xp, const float* __restrict__ xs, float* __restrict__ xout, int first, const float* __restrict__ g, const float* __restrict__ mod_l, int shift_chunk, bf16_t* __restrict__ H) {
    const int row = blockIdx.x * 4 + (threadIdx.x >> 6), lane = threadIdx.x & 63;
    const float* xrow = first ? (row < M_CTX ? xp + (size_t)row * D : xs + (size_t)(row - M_CTX) * D) : xout + (size_t)row * D;
    const float* mc = mod_l + (size_t)cond_of_row(row) * NMOD;
    norm_row(xrow, first ? xout + (size_t)row * D : nullptr, g, mc + (size_t)shift_chunk * D, mc + (size_t)(shift_chunk + 1) * D, H + (size_t)row * D, lane);
}

struct ZOff { int d1, d2; long s1, s2; };
__device__ __forceinline__ long zoff(const ZOff& o, int z) { return (long)(z / o.d1) * o.s1 + (long)((z % o.d1) / o.d2) * o.s2; }
template <bool BT, int MODE, bool COLMAP>
__global__ __launch_bounds__(256) void k_gemm(const bf16_t* __restrict__ A, long lda, ZOff oa, const bf16_t* __restrict__ B, long ldb, ZOff ob, void* __restrict__ Cv, long ldc, ZOff oc, int K, const float* __restrict__ gate  ) {
    const int z = blockIdx.z, w = threadIdx.x >> 6, lane = threadIdx.x & 63, r16 = lane & 15, q = lane >> 4;
    const int m0 = blockIdx.y * 128 + (w >> 1) * 64, n0 = blockIdx.x * 128 + (w & 1) * 64;
    const bf16_t* Ap = A + zoff(oa, z) + (long)(m0 + r16) * lda + q * 8;
    const bf16_t* Bp = B + zoff(ob, z);
    f32x4 acc[4][4];
#pragma unroll
    for (int i = 0; i < 4; ++i)
#pragma unroll
        for (int j = 0; j < 4; ++j) acc[i][j] = (f32x4){0.f, 0.f, 0.f, 0.f};
    for (int k0 = 0; k0 < K; k0 += 32) {
        bf16x8 a[4], b[4];
#pragma unroll
        for (int i = 0; i < 4; ++i) a[i] = *(const bf16x8*)(Ap + (long)(16 * i) * lda + k0);
#pragma unroll
        for (int j = 0; j < 4; ++j) {
            if (BT) b[j] = *(const bf16x8*)(Bp + (long)(n0 + 16 * j + r16) * ldb + k0 + q * 8);
            else {
#pragma unroll
                for (int e = 0; e < 8; ++e) b[j][e] = (short)Bp[(long)(k0 + q * 8 + e) * ldb + n0 + 16 * j + r16]; }
        }
#pragma unroll
        for (int i = 0; i < 4; ++i)
#pragma unroll
            for (int j = 0; j < 4; ++j) acc[i][j] = __builtin_amdgcn_mfma_f32_16x16x32_bf16(a[i], b[j], acc[i][j], 0, 0, 0);
    }
    const long co = zoff(oc, z);
#pragma unroll
    for (int i = 0; i < 4; ++i)
#pragma unroll
        for (int j = 0; j < 4; ++j)
#pragma unroll
            for (int r = 0; r < 4; ++r) {
                const int m = m0 + 16 * i + 4 * q + r, n = n0 + 16 * j + r16; const int nc = COLMAP ? ((n & ~127) | map8(n & 127)) : n; const float v = acc[i][j][r];
                if (MODE == 0) ((float*)Cv)[co + (long)m * ldc + nc] = v;
                else if (MODE == 1) { const float rl = v > 0.f ? v : 0.f; ((bf16_t*)Cv)[co + (long)m * ldc + nc] = (bf16_t)f2bf(rl * rl); }
                else if (MODE == 2) { float* x = (float*)Cv + co + (long)m * ldc + nc; *x = *x + gate[(size_t)cond_of_row(m) * NMOD + nc] * v; }
                else ((bf16_t*)Cv)[co + (long)m * ldc + nc] = (bf16_t)f2bf(v);
            }
}

struct EpiInArgs {
    const float* Z; int l;
    bf16_t *QA, *KAL, *VAL, *KAC, *VAC, *QB, *KBL, *VBL, *KBC, *VBC, *YTL, *YTC;
    float* out;
    const float *gqa, *gka, *gqb, *gkb;
    const float* rope;
};
__global__ __launch_bounds__(256) void k_epi_in(EpiInArgs a) {
    const size_t gid = (size_t)blockIdx.x * 256 + threadIdx.x;
    const int unit = (int)(gid % 40), row = (int)(gid / 40);
    if (row >= M_ALL) return;
    const bool lat = row >= M_CTX; const int b = lat ? (row - M_CTX) >> 11 : row >> 8, tk = lat ? (row - M_CTX) & 2047 : row & 255;
    const float* zr = a.Z + (size_t)row * N_IN; const int l = a.l;
    const float* cosA = a.rope; const float* sinA = cosA + 2048 * 64; const float* cosB = cosA + 2 * 2048 * 64; const float* sinB = cosB + 2048 * 32;
    if (unit < 10) {
        const bool isq = unit < 8; const int head = isq ? unit : unit - 8; const int colbase = isq ? head * 128 : 1024 + head * 128;
        const float* g = isq ? a.gqa : a.gka;
        float ss = 0.f; for (int s = 0; s < 128; ++s) { const float v = zr[colbase + map8inv(s)]; ss += v * v; }
        const float rinv = rsqrtf(ss * (1.0f / 128.0f) + EPS);
        bf16_t* dst; float* st = nullptr;
        if (isq) dst = a.QA + (size_t)row * 1024 + head * 128;
        else if (lat) dst = a.KAL + ((size_t)(l * NB_LAT + b) * S_LAT + tk) * 256 + head * 128;
        else { dst = a.KAC + (size_t)row * 256 + head * 128; st = a.out + OUT_SAK + ((size_t)(b * DEPTH + l) * T_CTX + tk) * 256 + head * 128; }
        for (int u = 0; u < 16; ++u) for (int e = 0; e < 4; ++e) { const int s1 = 8 * u + e, s2 = s1 + 4; const int l1 = sigma128(s1), l2 = sigma128(s2);
            float x1 = zr[colbase + map8inv(s1)] * rinv * g[l1], x2 = zr[colbase + map8inv(s2)] * rinv * g[l2];
            if (st) { st[l1] = x1; st[l2] = x2; }
            if (lat) { const int fi = (u < 8 ? 0 : 32) + 4 * (u & 7) + e; const float c = cosA[tk * 64 + fi], sn = sinA[tk * 64 + fi]; const float y1 = x1 * c - x2 * sn, y2 = x2 * c + x1 * sn; x1 = y1; x2 = y2; }
            dst[s1] = (bf16_t)f2bf(x1); dst[s2] = (bf16_t)f2bf(x2); }
    } else if (unit < 12) {
        const int head = unit - 10; const int colbase = 1280 + head * 128;
        bf16_t* dst = lat ? a.VAL + ((size_t)(l * NB_LAT + b) * S_LAT + tk) * 256 + head * 128 : a.VAC + (size_t)row * 256 + head * 128;
        float* st = lat ? nullptr : a.out + OUT_SAV + ((size_t)(b * DEPTH + l) * T_CTX + tk) * 256 + head * 128;
        for (int s = 0; s < 128; ++s) { const float v = zr[colbase + map8inv(s)]; if (st) st[s] = v; dst[s] = (bf16_t)f2bf(v); }
    } else if (unit < 28) {
        const bool isq = unit < 20; const int hc = isq ? unit - 12 : unit - 20; const int colbase = (isq ? 1536 : 2048) + (hc >> 1) * 128;
        const int sb = (hc & 1) * 64; const float* g = isq ? a.gqb : a.gkb;
        float ss = 0.f; for (int s = 0; s < 64; ++s) { const float v = zr[colbase + map8inv(sb + s)]; ss += v * v; }
        const float rinv = rsqrtf(ss * (1.0f / 64.0f) + EPS);
        bf16_t* dst; float* st = nullptr;
        if (isq) dst = a.QB + (size_t)row * 512 + hc * 64;
        else if (lat) dst = a.KBL + ((size_t)(l * NB_LAT + b) * S_LAT + tk) * 512 + hc * 64;
        else { dst = a.KBC + (size_t)row * 512 + hc * 64; st = a.out + OUT_SDK + ((size_t)(b * DEPTH + l) * T_CTX + tk) * 512 + hc * 64; }
        for (int u = 0; u < 8; ++u) for (int e = 0; e < 4; ++e) { const int s1 = 8 * u + e, s2 = s1 + 4; const int l1 = sigma64(s1), l2 = sigma64(s2);
            float x1 = zr[colbase + map8inv(sb + s1)] * rinv * g[l1], x2 = zr[colbase + map8inv(sb + s2)] * rinv * g[l2];
            if (st) { st[l1] = x1; st[l2] = x2; }
            if (lat) { const int fi = (u < 4 ? 0 : 16) + 4 * (u & 3) + e; const float c = cosB[tk * 32 + fi], sn = sinB[tk * 32 + fi]; const float y1 = x1 * c - x2 * sn, y2 = x2 * c + x1 * sn; x1 = y1; x2 = y2; }
            dst[s1] = (bf16_t)f2bf(x1); dst[s2] = (bf16_t)f2bf(x2); }
    } else if (unit < 32) {
        const int head = unit - 28; const int colbase = 2560 + head * 128;
        bf16_t* dst = lat ? a.VBL + ((size_t)(l * NB_LAT + b) * S_LAT + tk) * 512 + head * 128 : a.VBC + (size_t)row * 512 + head * 128;
        float* st = lat ? nullptr : a.out + OUT_SDV + ((size_t)(b * DEPTH + l) * T_CTX + tk) * 512 + head * 128;
        for (int s = 0; s < 128; ++s) { const float v = zr[colbase + map8inv(s)]; if (st) st[s] = v; dst[s] = (bf16_t)f2bf(v); }
    } else {
        const int j = unit - 32; const int cs = j >> 2; const int colbase = 3072 + j * 128;
        for (int p = 0; p < 128; ++p) { const float v = zr[colbase + p]; const int yrow = ((j & 3) * 128) + p;
            if (lat) a.YTL[((size_t)b * 512 + yrow) * 4096 + cs * 2048 + tk] = (bf16_t)f2bf(v);
            else a.YTC[((size_t)b * 512 + yrow) * 512 + cs * 256 + tk] = (bf16_t)f2bf(v); }
    }
}
__global__ __launch_bounds__(256) void k_softmax(const float* __restrict__ S, bf16_t* __restrict__ P, int ncols, float scale, long nrows) {
    const long row = (long)blockIdx.x * 4 + (threadIdx.x >> 6); const int lane = threadIdx.x & 63; if (row >= nrows) return;
    const float* s = S + row * ncols; float mx = -3.0e38f;
    for (int c = lane; c < ncols; c += 64) mx = fmaxf(mx, s[c]);
#pragma unroll
    for (int o = 1; o < 64; o <<= 1) mx = fmaxf(mx, __shfl_xor(mx, o));
    float sum = 0.f; for (int c = lane; c < ncols; c += 64) sum += expf((s[c] - mx) * scale);
    sum = wave_sum(sum); const float inv = 1.0f / sum;
    for (int c = lane; c < ncols; c += 64) P[row * ncols + c] = (bf16_t)f2bf(expf((s[c] - mx) * scale) * inv);
}
__global__ __launch_bounds__(256) void k_softmax_diff(const float* __restrict__ S, bf16_t* __restrict__ P, int ncols, int nq, float scale, const float* __restrict__ lamp, long nrows) {
    const long row = (long)blockIdx.x * 4 + (threadIdx.x >> 6); const int lane = threadIdx.x & 63; if (row >= nrows) return;
    const long zz = row / nq, qq = row % nq; const float lam = *lamp;
    const float* s1 = S + ((2 * zz) * nq + qq) * ncols; const float* s2 = S + ((2 * zz + 1) * nq + qq) * ncols;
    float m1 = -3.0e38f, m2 = -3.0e38f;
    for (int c = lane; c < ncols; c += 64) { m1 = fmaxf(m1, s1[c]); m2 = fmaxf(m2, s2[c]); }
#pragma unroll
    for (int o = 1; o < 64; o <<= 1) { m1 = fmaxf(m1, __shfl_xor(m1, o)); m2 = fmaxf(m2, __shfl_xor(m2, o)); }
    float a1 = 0.f, a2 = 0.f; for (int c = lane; c < ncols; c += 64) { a1 += expf((s1[c] - m1) * scale); a2 += expf((s2[c] - m2) * scale); }
    a1 = 1.0f / wave_sum(a1); a2 = lam / wave_sum(a2);
    for (int c = lane; c < ncols; c += 64) P[row * ncols + c] = (bf16_t)f2bf(expf((s1[c] - m1) * scale) * a1 - expf((s2[c] - m2) * scale) * a2);
}
__global__ __launch_bounds__(256) void k_subln(const float* __restrict__ O, bf16_t* __restrict__ MIX, int nq, long row0, const float* __restrict__ g, float post, long nrows) {
    const long row = (long)blockIdx.x * 4 + (threadIdx.x >> 6); const int lane = threadIdx.x & 63; if (row >= nrows) return;
    const long z = row / nq, qq = row % nq; const int h = (int)(z & 3); const long zb = z >> 2;
    const float v0 = O[row * 128 + lane], v1 = O[row * 128 + 64 + lane];
    const float rinv = rsqrtf(wave_sum(v0 * v0 + v1 * v1) * (1.0f / 128.0f) + EPS) * post;
    bf16_t* dst = MIX + (size_t)(row0 + zb * nq + qq) * D + 1024 + h * 128;
    dst[lane] = (bf16_t)f2bf(v0 * rinv * g[lane]); dst[64 + lane] = (bf16_t)f2bf(v1 * rinv * g[64 + lane]);
}
struct Ptrs {
    const float *x_prompt, *x_sample, *cak, *cav, *cdk, *cdv, *c, *c_ctx, *w_ada, *b_ada, *g_mix, *g_mlp, *w_in, *qn_a, *kn_a, *qn_b, *kn_b, *lq1, *lk1, *lq2, *lk2, *subln, *w_fourier, *w_out, *w_mi, *w_mo;
    float* out; unsigned char* ws;
    bf16_t *BT_IN, *BT_OUT, *BT_MI, *BT_MO, *DFT_L, *DFT_C, *H, *QA, *KAL, *VAL, *KAC, *VAC, *QB, *KBL, *VBL, *KBC, *VBC, *YTL, *YTC, *MIX, *HID;
    float *MOD, *ROPE, *G, *LAM, *OTMP;
};
__host__ __device__ __forceinline__ Ptrs make_ptrs_hd(const float* const* in, float* out, unsigned char* w) {
    Ptrs p{};
    p.x_prompt = in[0]; p.x_sample = in[1]; p.cak = in[2]; p.cav = in[3]; p.cdk = in[4]; p.cdv = in[5]; p.c = in[6]; p.c_ctx = in[7]; p.w_ada = in[8]; p.b_ada = in[9];
    p.g_mix = in[10]; p.g_mlp = in[11]; p.w_in = in[12]; p.qn_a = in[13]; p.kn_a = in[14]; p.qn_b = in[15]; p.kn_b = in[16]; p.lq1 = in[17]; p.lk1 = in[18]; p.lq2 = in[19]; p.lk2 = in[20];
    p.subln = in[21]; p.w_fourier = in[22]; p.w_out = in[23]; p.w_mi = in[24]; p.w_mo = in[25];
    p.out = out; p.ws = w;
    p.BT_IN = (bf16_t*)(w + WS_BT_IN); p.BT_OUT = (bf16_t*)(w + WS_BT_OUT); p.BT_MI = (bf16_t*)(w + WS_BT_MI); p.BT_MO = (bf16_t*)(w + WS_BT_MO);
    p.DFT_L = (bf16_t*)(w + WS_DFT_L); p.DFT_C = (bf16_t*)(w + WS_DFT_C); p.MOD = (float*)(w + WS_MOD); p.ROPE = (float*)(w + WS_ROPE); p.G = (float*)(w + WS_G); p.LAM = (float*)(w + WS_LAM);
    p.H = (bf16_t*)(w + WS_H); p.QA = (bf16_t*)(w + WS_QA); p.KAL = (bf16_t*)(w + WS_KAL); p.VAL = (bf16_t*)(w + WS_VAL); p.KAC = (bf16_t*)(w + WS_KAC); p.VAC = (bf16_t*)(w + WS_VAC);
    p.QB = (bf16_t*)(w + WS_QB); p.KBL = (bf16_t*)(w + WS_KBL); p.VBL = (bf16_t*)(w + WS_VBL); p.KBC = (bf16_t*)(w + WS_KBC); p.VBC = (bf16_t*)(w + WS_VBC);
    p.YTL = (bf16_t*)(w + WS_YTL); p.YTC = (bf16_t*)(w + WS_YTC); p.MIX = (bf16_t*)(w + WS_MIX); p.HID = (bf16_t*)(w + WS_HID); p.OTMP = (float*)(w + WS_OTMP);
    return p;
}
static Ptrs make_ptrs(void* const* d_in, void* d_out, void* d_ws) { return make_ptrs_hd((const float* const*)d_in, (float*)d_out, (unsigned char*)d_ws); }
static void launch_prologue(const Ptrs& p, hipStream_t st) {
    hipLaunchKernelGGL(k_prep_transpose, dim3(D / 32, 3072 / 128, DEPTH), dim3(256), 0, st, p.w_in, D, N_INRAW, (size_t)D * N_INRAW, p.BT_IN, (size_t)N_IN * D, 1);
    hipLaunchKernelGGL(k_prep_transpose, dim3(D / 32, D / 128, DEPTH), dim3(256), 0, st, p.w_out, D, D, (size_t)D * D, p.BT_OUT, (size_t)D * D, 0);
    hipLaunchKernelGGL(k_prep_transpose, dim3(D / 32, DFF / 128, DEPTH), dim3(256), 0, st, p.w_mi, D, DFF, (size_t)D * DFF, p.BT_MI, (size_t)DFF * D, 0);
    hipLaunchKernelGGL(k_prep_transpose, dim3(DFF / 32, D / 128, DEPTH), dim3(256), 0, st, p.w_mo, DFF, D, (size_t)DFF * D, p.BT_MO, (size_t)D * DFF, 0);
    hipLaunchKernelGGL(k_prep_G, dim3(DEPTH * 4 * 2 * 128 * 128 / 256), dim3(256), 0, st, p.w_fourier, p.G);
    hipLaunchKernelGGL(k_prep_fold, dim3(D / 64, 4, DEPTH), dim3(256), 0, st, p.w_in, p.G, p.BT_IN);
    hipLaunchKernelGGL(k_prep_ada, dim3(NMOD / 256, DEPTH), dim3(256), 0, st, p.c, p.c_ctx, p.w_ada, p.b_ada, p.MOD);
    hipLaunchKernelGGL(k_prep_tables, dim3(2048), dim3(256), 0, st, p.ROPE, p.DFT_L, p.DFT_C, p.LAM, p.lq1, p.lk1, p.lq2, p.lk2, (float*)(p.ws + WS_GAIN), p.qn_a, p.kn_a, p.qn_b, p.kn_b);
    hipLaunchKernelGGL(k_prep_cache, dim3(2048), dim3(256), 0, st, p.cak, p.cav, p.cdk, p.cdv, p.KAL, p.VAL, p.KBL, p.VBL);
}
static const ZOff Z0{1 << 30, 1, 0, 0};
static void simple_layer(const Ptrs& p, int l, hipStream_t st, unsigned mask = 0x7f) {
    const float* mod_l = p.MOD + (size_t)l * NCOND * NMOD;
    float* ZF = (float*)p.HID;
    bf16_t* PB = p.H;
    const float HUGE_S = 0.f; (void)HUGE_S;
    if (mask & 1u) hipLaunchKernelGGL(k_norm, dim3(M_ALL / 4), dim3(256), 0, st, p.x_prompt, p.x_sample, p.out, l == 0 ? 1 : 0, p.g_mix + (size_t)l * D, mod_l, 0, p.H);
    if (mask & 2u) {
    hipLaunchKernelGGL((k_gemm<true, 0, false>), dim3(N_IN / 128, M_ALL / 128, 1), dim3(256), 0, st, p.H, (long)D, Z0, p.BT_IN + (size_t)l * N_IN * D, (long)D, Z0, (void*)ZF, (long)N_IN, Z0, D, (const float*)nullptr);
    EpiInArgs ea{}; ea.Z = ZF; ea.l = l; ea.QA = p.QA; ea.KAL = p.KAL; ea.VAL = p.VAL; ea.KAC = p.KAC; ea.VAC = p.VAC; ea.QB = p.QB; ea.KBL = p.KBL; ea.VBL = p.VBL; ea.KBC = p.KBC; ea.VBC = p.VBC;
    ea.YTL = p.YTL; ea.YTC = p.YTC; ea.out = p.out; ea.gqa = p.qn_a + l * 128; ea.gka = p.kn_a + l * 128; ea.gqb = p.qn_b + l * 64; ea.gkb = p.kn_b + l * 64; ea.rope = p.ROPE;
    hipLaunchKernelGGL(k_epi_in, dim3((M_ALL * 40 + 255) / 256), dim3(256), 0, st, ea);
    }
    if (mask & 4u) {
    const float scA = 0.088388347648318440f, scB = 0.125f; const float post = 1.0f - lambda_init_of(l);
    {   ZOff oa{8, 1, (long)T_CTX * 1024, 128}, ob{8, 4, (long)T_CTX * 256, 128}, oc{1 << 30, 1, 0, (long)T_CTX * T_CTX};
        hipLaunchKernelGGL((k_gemm<true, 0, false>), dim3(T_CTX / 128, T_CTX / 128, NB_CTX * 8), dim3(256), 0, st, p.QA, 1024L, oa, p.KAC, 256L, ob, (void*)ZF, (long)T_CTX, oc, 128, (const float*)nullptr);
        const long nr = (long)NB_CTX * 8 * T_CTX; hipLaunchKernelGGL(k_softmax, dim3((unsigned)(nr / 4)), dim3(256), 0, st, ZF, PB, T_CTX, scA, nr);
        ZOff pa{1 << 30, 1, 0, (long)T_CTX * T_CTX}, pb{8, 4, (long)T_CTX * 256, 128}, pc{8, 1, (long)T_CTX * D, 128};
        hipLaunchKernelGGL((k_gemm<false, 3, false>), dim3(1, T_CTX / 128, NB_CTX * 8), dim3(256), 0, st, PB, (long)T_CTX, pa, p.VAC, 256L, pb, (void*)p.MIX, (long)D, pc, T_CTX, (const float*)nullptr); }
    {   ZOff oa{8, 1, (long)T_CTX * 512, 64}, ob{8, 1, (long)T_CTX * 512, 64}, oc{1 << 30, 1, 0, (long)T_CTX * T_CTX};
        hipLaunchKernelGGL((k_gemm<true, 0, false>), dim3(T_CTX / 128, T_CTX / 128, NB_CTX * 8), dim3(256), 0, st, p.QB, 512L, oa, p.KBC, 512L, ob, (void*)ZF, (long)T_CTX, oc, 64, (const float*)nullptr);
        const long nr = (long)NB_CTX * 4 * T_CTX; hipLaunchKernelGGL(k_softmax_diff, dim3((unsigned)(nr / 4)), dim3(256), 0, st, ZF, PB, T_CTX, T_CTX, scB, p.LAM + l, nr);
        ZOff pa{1 << 30, 1, 0, (long)T_CTX * T_CTX}, pb{4, 1, (long)T_CTX * 512, 128}, pc{1 << 30, 1, 0, (long)T_CTX * 128};
        hipLaunchKernelGGL((k_gemm<false, 0, false>), dim3(1, T_CTX / 128, NB_CTX * 4), dim3(256), 0, st, PB, (long)T_CTX, pa, p.VBC, 512L, pb, (void*)p.OTMP, 128L, pc, T_CTX, (const float*)nullptr);
        hipLaunchKernelGGL(k_subln, dim3((unsigned)(nr / 4)), dim3(256), 0, st, p.OTMP, p.MIX, T_CTX, 0L, p.subln + l * 128, post, nr); }
    {   ZOff ob{1 << 30, 1, 0, 512L * 512}, oc{1 << 30, 1, 0, (long)T_CTX * D};
        hipLaunchKernelGGL((k_gemm<true, 3, true>), dim3(512 / 128, T_CTX / 128, NB_CTX), dim3(256), 0, st, p.DFT_C, 512L, Z0, p.YTC, 512L, ob, (void*)(p.MIX + 1536), (long)D, oc, 512, (const float*)nullptr); }
    for (int b = 0; b < NB_LAT; ++b) {
        const size_t row0 = (size_t)M_CTX + (size_t)b * T_LAT;
        const bf16_t* kal = p.KAL + (size_t)(l * NB_LAT + b) * S_LAT * 256; const bf16_t* val = p.VAL + (size_t)(l * NB_LAT + b) * S_LAT * 256;
        const bf16_t* kbl = p.KBL + (size_t)(l * NB_LAT + b) * S_LAT * 512; const bf16_t* vbl = p.VBL + (size_t)(l * NB_LAT + b) * S_LAT * 512;
        {   ZOff oa{1 << 30, 1, 0, 128}, ob{1 << 30, 4, 0, 128}, oc{1 << 30, 1, 0, (long)T_LAT * S_LAT};
            hipLaunchKernelGGL((k_gemm<true, 0, false>), dim3(S_LAT / 128, T_LAT / 128, 8), dim3(256), 0, st, p.QA + row0 * 1024, 1024L, oa, kal, 256L, ob, (void*)ZF, (long)S_LAT, oc, 128, (const float*)nullptr);
            const long nr = 8L * T_LAT; hipLaunchKernelGGL(k_softmax, dim3((unsigned)(nr / 4)), dim3(256), 0, st, ZF, PB, S_LAT, scA, nr);
            ZOff pa{1 << 30, 1, 0, (long)T_LAT * S_LAT}, pb{1 << 30, 4, 0, 128}, pc{1 << 30, 1, 0, 128};
            hipLaunchKernelGGL((k_gemm<false, 3, false>), dim3(1, T_LAT / 128, 8), dim3(256), 0, st, PB, (long)S_LAT, pa, val, 256L, pb, (void*)(p.MIX + row0 * D), (long)D, pc, S_LAT, (const float*)nullptr); }
        {   ZOff oa{1 << 30, 1, 0, 64}, ob{1 << 30, 1, 0, 64}, oc{1 << 30, 1, 0, (long)T_LAT * S_LAT};
            hipLaunchKernelGGL((k_gemm<true, 0, false>), dim3(S_LAT / 128, T_LAT / 128, 8), dim3(256), 0, st, p.QB + row0 * 512, 512L, oa, kbl, 512L, ob, (void*)ZF, (long)S_LAT, oc, 64, (const float*)nullptr);
            const long nr = 4L * T_LAT; hipLaunchKernelGGL(k_softmax_diff, dim3((unsigned)(nr / 4)), dim3(256), 0, st, ZF, PB, S_LAT, T_LAT, scB, p.LAM + l, nr);
            ZOff pa{1 << 30, 1, 0, (long)T_LAT * S_LAT}, pb{1 << 30, 1, 0, 128}, pc{1 << 30, 1, 0, (long)T_LAT * 128};
            hipLaunchKernelGGL((k_gemm<false, 0, false>), dim3(1, T_LAT / 128, 4), dim3(256), 0, st, PB, (long)S_LAT, pa, vbl, 512L, pb, (void*)p.OTMP, 128L, pc, S_LAT, (const float*)nullptr);
            hipLaunchKernelGGL(k_subln, dim3((unsigned)(nr / 4)), dim3(256), 0, st, p.OTMP, p.MIX, T_LAT, (long)row0, p.subln + l * 128, post, nr); }
        {   hipLaunchKernelGGL((k_gemm<true, 3, true>), dim3(512 / 128, T_LAT / 128, 1), dim3(256), 0, st, p.DFT_L, 4096L, Z0, p.YTL + (size_t)b * 512 * 4096, 4096L, Z0, (void*)(p.MIX + row0 * D + 1536), (long)D, Z0, 4096, (const float*)nullptr); }
    }
    }
    if (mask & 8u) hipLaunchKernelGGL((k_gemm<true, 2, true>), dim3(D / 128, M_ALL / 128, 1), dim3(256), 0, st, p.MIX, (long)D, Z0, p.BT_OUT + (size_t)l * D * D, (long)D, Z0, (void*)p.out, (long)D, Z0, D, mod_l + 2 * D);
    if (mask & 16u) hipLaunchKernelGGL(k_norm, dim3(M_ALL / 4), dim3(256), 0, st, p.x_prompt, p.x_sample, p.out, 0, p.g_mlp + (size_t)l * D, mod_l, 3, p.H);
    if (mask & 32u) hipLaunchKernelGGL((k_gemm<true, 1, true>), dim3(DFF / 128, M_ALL / 128, 1), dim3(256), 0, st, p.H, (long)D, Z0, p.BT_MI + (size_t)l * DFF * D, (long)D, Z0, (void*)p.HID, (long)DFF, Z0, D, (const float*)nullptr);
    if (mask & 64u) hipLaunchKernelGGL((k_gemm<true, 2, true>), dim3(D / 128, M_ALL / 128, 1), dim3(256), 0, st, p.HID, (long)DFF, Z0, p.BT_MO + (size_t)l * D * DFF, (long)DFF, Z0, (void*)p.out, (long)D, Z0, DFF, mod_l + 5 * D);
}
namespace pg8 {
#define PG8_LAS __attribute__((address_space(3)))
typedef unsigned short bf16_t;
typedef short bf16x8 __attribute__((ext_vector_type(8)));
typedef float f32x4 __attribute__((ext_vector_type(4)));
typedef unsigned u32x4 __attribute__((ext_vector_type(4)));
constexpr int BM = 256, BK = 64, HALF = 128, HTB = HALF * BK * 2  , STAGE_BYTES = 8 * HTB, NXCD = 8, WGM = 8;

__host__ __device__ __forceinline__ int lds_byte(int r, int c) { const int st = (r >> 4) * 2 + (c >> 5), rr = r & 15, cc = c & 31, ob = rr * 64 + cc * 2; return st * 1024 + (ob ^ (((ob >> 9) & 1) << 5)); }
__host__ __device__ __forceinline__ void stage_rc(int b, int& R, int& C) { const int st = b / 1024, sb = b % 1024, swz = sb ^ (((sb >> 9) & 1) << 5); R = (st >> 1) * 16 + swz / 64; C = (st & 1) * 32 + (swz % 64) / 2; }
__host__ __device__ __forceinline__ int perm32(int rho) { const int n = rho >> 4, i = rho & 15; return 8 * (i >> 2) + 4 * n + (i & 3); }

struct Unit { int pm, pn, kh, aux; };
struct Gemm { const bf16_t* A; const bf16_t* Bt; int M, N, K, ld; };

struct StaticOrder {
    int nM, nN, nwg, G, c; int rounds = 1 << 30;
    __device__ __forceinline__ const char* aptr(const Unit& u, const Gemm& g) const { return (const char*)g.A + (size_t)u.pm * ((size_t)BM * g.ld * 2) + (size_t)u.kh * ((size_t)g.K * 2); }
    __device__ __forceinline__ const char* bptr(const Unit& u, const Gemm& g) const { return (const char*)g.Bt + (size_t)u.pn * ((size_t)BM * g.ld * 2) + (size_t)u.kh * ((size_t)g.K * 2); }
    __host__ __device__ void init(int M, int N, int G_, int c_) { nM = M / BM; nN = N / BM; nwg = nM * nN; G = G_; c = c_; }
    __host__ __device__ bool next(int i, Unit& u) const {
        const long L = (long)i * G + c; if (L >= nwg || i >= rounds) return false; u.kh = 0; u.aux = 0;
        int wgid = (int)L; { const int q = nwg / NXCD, r = nwg % NXCD, xcd = wgid % NXCD, off = wgid / NXCD; wgid = (xcd < r ? xcd * (q + 1) : r * (q + 1) + (xcd - r) * q) + off; }
        const int nig = WGM * nN, gid = wgid / nig, fm = gid * WGM, gsz = (nM - fm) < WGM ? (nM - fm) : WGM;
        u.pm = fm + ((wgid % nig) % gsz); u.pn = (wgid % nig) / gsz; return true;
    }
    __device__ __forceinline__ void a_ready(const Unit&) const {}
    __device__ __forceinline__ void done(const Unit&) const {}
};


__device__ __forceinline__ unsigned cvt_pk_bf16(float lo, float hi) { unsigned r; asm volatile("v_cvt_pk_bf16_f32 %0, %1, %2" : "=v"(r) : "v"(lo), "v"(hi)); return r; }
__device__ __forceinline__ u32x4 pack8(const f32x4 a, const f32x4 b) { u32x4 w; w.x = cvt_pk_bf16(a[0], a[1]); w.y = cvt_pk_bf16(a[2], a[3]); w.z = cvt_pk_bf16(b[0], b[1]); w.w = cvt_pk_bf16(b[2], b[3]); return w; }
#define EPI_LANE_COORDS int t_ = threadIdx.x; asm volatile("" : "+v"(t_)); const int wid_ = __builtin_amdgcn_readfirstlane(t_ >> 6), wr = wid_ >> 2, wc = wid_ & 3, fr = t_ & 15, fq = (t_ >> 4) & 3
__device__ __forceinline__ float row_rinv(const float* ss, int row) {
    const f32x4 a = *(const f32x4*)(ss + (size_t)row * 8), b = *(const f32x4*)(ss + (size_t)row * 8 + 4);
    return __builtin_amdgcn_rsqf((((a[0] + a[1]) + (a[2] + a[3])) + ((b[0] + b[1]) + (b[2] + b[3]))) * (1.0f / D) + EPS);
}
struct EpiRelu2 {
    static constexpr bool PERM = false, AFTER_DRAIN = false;
    bf16_t* O; int ldc; const float* ss; const float* bias;
    __device__ __forceinline__ void operator()(f32x4 (&acc)[2][2][4][2], const Unit& u, int, int, int, int, PG8_LAS unsigned char*) const {
        EPI_LANE_COORDS;
        const int cond = u.pm < 16 ? 0 : 1 + ((u.pm - 16) >> 3);
        const float* bp = bias + (size_t)cond * ldc + u.pn * BM + wc * 32 + 4 * fq;
        f32x4 bv[2][2];
#pragma unroll
        for (int bj = 0; bj < 2; ++bj) { bv[bj][0] = *(const f32x4*)(bp + bj * HALF); bv[bj][1] = *(const f32x4*)(bp + bj * HALF + 16); }
        const int row0 = u.pm * BM + wr * 64 + fr;
        bf16_t* base = O + (size_t)row0 * ldc + u.pn * BM + wc * 32 + 8 * fq;
#pragma unroll
        for (int ai = 0; ai < 2; ++ai)
#pragma unroll
            for (int m = 0; m < 4; ++m) { bf16_t* rowp = base + (size_t)(ai * HALF + m * 16) * ldc;
                const float r = row_rinv(ss, row0 + ai * HALF + m * 16);
#pragma unroll
                for (int bj = 0; bj < 2; ++bj) { f32x4 v0 = acc[ai][bj][m][0] * r + bv[bj][0], v1 = acc[ai][bj][m][1] * r + bv[bj][1];
#pragma unroll
                    for (int e = 0; e < 4; ++e) { const float a = v0[e] > 0.f ? v0[e] : 0.f, b = v1[e] > 0.f ? v1[e] : 0.f; v0[e] = a * a; v1[e] = b * b; }
                    *(u32x4*)(rowp + bj * HALF) = pack8(v0, v1); } }
    }
};
struct EpiBf16Out {
    static constexpr bool PERM = false, AFTER_DRAIN = false;
    bf16_t* O; int ldc; int col_off;
    __device__ __forceinline__ void operator()(f32x4 (&acc)[2][2][4][2], const Unit& u, int, int, int, int, PG8_LAS unsigned char*) const {
        EPI_LANE_COORDS;
        bf16_t* base = O + (size_t)(u.pm * BM + wr * 64 + fr) * ldc + col_off + u.pn * BM + wc * 32 + 8 * fq;
#pragma unroll
        for (int ai = 0; ai < 2; ++ai)
#pragma unroll
            for (int m = 0; m < 4; ++m) { bf16_t* rowp = base + (size_t)(ai * HALF + m * 16) * ldc;
#pragma unroll
                for (int bj = 0; bj < 2; ++bj) *(u32x4*)(rowp + bj * HALF) = pack8(acc[ai][bj][m][0], acc[ai][bj][m][1]); }
    }
};
struct ResNext { bf16_t* XA; const float* gn; const float* scn; float* ssn; };
struct EpiRes {
    static constexpr bool PERM = false, AFTER_DRAIN = false;
    float* X; const float* gate; ResNext nx;
    template <bool SPLIT>
    __device__ __forceinline__ void run(f32x4 (&acc)[2][2][4][2], const Unit& u, int wr, int wc, int fr, int fq, const float* pb, PG8_LAS unsigned char* lds, int t_) const {
        PG8_LAS float* PT = (PG8_LAS float*)(lds + STAGE_BYTES);
        const int cond = u.pm < 16 ? 0 : 1 + ((u.pm - 16) >> 3); const int col0 = u.pn * BM + wc * 32 + 8 * fq;
        const float* gp = gate + (size_t)cond * NMOD + col0;
        f32x4 gv[2][2], av[2][2];
        const bool has_next = nx.XA != nullptr;
#pragma unroll
        for (int bj = 0; bj < 2; ++bj) { gv[bj][0] = *(const f32x4*)(gp + bj * HALF); gv[bj][1] = *(const f32x4*)(gp + bj * HALF + 4); av[bj][0] = (f32x4){0.f, 0.f, 0.f, 0.f}; av[bj][1] = av[bj][0]; }
        if (has_next) { const float* g2 = nx.gn + col0; const float* s2 = nx.scn + (size_t)cond * NMOD + col0;
#pragma unroll
            for (int bj = 0; bj < 2; ++bj) { av[bj][0] = *(const f32x4*)(g2 + bj * HALF) * (*(const f32x4*)(s2 + bj * HALF) + 1.0f); av[bj][1] = *(const f32x4*)(g2 + bj * HALF + 4) * (*(const f32x4*)(s2 + bj * HALF + 4) + 1.0f); } }
        const int row0 = u.pm * BM + wr * 64 + fr;
        float* base = X + (size_t)row0 * D + col0;
#pragma unroll
        for (int ai = 0; ai < 2; ++ai)
#pragma unroll
            for (int m = 0; m < 4; ++m) { const int ro = ai * HALF + m * 16; float* rowp = base + (size_t)ro * D; float sq = 0.f;
#pragma unroll
                for (int bj = 0; bj < 2; ++bj) { f32x4 x0 = *(const f32x4*)(rowp + bj * HALF), x1 = *(const f32x4*)(rowp + bj * HALF + 4);
                    f32x4 a0 = acc[ai][bj][m][0], a1 = acc[ai][bj][m][1];
                    if (SPLIT) { a0 = a0 + *(const f32x4*)(pb + (size_t)(((ai * 2 + bj) * 4 + m) * 2 + 0) * 2048); a1 = a1 + *(const f32x4*)(pb + (size_t)(((ai * 2 + bj) * 4 + m) * 2 + 1) * 2048); }
                    x0 = x0 + gv[bj][0] * a0; x1 = x1 + gv[bj][1] * a1;
                    *(f32x4*)(rowp + bj * HALF) = x0; *(f32x4*)(rowp + bj * HALF + 4) = x1;
                    if (has_next) { *(u32x4*)(nx.XA + (size_t)(row0 + ro) * D + col0 + bj * HALF) = pack8(x0 * av[bj][0], x1 * av[bj][1]);
                        sq += (x0[0] * x0[0] + x0[1] * x0[1]) + (x0[2] * x0[2] + x0[3] * x0[3]) + (x1[0] * x1[0] + x1[1] * x1[1]) + (x1[2] * x1[2] + x1[3] * x1[3]); } }
                if (has_next) { sq += __shfl_xor(sq, 16); sq += __shfl_xor(sq, 32); if (fq == 0) PT[(ro + wr * 64 + fr) * 4 + wc] = sq; }
                asm volatile("" ::: "memory"); }
        if (has_next) {
            asm volatile("s_waitcnt lgkmcnt(0)" ::: "memory"); __builtin_amdgcn_s_barrier(); asm volatile("" ::: "memory");
            if (t_ < 256) { const f32x4 p = *(const PG8_LAS f32x4*)(PT + t_ * 4); nx.ssn[(size_t)(u.pm * BM + t_) * 8 + u.pn] = (p[0] + p[1]) + (p[2] + p[3]); }
        }
    }
    __device__ __forceinline__ void operator()(f32x4 (&acc)[2][2][4][2], const Unit& u, int, int, int, int, PG8_LAS unsigned char* lds) const {
        EPI_LANE_COORDS;
        run<false>(acc, u, wr, wc, fr, fq, nullptr, lds, t_);
    }
};
struct EpiIn {
    static constexpr bool PERM = false, AFTER_DRAIN = false;
    int l;
    unsigned char* ws; float* out_; const float* ss; const float* bias;
    __device__ __forceinline__ void operator()(f32x4 (&acc)[2][2][4][2], const Unit& u, int, int, int, int, PG8_LAS unsigned char* lds) const {
        EPI_LANE_COORDS;
        unsigned char* w = ws; float* out = out_; asm volatile("" : "+s"(w), "+s"(out));
        bf16_t* const QA = (bf16_t*)(w + WS_QA); bf16_t* const KAL = (bf16_t*)(w + WS_KAL); bf16_t* const VAL = (bf16_t*)(w + WS_VAL); bf16_t* const KAC = (bf16_t*)(w + WS_KAC); bf16_t* const VAC = (bf16_t*)(w + WS_VAC);
        bf16_t* const QB = (bf16_t*)(w + WS_QB); bf16_t* const KBL = (bf16_t*)(w + WS_KBL); bf16_t* const VBL = (bf16_t*)(w + WS_VBL); bf16_t* const KBC = (bf16_t*)(w + WS_KBC); bf16_t* const VBC = (bf16_t*)(w + WS_VBC);
        bf16_t* const YTL = (bf16_t*)(w + WS_YTL); bf16_t* const YTC = (bf16_t*)(w + WS_YTC); const float* const rope = (const float*)(w + WS_ROPE); const float* const gains = (const float*)(w + WS_GAIN) + l * 384;
        const int pn = u.pn, pm = u.pm; const bool lat = pm >= 16; const int b = lat ? (pm - 16) >> 3 : pm; const int tbase = lat ? ((pm - 16) & 7) * 256 : 0;
        const int rl0 = wr * 64 + fr;
        {
            const int cond = lat ? 1 + b : 0; const float* bp = bias + (size_t)cond * N_IN + pn * BM + wc * 32 + 4 * fq;
            f32x4 bv[2][2];
#pragma unroll
            for (int bj = 0; bj < 2; ++bj) { bv[bj][0] = *(const f32x4*)(bp + bj * HALF); bv[bj][1] = *(const f32x4*)(bp + bj * HALF + 16); }
#pragma unroll
            for (int ai = 0; ai < 2; ++ai)
#pragma unroll
                for (int m = 0; m < 4; ++m) { const float r = row_rinv(ss, pm * BM + ai * HALF + m * 16 + rl0);
#pragma unroll
                    for (int bj = 0; bj < 2; ++bj) { acc[ai][bj][m][0] = acc[ai][bj][m][0] * r + bv[bj][0]; acc[ai][bj][m][1] = acc[ai][bj][m][1] * r + bv[bj][1]; } }
        }
        const size_t lrow = (size_t)(l * NB_LAT + b) * S_LAT;
        PG8_LAS float* P = (PG8_LAS float*)(lds + STAGE_BYTES);
        const bool normed = (pn <= 4) || (pn >= 6 && pn <= 9);
        if (normed) {
            const bool is128 = pn <= 4;
#pragma unroll
            for (int ai = 0; ai < 2; ++ai)
#pragma unroll
                for (int m = 0; m < 4; ++m)
#pragma unroll
                    for (int bj = 0; bj < 2; ++bj) { const f32x4 a0 = acc[ai][bj][m][0], a1 = acc[ai][bj][m][1];
                        float s = (a0[0] * a0[0] + a0[1] * a0[1]) + (a0[2] * a0[2] + a0[3] * a0[3]) + (a1[0] * a1[0] + a1[1] * a1[1]) + (a1[2] * a1[2] + a1[3] * a1[3]);
                        s += __shfl_xor(s, 16); s += __shfl_xor(s, 32);
                        if (fq == 0) P[(bj * 256 + ai * HALF + m * 16 + rl0) * 4 + wc] = s; }
            asm volatile("s_waitcnt lgkmcnt(0)" ::: "memory"); __builtin_amdgcn_s_barrier(); asm volatile("" ::: "memory");
            int lbase, pstep, fbase, sbase;
            const float *cosT, *sinT; int tstride; const float* g;
            if (is128) { const int u16 = 4 * wc + fq; lbase = (u16 < 8 ? 0 : 64) + 4 * (u16 & 7); pstep = 32; fbase = (u16 < 8 ? 0 : 32) + 4 * (u16 & 7); sbase = 8 * u16;
                cosT = rope; sinT = rope + 2048 * 64; tstride = 64; g = gains + ((pn < 4) ? 0 : 128); }
            else { const int u8 = 4 * (wc & 1) + fq; lbase = (u8 < 4 ? 0 : 32) + 4 * (u8 & 3); pstep = 16; fbase = (u8 < 4 ? 0 : 16) + 4 * (u8 & 3); sbase = 64 * (wc >> 1) + 8 * u8;
                cosT = rope + 2 * 2048 * 64; sinT = cosT + 2048 * 32; tstride = 32; g = gains + ((pn < 8) ? 256 : 320); }
            const f32x4 g0 = *(const f32x4*)(g + lbase), g1 = *(const f32x4*)(g + lbase + pstep);
            const float invdim = is128 ? (1.0f / 128.0f) : (1.0f / 64.0f);
            const bool isq = (pn < 4) || (pn == 6) || (pn == 7);
#pragma unroll
            for (int ai = 0; ai < 2; ++ai)
#pragma unroll
                for (int m = 0; m < 4; ++m) { const int rl = ai * HALF + m * 16 + rl0; const int tk = tbase + rl; const size_t row = (size_t)pm * BM + rl;
                    f32x4 cs4 = (f32x4){1.f, 1.f, 1.f, 1.f}, sn4 = (f32x4){0.f, 0.f, 0.f, 0.f};
                    if (lat) { cs4 = *(const f32x4*)(cosT + (size_t)tk * tstride + fbase); sn4 = *(const f32x4*)(sinT + (size_t)tk * tstride + fbase); }
#pragma unroll
                    for (int bj = 0; bj < 2; ++bj) { const f32x4 pp = *(const PG8_LAS f32x4*)(P + (bj * 256 + rl) * 4);
                        const float tot = is128 ? ((pp[0] + pp[1]) + (pp[2] + pp[3])) : (wc < 2 ? pp[0] + pp[1] : pp[2] + pp[3]);
                        const float rinv = __builtin_amdgcn_rsqf(tot * invdim + EPS);
                        f32x4 x1 = acc[ai][bj][m][0] * rinv * g0, x2 = acc[ai][bj][m][1] * rinv * g1;
                        bf16_t* dst;
                        if (is128) { if (pn < 4) dst = QA + row * 1024 + (2 * pn + bj) * 128 + sbase;
                            else if (lat) dst = KAL + (lrow + tk) * 256 + bj * 128 + sbase;
                            else { dst = KAC + row * 256 + bj * 128 + sbase; float* st = out + OUT_SAK + ((size_t)(b * DEPTH + l) * T_CTX + tk) * 256 + bj * 128 + lbase; *(f32x4*)st = x1; *(f32x4*)(st + pstep) = x2; } }
                        else { const int h = 2 * ((pn - 6) & 1) + bj;
                            if (pn < 8) dst = QB + row * 512 + h * 128 + sbase;
                            else if (lat) dst = KBL + (lrow + tk) * 512 + h * 128 + sbase;
                            else { dst = KBC + row * 512 + h * 128 + sbase; float* st = out + OUT_SDK + ((size_t)(b * DEPTH + l) * T_CTX + tk) * 512 + h * 128 + 64 * (wc >> 1) + lbase; *(f32x4*)st = x1; *(f32x4*)(st + pstep) = x2; } }
                        if (lat) { const f32x4 y1 = x1 * cs4 - x2 * sn4, y2 = x2 * cs4 + x1 * sn4; x1 = y1; x2 = y2; }
                        *(u32x4*)dst = pack8(x1, x2); }
                    asm volatile("" ::: "memory");
                }
            (void)isq;
        } else if (pn == 5 || pn == 10 || pn == 11) {
            const bool isa = pn == 5; const int pitch = isa ? 256 : 512; const int hb = isa ? 0 : 2 * (pn - 10);
            const int sb = wc * 32 + 8 * fq;
#pragma unroll
            for (int ai = 0; ai < 2; ++ai)
#pragma unroll
                for (int m = 0; m < 4; ++m) { const int rl = ai * HALF + m * 16 + rl0; const int tk = tbase + rl; const size_t row = (size_t)pm * BM + rl;
#pragma unroll
                    for (int bj = 0; bj < 2; ++bj) { const int col = (hb + bj) * 128 + sb; const f32x4 x1 = acc[ai][bj][m][0], x2 = acc[ai][bj][m][1];
                        bf16_t* dst;
                        if (lat) dst = (isa ? VAL : VBL) + (lrow + tk) * pitch + col;
                        else { dst = (isa ? VAC : VBC) + row * pitch + col; float* st = out + (isa ? OUT_SAV : OUT_SDV) + ((size_t)(b * DEPTH + l) * T_CTX + tk) * pitch + col; *(f32x4*)st = x1; *(f32x4*)(st + 4) = x2; }
                        *(u32x4*)dst = pack8(x1, x2); } }
        } else {
            const int cs = (pn - 12) >> 1; const int g2 = 2 * ((pn - 12) & 1);
            bf16_t* ybase = lat ? YTL + (size_t)b * 512 * 4096 + cs * T_LAT + tbase : YTC + (size_t)b * 512 * 512 + cs * T_CTX;
            const size_t ypitch = lat ? 4096 : 512;
#pragma unroll
            for (int ai = 0; ai < 2; ++ai)
#pragma unroll
                for (int m = 0; m < 4; ++m) { const int rl = ai * HALF + m * 16 + rl0;
#pragma unroll
                    for (int bj = 0; bj < 2; ++bj)
#pragma unroll
                        for (int n = 0; n < 2; ++n) { const f32x4 v = acc[ai][bj][m][n];
#pragma unroll
                            for (int e = 0; e < 4; ++e) { const int yrow = (g2 + bj) * 128 + wc * 32 + 16 * n + 4 * fq + e; ybase[(size_t)yrow * ypitch + rl] = (bf16_t)(cvt_pk_bf16(v[e], 0.f) & 0xffffu); } } }
        }
    }
};
struct SplitOrder {
    StaticOrder base; int c, on;
    __device__ __forceinline__ void init(int M, int N, int G, int c_) { base.init(M, N, 256, c_ & 127); c = c_; on = (G == 256); }
    __device__ __forceinline__ bool next(int i, Unit& u) const { if (!on || i > 0) return false; const bool ok = base.next(2, u); u.kh = c >> 7; u.aux = c & 127; return ok; }
    __device__ __forceinline__ const char* aptr(const Unit& u, const Gemm& g) const { return base.aptr(u, g); }
    __device__ __forceinline__ const char* bptr(const Unit& u, const Gemm& g) const { return base.bptr(u, g); }
    __device__ __forceinline__ void a_ready(const Unit&) const {}
    __device__ __forceinline__ void done(const Unit&) const {}
};
struct EpiResSplit {
    static constexpr bool PERM = false, AFTER_DRAIN = false;
    EpiRes R; float* part; unsigned* flags; unsigned* tmo;
    __device__ __forceinline__ void operator()(f32x4 (&acc)[2][2][4][2], const Unit& u, int, int, int, int, PG8_LAS unsigned char* lds) const {
        EPI_LANE_COORDS;
        float* pb = part + (size_t)u.aux * 65536 + (size_t)t_ * 4;
        unsigned* flag = flags + (size_t)u.aux * 64;
        if (u.kh == 1) {
#pragma unroll
            for (int ai = 0; ai < 2; ++ai)
#pragma unroll
                for (int bj = 0; bj < 2; ++bj)
#pragma unroll
                    for (int m = 0; m < 4; ++m)
#pragma unroll
                        for (int n = 0; n < 2; ++n) *(f32x4*)(pb + (size_t)(((ai * 2 + bj) * 4 + m) * 2 + n) * 2048) = acc[ai][bj][m][n];
            asm volatile("s_waitcnt vmcnt(0)" ::: "memory");
            __builtin_amdgcn_s_barrier(); asm volatile("" ::: "memory");
            if (t_ == 0) { __builtin_amdgcn_fence(__ATOMIC_RELEASE, "agent"); asm volatile("s_waitcnt vmcnt(0)" ::: "memory");
                __hip_atomic_store(flag, 1u, __ATOMIC_RELAXED, __HIP_MEMORY_SCOPE_AGENT); }
        } else {
            if (wid_ == 0) {
                unsigned sp = 0;
                while ((unsigned)__builtin_amdgcn_readfirstlane(__hip_atomic_load(flag, __ATOMIC_RELAXED, __HIP_MEMORY_SCOPE_AGENT)) == 0u) {
                    __builtin_amdgcn_s_sleep(2);
                    if ((++sp & 1023u) == 0u) { if (__builtin_amdgcn_readfirstlane(__hip_atomic_load(tmo, __ATOMIC_RELAXED, __HIP_MEMORY_SCOPE_AGENT)) != 0u) break;
                        if (sp > (1u << 22)) { if (t_ == 0) __hip_atomic_store(tmo, 1u, __ATOMIC_RELAXED, __HIP_MEMORY_SCOPE_AGENT); break; } } }
                __builtin_amdgcn_fence(__ATOMIC_ACQUIRE, "agent");
                asm volatile("s_waitcnt vmcnt(0)" ::: "memory");
            }
            __builtin_amdgcn_s_barrier(); asm volatile("" ::: "memory");
            R.run<true>(acc, u, wr, wc, fr, fq, pb, lds, t_);
        }
    }
};
struct DftOrder {
    int lat, first, count, G, c;
    __device__ __forceinline__ bool next(int i, Unit& u) const {
        const int nu = lat ? 128 : 32; const int k = c - first; if (k < 0 || k >= count) return false; const int id = k + i * count; if (id >= nu) return false;
        u.kh = 0; u.aux = 0;
        if (lat) { const int b = id >> 4, pmm = (id >> 1) & 7; u.pm = 16 + b * 8 + pmm; u.pn = id & 1; } else { u.pm = id >> 1; u.pn = id & 1; }
        return true;
    }
    __device__ __forceinline__ const char* aptr(const Unit& u, const Gemm& g) const { return lat ? (const char*)g.A + (size_t)((u.pm - 16) & 7) * ((size_t)BM * g.ld * 2) : (const char*)g.A; }
    __device__ __forceinline__ const char* bptr(const Unit& u, const Gemm& g) const { const int b = lat ? (u.pm - 16) >> 3 : u.pm; return (const char*)g.Bt + ((size_t)b * 512 + (size_t)u.pn * BM) * ((size_t)g.ld * 2); }
    __device__ __forceinline__ void a_ready(const Unit&) const {}
    __device__ __forceinline__ void done(const Unit&) const {}
};
template <class Epi, class Sched, bool ALIGN_EPI = false, bool SP2 = false>
__device__ __forceinline__ void gemm_phase(PG8_LAS unsigned char* lds, const Gemm g, const Sched& S, const Epi& E) {
    int tid = threadIdx.x; asm volatile("" : "+v"(tid));
    const int wid = __builtin_amdgcn_readfirstlane(tid >> 6), lane = tid & 63, wr = wid >> 2, wc = wid & 3, fr = lane & 15, fq = lane >> 4;
    const int K = g.ld, nt = g.K / BK;
    unsigned voffA[2], voffB[2];
#pragma unroll
    for (int i = 0; i < 2; ++i) { int R, C; stage_rc(tid * 16 + i * 8192, R, C); const int Rb = Epi::PERM ? ((R & ~31) + perm32(R & 31)) : R;
        voffA[i] = (unsigned)(R * K + C) * 2u; voffB[i] = (unsigned)(Rb * K + C) * 2u; }
    const size_t kstep = (size_t)(BK * 2);
    const size_t hstep = (size_t)HALF * K * 2;
    const size_t tstep = 2 * hstep;
    const unsigned ldsw = (unsigned)wid * 1024u;
    const int aoff = lds_byte(wr * 64 + fr, fq * 8), boff = lds_byte(wc * 32 + fr, fq * 8);
#define PG8_SA(b, h) (((b) * 2 + (h)) * HTB)
#define PG8_SB(b, h) ((4 + (b) * 2 + (h)) * HTB)
#define PG8_STAGE(bufoff, gbase, voff) do { _Pragma("unroll") for (int _i = 0; _i < 2; ++_i) \
        __builtin_amdgcn_global_load_lds((const unsigned*)((const char*)(gbase) + (voff)[_i]), (PG8_LAS unsigned*)(lds + (bufoff) + ldsw + _i * 8192), 16, 0, 0); } while (0)
#define PG8_LDA(dst, b, h) do { _Pragma("unroll") for (int m = 0; m < 4; ++m) _Pragma("unroll") for (int k = 0; k < 2; ++k) dst[m][k] = *(const PG8_LAS bf16x8*)(lds + PG8_SA(b, h) + aoff + m * 2048 + k * 1024); } while (0)
#define PG8_LDB(dst, b, h) do { _Pragma("unroll") for (int n = 0; n < 2; ++n) _Pragma("unroll") for (int k = 0; k < 2; ++k) dst[n][k] = *(const PG8_LAS bf16x8*)(lds + PG8_SB(b, h) + boff + n * 2048 + k * 1024); } while (0)
#define PG8_MMA(ai, bj, At, Bt) do { __builtin_amdgcn_s_setprio(1); _Pragma("unroll") for (int m = 0; m < 4; ++m) _Pragma("unroll") for (int n = 0; n < 2; ++n) _Pragma("unroll") for (int k = 0; k < 2; ++k) \
        acc[ai][bj][m][n] = __builtin_amdgcn_mfma_f32_16x16x32_bf16(Bt[n][k], At[m][k], acc[ai][bj][m][n], 0, 0, 0); __builtin_amdgcn_s_setprio(0); } while (0)
#define PG8_WAIT_V(n) asm volatile("s_waitcnt vmcnt(" #n ")" ::: "memory")
#define PG8_WAIT_L(n) asm volatile("s_waitcnt lgkmcnt(" #n ")" ::: "memory")
#define PG8_BAR __builtin_amdgcn_s_barrier()
#define PG8_SCHED __builtin_amdgcn_sched_barrier(0)
    Unit cur, nxt; int ui = 0;
    if (!S.next(0, cur)) return;
    f32x4 acc[2][2][4][2];
#pragma unroll
    for (int a = 0; a < 2; ++a)
#pragma unroll
        for (int b = 0; b < 2; ++b)
#pragma unroll
            for (int m = 0; m < 4; ++m)
#pragma unroll
                for (int n = 0; n < 2; ++n) acc[a][b][m][n] = (f32x4){0.f, 0.f, 0.f, 0.f};
    bf16x8 At[4][2], B0[2][2], B1[2][2];
    const char* cA = S.aptr(cur, g); const char* cB = S.bptr(cur, g);
    S.a_ready(cur);
    if constexpr (SP2) {
        PG8_STAGE(PG8_SB(0, 0), cB, voffB); PG8_STAGE(PG8_SB(0, 1), cB + hstep, voffB); PG8_STAGE(PG8_SA(0, 0), cA, voffA); PG8_STAGE(PG8_SA(0, 1), cA + hstep, voffA);
        if (wr == 1) PG8_BAR;
        PG8_WAIT_V(2); PG8_BAR;
        PG8_STAGE(PG8_SB(1, 0), cB + kstep, voffB); PG8_STAGE(PG8_SA(1, 0), cA + kstep, voffA); PG8_STAGE(PG8_SB(1, 1), cB + hstep + kstep, voffB);
        PG8_WAIT_V(6); PG8_BAR;
    } else {
        PG8_STAGE(PG8_SB(0, 0), cB, voffB); PG8_STAGE(PG8_SA(0, 0), cA, voffA); PG8_STAGE(PG8_SB(0, 1), cB + hstep, voffB); PG8_STAGE(PG8_SA(0, 1), cA + hstep, voffA);
        if (wr == 1) PG8_BAR;
        PG8_WAIT_V(4); PG8_BAR;
        PG8_STAGE(PG8_SB(1, 0), cB + kstep, voffB); PG8_STAGE(PG8_SA(1, 0), cA + kstep, voffA); PG8_STAGE(PG8_SB(1, 1), cB + hstep + kstep, voffB);
        PG8_WAIT_V(6); PG8_BAR;
    }
    for (;;) {
        const bool has_next = S.next(ui + 1, nxt);
        const char* nA = has_next ? S.aptr(nxt, g) : cA; const char* nB = has_next ? S.bptr(nxt, g) : cB;
        for (int t = 0; t < nt; t += 2) {
            const bool last = (t == nt - 2);
            const char* a1 = cA + (size_t)(t + 1) * kstep;
            const char* a2 = last ? nA : cA + (size_t)(t + 2) * kstep; const char* b2 = last ? nB : cB + (size_t)(t + 2) * kstep;
            const char* a3 = a2 + kstep; const char* b3 = b2 + kstep;
            if (last && has_next) S.a_ready(nxt);
            if constexpr (SP2) {
            PG8_LDB(B0, 0, 0); PG8_LDB(B1, 0, 1); PG8_SCHED; PG8_LDA(At, 0, 0); PG8_STAGE(PG8_SA(1, 1), a1 + hstep, voffA);
            PG8_WAIT_V(8); PG8_WAIT_L(0); PG8_BAR; PG8_MMA(0, 0, At, B0); PG8_MMA(0, 1, At, B1); PG8_BAR; PG8_SCHED;
            PG8_LDA(At, 0, 1); PG8_STAGE(PG8_SB(0, 0), b2, voffB); PG8_STAGE(PG8_SB(0, 1), b2 + hstep, voffB); PG8_STAGE(PG8_SA(0, 0), a2, voffA);
            PG8_WAIT_V(8); PG8_WAIT_L(0); PG8_BAR; PG8_MMA(1, 0, At, B0); PG8_MMA(1, 1, At, B1); PG8_BAR; PG8_SCHED;
            PG8_LDB(B0, 1, 0); PG8_LDB(B1, 1, 1); PG8_SCHED; PG8_LDA(At, 1, 0); PG8_STAGE(PG8_SA(0, 1), a2 + hstep, voffA);
            PG8_WAIT_V(8); PG8_WAIT_L(0); PG8_BAR; PG8_MMA(0, 0, At, B0); PG8_MMA(0, 1, At, B1); PG8_BAR; PG8_SCHED;
            PG8_LDA(At, 1, 1); PG8_STAGE(PG8_SB(1, 0), b3, voffB); PG8_STAGE(PG8_SB(1, 1), b3 + hstep, voffB); PG8_STAGE(PG8_SA(1, 0), a3, voffA);
            PG8_WAIT_V(8); PG8_WAIT_L(0); PG8_BAR; PG8_MMA(1, 0, At, B0); PG8_MMA(1, 1, At, B1); PG8_BAR; PG8_SCHED;
            } else {
            PG8_LDB(B0, 0, 0); PG8_SCHED; PG8_LDA(At, 0, 0); PG8_STAGE(PG8_SA(1, 1), a1 + hstep, voffA);
            PG8_WAIT_L(8); PG8_BAR; PG8_WAIT_L(0); PG8_MMA(0, 0, At, B0); PG8_BAR; PG8_SCHED;
            PG8_LDB(B1, 0, 1); PG8_STAGE(PG8_SB(0, 0), b2, voffB);
            PG8_BAR; PG8_WAIT_L(0); PG8_MMA(0, 1, At, B1); PG8_BAR;
            PG8_LDA(At, 0, 1); PG8_STAGE(PG8_SA(0, 0), a2, voffA);
            PG8_BAR; PG8_WAIT_L(0); PG8_MMA(1, 0, At, B0); PG8_BAR; PG8_SCHED;
            PG8_STAGE(PG8_SB(0, 1), b2 + hstep, voffB);
            PG8_WAIT_V(6); PG8_BAR; PG8_MMA(1, 1, At, B1); PG8_BAR;
            PG8_LDB(B0, 1, 0); PG8_SCHED; PG8_LDA(At, 1, 0); PG8_STAGE(PG8_SA(0, 1), a2 + hstep, voffA);
            PG8_WAIT_L(8); PG8_BAR; PG8_WAIT_L(0); PG8_MMA(0, 0, At, B0); PG8_BAR; PG8_SCHED;
            PG8_LDB(B1, 1, 1); PG8_STAGE(PG8_SB(1, 0), b3, voffB);
            PG8_BAR; PG8_WAIT_L(0); PG8_MMA(0, 1, At, B1); PG8_BAR;
            PG8_LDA(At, 1, 1); PG8_STAGE(PG8_SA(1, 0), a3, voffA);
            PG8_BAR; PG8_WAIT_L(0); PG8_MMA(1, 0, At, B0); PG8_BAR; PG8_SCHED;
            PG8_STAGE(PG8_SB(1, 1), b3 + hstep, voffB);
            PG8_WAIT_V(6); PG8_BAR; PG8_MMA(1, 1, At, B1); PG8_BAR;
            }
        }
        if constexpr (ALIGN_EPI) { if (wr == 0) PG8_BAR; }
        if constexpr (!Epi::AFTER_DRAIN) { E(acc, cur, wr, wc, fr, fq, lds); S.done(cur); }
        if (!has_next) break;
#pragma unroll
        for (int a = 0; a < 2; ++a)
#pragma unroll
            for (int b = 0; b < 2; ++b)
#pragma unroll
                for (int m = 0; m < 4; ++m)
#pragma unroll
                    for (int n = 0; n < 2; ++n) acc[a][b][m][n] = (f32x4){0.f, 0.f, 0.f, 0.f};
        cur = nxt; cA = nA; cB = nB; ++ui;
        if constexpr (ALIGN_EPI) { if (wr == 1) PG8_BAR; }
    }
    PG8_WAIT_V(0);
    if constexpr (!ALIGN_EPI) { if (wr == 0) PG8_BAR; }
    PG8_BAR;
    if constexpr (Epi::AFTER_DRAIN) { E.fused(acc, cur, wr, wc, fr, fq, lds, wid, lane); S.done(cur); }
#undef PG8_SA
#undef PG8_SB
#undef PG8_STAGE
#undef PG8_LDA
#undef PG8_LDB
#undef PG8_MMA
#undef PG8_WAIT_V
#undef PG8_WAIT_L
#undef PG8_BAR
#undef PG8_SCHED
}
}
namespace att {
constexpr int DV = 128, NW = 8, QBLK = 32, KVBLK = 64;
constexpr float THR = 8.f;
constexpr size_t SHM_V = KVBLK * DV * 2, SHM_K = KVBLK * DV * 2, SHM_ATTN = 2 * SHM_V + 2 * SHM_K + NW * 64 * 4;
using s16x4 = __attribute__((ext_vector_type(4))) short;
using f32x16 = __attribute__((ext_vector_type(16))) float;
#define KSWZ(row, colB) ((row) * 256 + ((colB) ^ (((row) & 7) << 4)))
#define SBAR() __builtin_amdgcn_sched_barrier(0)
__device__ __forceinline__ int crow(int r, int hi) { return (r & 3) + 8 * (r >> 2) + 4 * hi; }
__device__ __forceinline__ unsigned cvtpk(float lo, float hi) { unsigned r; asm volatile("v_cvt_pk_bf16_f32 %0, %1, %2" : "=v"(r) : "v"(lo), "v"(hi)); return r; }

template <int DQK>
__device__ __forceinline__ void partialSM(f32x16& p0, f32x16& p1, float& m_reg, float& mn, float& alpha) {
  constexpr float SCALE = DQK == 128 ? 0.088388347648318440f : 0.125f;
  constexpr float C = SCALE * 1.4426950408889634f;
  float pmax = p0[0];
#pragma unroll
  for (int r = 1; r < 16; ++r) pmax = fmaxf(pmax, p0[r]);
#pragma unroll
  for (int r = 0; r < 16; ++r) pmax = fmaxf(pmax, p1[r]);
  { auto rr = __builtin_amdgcn_permlane32_swap(__float_as_uint(pmax), __float_as_uint(pmax), false, false);
    pmax = fmaxf(__uint_as_float(rr[0]), __uint_as_float(rr[1])); }
  if (__builtin_expect(__all(pmax - m_reg <= THR / SCALE), 1)) { mn = m_reg; alpha = 1.f; }
  else { mn = fmaxf(m_reg, pmax); alpha = __builtin_amdgcn_exp2f((m_reg - mn) * C); m_reg = mn; }
  float mnC = -mn * C;
#pragma unroll
  for (int r = 0; r < 16; ++r) p0[r] = fmaf(p0[r], C, mnC);
#pragma unroll
  for (int r = 0; r < 16; ++r) p1[r] = fmaf(p1[r], C, mnC);
#pragma unroll
  for (int r = 0; r < 16; ++r) p0[r] = __builtin_amdgcn_exp2f(p0[r]);
}
__device__ __forceinline__ void finishSM(f32x16& p0, f32x16& p1, float alpha, float& l_reg, bf16x8& pa0, bf16x8& pa1, bf16x8& pa2, bf16x8& pa3) {
#pragma unroll
  for (int r = 0; r < 16; ++r) p1[r] = __builtin_amdgcn_exp2f(p1[r]);
  float ps = 0;
#pragma unroll
  for (int r = 0; r < 16; ++r) ps += p0[r];
#pragma unroll
  for (int r = 0; r < 16; ++r) ps += p1[r];
  { auto rr = __builtin_amdgcn_permlane32_swap(__float_as_uint(ps), __float_as_uint(ps), false, false);
    ps = __uint_as_float(rr[0]) + __uint_as_float(rr[1]); }
  l_reg = l_reg * alpha + ps;
#define PK4(P, BASE, OUT) do { unsigned a0 = cvtpk(P[BASE + 0], P[BASE + 1]), a1 = cvtpk(P[BASE + 2], P[BASE + 3]);   \
    unsigned b0 = cvtpk(P[BASE + 4], P[BASE + 5]), b1 = cvtpk(P[BASE + 6], P[BASE + 7]);                              \
    auto r0 = __builtin_amdgcn_permlane32_swap(a0, b0, false, false); auto r1 = __builtin_amdgcn_permlane32_swap(a1, b1, false, false); \
    u32x4 w = {r0[0], r1[0], r0[1], r1[1]}; OUT = *reinterpret_cast<bf16x8*>(&w); } while (0)
  PK4(p0, 0, pa0); PK4(p0, 8, pa1); PK4(p1, 0, pa2); PK4(p1, 8, pa3);
#undef PK4
}
template <int DQK>
__device__ __forceinline__ void qkt(f32x16& p0, f32x16& p1, const char* Ks, const bf16x8* qr, int r32, int hi, int koffB) {
  p0 = f32x16{}; p1 = f32x16{};
  Ks += koffB;
#pragma unroll
  for (int d0 = 0; d0 < DQK / 16; ++d0) { int cb = (d0 * 16 + hi * 8) * 2;
    bf16x8 b0 = *reinterpret_cast<const bf16x8*>(Ks + KSWZ(r32, cb));
    bf16x8 b1 = *reinterpret_cast<const bf16x8*>(Ks + KSWZ(32 + r32, cb));
    p0 = __builtin_amdgcn_mfma_f32_32x32x16_bf16(b0, qr[d0], p0, 0, 0, 0);
    p1 = __builtin_amdgcn_mfma_f32_32x32x16_bf16(b1, qr[d0], p1, 0, 0, 0); }
}
__device__ __forceinline__ int v_st(int k, int c) { const int kk = (k & ~0xC) | ((k & 4) << 1) | ((k & 8) >> 1); return ((kk >> 3) * 4 + (c >> 5)) * 512 + ((kk & 7) * 32 + (c & 31)) * 2; }
__device__ __forceinline__ int v_rd_base(int lane) { return ((lane & 3) << 3) | (((lane >> 2) & 3) << 6) | (((lane >> 4) & 1) << 5) | (((lane >> 5) & 1) << 8); }
constexpr int v_rd_off(int d0, int ks, int half) { return d0 * 512 + ks * 4096 + half * 2048; }
template <int OFF> __device__ __forceinline__ s16x4 tr_read(int vb) {
  s16x4 r; asm volatile("ds_read_b64_tr_b16 %0, %1 offset:%2" : "=&v"(r) : "v"(vb), "i"(OFF) : "memory"); return r;
}
template <int D0> __device__ __forceinline__ void pv_one(f32x16& od, int vb, bf16x8 pa0, bf16x8 pa1, bf16x8 pa2, bf16x8 pa3) {
  const s16x4 l0 = tr_read<v_rd_off(D0, 0, 0)>(vb), h0 = tr_read<v_rd_off(D0, 0, 1)>(vb), l1 = tr_read<v_rd_off(D0, 1, 0)>(vb), h1 = tr_read<v_rd_off(D0, 1, 1)>(vb);
  const s16x4 l2 = tr_read<v_rd_off(D0, 2, 0)>(vb), h2 = tr_read<v_rd_off(D0, 2, 1)>(vb), l3 = tr_read<v_rd_off(D0, 3, 0)>(vb), h3 = tr_read<v_rd_off(D0, 3, 1)>(vb);
  asm volatile("s_waitcnt lgkmcnt(0)" ::: "memory"); SBAR();
#define PK(L, H) (bf16x8){L[0], L[1], L[2], L[3], H[0], H[1], H[2], H[3]}
  od = __builtin_amdgcn_mfma_f32_32x32x16_bf16(pa0, PK(l0, h0), od, 0, 0, 0);
  od = __builtin_amdgcn_mfma_f32_32x32x16_bf16(pa1, PK(l1, h1), od, 0, 0, 0);
  od = __builtin_amdgcn_mfma_f32_32x32x16_bf16(pa2, PK(l2, h2), od, 0, 0, 0);
  od = __builtin_amdgcn_mfma_f32_32x32x16_bf16(pa3, PK(l3, h3), od, 0, 0, 0);
#undef PK
}
__device__ __forceinline__ void pv_d0(f32x16* o, int vb, bf16x8 pa0, bf16x8 pa1, bf16x8 pa2, bf16x8 pa3) {
  pv_one<0>(o[0], vb, pa0, pa1, pa2, pa3); pv_one<1>(o[1], vb, pa0, pa1, pa2, pa3); pv_one<2>(o[2], vb, pa0, pa1, pa2, pa3); pv_one<3>(o[3], vb, pa0, pa1, pa2, pa3);
}
template <int DQK, int LDQ, int LDK>
__device__ __forceinline__ void body(const bf16_t* __restrict__ Qb, const bf16_t* __restrict__ Kh, const bf16_t* __restrict__ Vh, int seq, int koffB, char* lds, f32x16 (&o)[4], float (&rli)[16]) {
  int tid = threadIdx.x; asm volatile("" : "+v"(tid));
  const int wid = tid >> 6, lane = tid & 63, r32 = lane & 31, hi = lane >> 5;
  char* V_lds = lds; char* K_lds = lds + 2 * SHM_V;
  float* ws = (float*)(lds + 2 * SHM_V + 2 * SHM_K) + wid * 64; float* li_l = ws; float* al_l = ws + 32;
  float m_reg = -1e30f, l_reg = 0;
#pragma unroll
  for (int d = 0; d < 4; ++d) o[d] = f32x16{};
  bf16x8 qr[DQK / 16];
  const bf16_t* Qw = Qb + (long)(wid * QBLK + r32) * LDQ + hi * 8;
#pragma unroll
  for (int d0 = 0; d0 < DQK / 16; ++d0) qr[d0] = *reinterpret_cast<const bf16x8*>(Qw + d0 * 16);
  const int sr = tid >> 4, sc = (tid & 15) * 8, vst0 = v_st(sr, sc), vst1 = v_st(32 + sr, sc);
  const int vb0 = (int)(uintptr_t)V_lds + v_rd_base(lane);
  bf16x8 sv0a, sv1a, sk0a, sk1a, sv0b, sv1b, sk0b, sk1b;
#define SLOAD_A(k0) do { sv0a = *(const bf16x8*)&Vh[(long)((k0) + sr) * LDK + sc]; sv1a = *(const bf16x8*)&Vh[(long)((k0) + 32 + sr) * LDK + sc]; \
    sk0a = *(const bf16x8*)&Kh[(long)((k0) + sr) * LDK + sc]; sk1a = *(const bf16x8*)&Kh[(long)((k0) + 32 + sr) * LDK + sc]; } while (0)
#define SLOAD_B(k0) do { sv0b = *(const bf16x8*)&Vh[(long)((k0) + sr) * LDK + sc]; sv1b = *(const bf16x8*)&Vh[(long)((k0) + 32 + sr) * LDK + sc]; \
    sk0b = *(const bf16x8*)&Kh[(long)((k0) + sr) * LDK + sc]; sk1b = *(const bf16x8*)&Kh[(long)((k0) + 32 + sr) * LDK + sc]; } while (0)
#define SWRITE(b, V0, V1, K0, K1) do { *(bf16x8*)(V_lds + (b) * SHM_V + vst0) = V0; *(bf16x8*)(V_lds + (b) * SHM_V + vst1) = V1; const int kc = sc * 2; \
    *(bf16x8*)(K_lds + (b) * SHM_K + KSWZ(sr, kc)) = K0; *(bf16x8*)(K_lds + (b) * SHM_K + KSWZ(32 + sr, kc)) = K1; } while (0)
#define SWAIT() asm volatile("s_waitcnt vmcnt(4)" ::: "memory")
#define RESC(a) do { if (__any((a) < 1.f)) { if (hi == 0) al_l[r32] = (a); asm volatile("s_waitcnt lgkmcnt(0)" ::: "memory"); \
    _Pragma("unroll") for (int d = 0; d < 4; ++d) _Pragma("unroll") for (int r = 0; r < 16; ++r) o[d][r] *= al_l[crow(r, hi)]; } } while (0)
  f32x16 pA0, pA1, pB0, pB1; float mnA, mnB, alA, alB; bf16x8 pa0, pa1, pa2, pa3; const int NT = seq / KVBLK;
  SLOAD_A(0); asm volatile("s_waitcnt vmcnt(0)" ::: "memory"); SWRITE(0, sv0a, sv1a, sk0a, sk1a); __syncthreads();
  qkt<DQK>(pA0, pA1, K_lds, qr, r32, hi, koffB); partialSM<DQK>(pA0, pA1, m_reg, mnA, alA);
  SLOAD_B(KVBLK); if (2 < NT) SLOAD_A(2 * KVBLK);
  SWAIT(); SWRITE(1, sv0b, sv1b, sk0b, sk1b); __syncthreads();
  for (int j = 1; j + 1 < NT; j += 2) {
    SBAR(); qkt<DQK>(pB0, pB1, K_lds + SHM_K, qr, r32, hi, koffB);
    finishSM(pA0, pA1, alA, l_reg, pa0, pa1, pa2, pa3); SBAR();
    SLOAD_B((j + 2) * KVBLK); SBAR();
    pv_d0(o, vb0, pa0, pa1, pa2, pa3); partialSM<DQK>(pB0, pB1, m_reg, mnB, alB);
    __syncthreads(); SWAIT(); SWRITE(0, sv0a, sv1a, sk0a, sk1a);
    RESC(alB); __syncthreads();
    SBAR(); qkt<DQK>(pA0, pA1, K_lds, qr, r32, hi, koffB);
    finishSM(pB0, pB1, alB, l_reg, pa0, pa1, pa2, pa3); SBAR();
    if (j + 3 < NT) SLOAD_A((j + 3) * KVBLK); SBAR();
    pv_d0(o, vb0 + (int)SHM_V, pa0, pa1, pa2, pa3); partialSM<DQK>(pA0, pA1, m_reg, mnA, alA);
    __syncthreads(); SWAIT(); SWRITE(1, sv0b, sv1b, sk0b, sk1b);
    RESC(alA); __syncthreads();
  }
  SBAR(); qkt<DQK>(pB0, pB1, K_lds + SHM_K, qr, r32, hi, koffB);
  finishSM(pA0, pA1, alA, l_reg, pa0, pa1, pa2, pa3); SBAR();
  pv_d0(o, vb0, pa0, pa1, pa2, pa3); partialSM<DQK>(pB0, pB1, m_reg, mnB, alB);
  __syncthreads(); RESC(alB);
  finishSM(pB0, pB1, alB, l_reg, pa0, pa1, pa2, pa3); SBAR();
  pv_d0(o, vb0 + (int)SHM_V, pa0, pa1, pa2, pa3);
  if (hi == 0) li_l[r32] = l_reg; asm volatile("s_waitcnt lgkmcnt(0)" ::: "memory");
#pragma unroll
  for (int r = 0; r < 16; ++r) rli[r] = __builtin_amdgcn_rcpf(li_l[crow(r, hi)]);
  __syncthreads();
#undef SLOAD_A
#undef SLOAD_B
#undef SWRITE
#undef SWAIT
#undef RESC
}
#undef KSWZ
#undef SBAR
}
#define GAS __attribute__((address_space(1)))
#define LAS __attribute__((address_space(3)))
typedef GAS unsigned gu32;
#define RLX_AGENT __ATOMIC_RELAXED, __HIP_MEMORY_SCOPE_AGENT
#define XB_TMO      128
#define XB_XCNT(j)  (256  + 64 * (j))
#define XB_XSUB(j)  (1280 + 64 * (j))
#define XB_XGEN(j)  (2304 + 64 * (j))
#define XB_TOP      3328
#define XB_TOPGEN   3392
#define XCD_BAR_WORDS 3456
#define XB_SPIN_CAP (1u << 18)

__device__ __forceinline__ unsigned xb_ld(unsigned* p)              { return __hip_atomic_load(p, __ATOMIC_RELAXED, __HIP_MEMORY_SCOPE_AGENT); }
__device__ __forceinline__ unsigned xb_add(unsigned* p, unsigned v) { return __hip_atomic_fetch_add(p, v, __ATOMIC_RELAXED, __HIP_MEMORY_SCOPE_AGENT); }
__device__ __forceinline__ unsigned xb_xcc_id() { return (unsigned)__builtin_amdgcn_s_getreg((3 << 11) | 20) & 0xFu; }
#define XB_SPIN(cond, bar) do { unsigned _sp = 0; while (cond) { __builtin_amdgcn_s_sleep(1); \
    if ((++_sp & 255u) == 0u) { if (xb_ld(&(bar)[XB_TMO])) break; if (_sp > XB_SPIN_CAP) { atomicAdd(&(bar)[XB_TMO], 1u); break; } } } } while (0)

struct XcdBarrier {
    unsigned* bar; unsigned x;
    volatile LAS unsigned* st;
};

__device__ __forceinline__ XcdBarrier xcd_barrier_post(unsigned* bar, volatile LAS unsigned* st) {
    XcdBarrier b; b.bar = bar; b.x = xb_xcc_id(); b.st = st;
    if (threadIdx.x == 0) (void)xb_add(&bar[XB_XCNT(b.x)], 1u);
    return b;
}
__device__ __forceinline__ void xcd_barrier_complete(unsigned* bar, unsigned x, unsigned& nloc, unsigned& nx) {
    const unsigned G = gridDim.x * gridDim.y * gridDim.z;
    unsigned sum, cnt, mine, sp = 0u;
    for (;;) {
        sum = 0u; cnt = 0u; mine = 0u;
#pragma unroll
        for (unsigned j = 0; j < 16; ++j) { const unsigned c = xb_ld(&bar[XB_XCNT(j)]); sum += c; cnt += (c > 0u) ? 1u : 0u; mine = (j == x) ? c : mine; }
        if (sum == G) break;
        __builtin_amdgcn_s_sleep(1);
        if ((++sp & 255u) == 0u) { if (xb_ld(&bar[XB_TMO])) break; if (sp > XB_SPIN_CAP) { atomicAdd(&bar[XB_TMO], 1u); break; } }
    }
    nloc = mine > 0u ? mine : 1u; nx = cnt > 0u ? cnt : 1u;
}

__device__ __forceinline__ void xcd_barrier(const XcdBarrier& b) {
    asm volatile("s_waitcnt vmcnt(0)" ::: "memory");
    __syncthreads();
    if (threadIdx.x == 0) {
        unsigned* bar = b.bar;
        __builtin_amdgcn_s_waitcnt(0);
        unsigned nloc = b.st[0], nx = b.st[1];
        if (nloc == 0u) { xcd_barrier_complete(bar, b.x, nloc, nx); b.st[0] = nloc; b.st[1] = nx; }
        const unsigned old = xb_add(&bar[XB_XSUB(b.x)], 1u);
        const unsigned gen = old / nloc;
        if (old + 1u == (gen + 1u) * nloc) {
            __builtin_amdgcn_fence(__ATOMIC_RELEASE, "agent");
            asm volatile("s_waitcnt vmcnt(0)" ::: "memory");
            const unsigned og = xb_add(&bar[XB_TOP], 1u);
            const unsigned tg = og / nx;
            if (og + 1u == (tg + 1u) * nx) xb_add(&bar[XB_TOPGEN], 1u);
            else XB_SPIN(xb_ld(&bar[XB_TOPGEN]) == tg, bar);
            __builtin_amdgcn_fence(__ATOMIC_ACQUIRE, "agent");
            xb_add(&bar[XB_XGEN(b.x)], 1u);
            asm volatile("s_waitcnt vmcnt(0)" ::: "memory");
        } else {
            XB_SPIN(xb_ld(&bar[XB_XGEN(b.x)]) == gen, bar);
            __builtin_amdgcn_fence(__ATOMIC_ACQUIRE, "agent");
            asm volatile("s_waitcnt vmcnt(0)" ::: "memory");
        }
    }
    __syncthreads();
}

#ifndef DUP_MASK
#define DUP_MASK 0
#endif
#ifndef PROLOGUE_IN_KERNEL
#define PROLOGUE_IN_KERNEL 1
#endif
#ifndef MIX_PARTS
#define MIX_PARTS 7
#endif
#ifndef PH_MASK
#define PH_MASK 0x7f
#endif
constexpr int NWAVES = 8;
constexpr int RING_BYTES = 131072;
constexpr int PTAB_OFF = RING_BYTES;
constexpr int MISC_OFF = PTAB_OFF + 8192;
constexpr int LDS_BYTES = 147456;
static_assert(pg8::STAGE_BYTES == RING_BYTES && MISC_OFF + 128 <= LDS_BYTES && (int)att::SHM_ATTN <= RING_BYTES, "LDS map");
constexpr int CW_TMO = 64;
constexpr int CW_FLAG = 16384;
constexpr int CW_BAR = 4096;
constexpr int N_PHASES = 3 + 5 * DEPTH;

struct MegaArgs { const float* in[26]; float* out; unsigned char* ws; int ph_lo, ph_hi, pad0, pad1; };

__device__ __forceinline__ void attn_a_unit(const Ptrs& P, size_t row0, const bf16_t* Kb, const bf16_t* Vb, int seq, int h, char* lds) {
    att::f32x16 o[4]; float rli[16];
    att::body<128, 1024, 256>(P.QA + row0 * 1024 + h * 128, Kb + (h >> 2) * 128, Vb + (h >> 2) * 128, seq, 0, lds, o, rli);
    int tid = threadIdx.x; asm volatile("" : "+v"(tid));
    const int wid = tid >> 6, lane = tid & 63, r32 = lane & 31, hi = lane >> 5;
    bf16_t* ob = P.MIX + (row0 + wid * 32) * D + h * 128 + r32;
#pragma unroll
    for (int r = 0; r < 16; ++r) { const int orow = att::crow(r, hi);
#pragma unroll
        for (int d0 = 0; d0 < 4; ++d0) ob[(size_t)orow * D + d0 * 32] = (bf16_t)f2bf(o[d0][r] * rli[r]); }
}
__device__ __forceinline__ void attn_b_unit(const Ptrs& P, size_t row0, const bf16_t* Kb, const bf16_t* Vb, int seq, int h, int l, char* lds) {
    float* slot = P.OTMP + (size_t)blockIdx.x * (2 * 256 * 128);
#pragma unroll 1
    for (int c = 0; c < 2; ++c) {
        att::f32x16 o[4]; float rli[16];
        att::body<64, 512, 512>(P.QB + row0 * 512 + h * 128 + c * 64, Kb + h * 128, Vb + h * 128, seq, c * 128, lds, o, rli);
        int tid = threadIdx.x; asm volatile("" : "+v"(tid));
        const int wid = tid >> 6, lane = tid & 63, r32 = lane & 31, hi = lane >> 5;
        float* o1 = slot + (size_t)c * (256 * 128) + (size_t)(wid * 32) * 128 + r32;
#pragma unroll
        for (int r = 0; r < 16; ++r) { const int orow = att::crow(r, hi);
#pragma unroll
            for (int d0 = 0; d0 < 4; ++d0) o1[(size_t)orow * 128 + d0 * 32] = o[d0][r] * rli[r]; }
    }
    asm volatile("s_waitcnt vmcnt(0)" ::: "memory"); __syncthreads();
    {   int tid = threadIdx.x; asm volatile("" : "+v"(tid));
        const int wid = tid >> 6, lane = tid & 63;
        const float lam = P.LAM[l]; const float post = 1.0f - lambda_init_of(l); const float g0 = P.subln[l * 128 + lane], g1 = P.subln[l * 128 + 64 + lane];
#pragma unroll 4
        for (int i = 0; i < 32; ++i) { const int row = wid * 32 + i; const float* a = slot + (size_t)row * 128 + lane; const float* b = a + 256 * 128;
            const float v0 = a[0] - lam * b[0], v1 = a[64] - lam * b[64];
            const float rinv = __builtin_amdgcn_rsqf(wave_sum(v0 * v0 + v1 * v1) * (1.0f / 128.0f) + EPS) * post;
            bf16_t* ob = P.MIX + (row0 + row) * D + 1024 + h * 128 + lane;
            ob[0] = (bf16_t)f2bf(v0 * rinv * g0); ob[64] = (bf16_t)f2bf(v1 * rinv * g1); }
    }
    __syncthreads();
}

__device__ __forceinline__ void x0_row(const float* __restrict__ xrow, float* __restrict__ xcopy, const float* __restrict__ g, const float* __restrict__ scale, bf16_t* __restrict__ xa, float* __restrict__ ssrow, int lane) {
    f32x4 v[8]; float ss = 0.f;
#pragma unroll
    for (int j = 0; j < 8; ++j) { v[j] = *(const f32x4*)(xrow + lane * 4 + 256 * j); ss += (v[j][0] * v[j][0] + v[j][1] * v[j][1]) + (v[j][2] * v[j][2] + v[j][3] * v[j][3]); }
#pragma unroll
    for (int j = 0; j < 8; ++j) *(f32x4*)(xcopy + lane * 4 + 256 * j) = v[j];
    ss = wave_sum(ss); if (lane < 8) ssrow[lane] = (lane == 0) ? ss : 0.f;
#pragma unroll
    for (int j = 0; j < 8; ++j) { const int c = lane * 4 + 256 * j; const f32x4 o = v[j] * (*(const f32x4*)(g + c)) * (*(const f32x4*)(scale + c) + 1.0f);
        *(u32x2*)(xa + c) = (u32x2){pk2(o[0], o[1]), pk2(o[2], o[3])}; }
}
__device__ __forceinline__ void bias_row(const bf16_t* __restrict__ btrow, const float* sh, float* __restrict__ bias_r, int bias_stride, int lane) {
    f32x4 wl[4], wh[4];
#pragma unroll
    for (int j = 0; j < 4; ++j) { const u32x4 q = *(const u32x4*)(btrow + lane * 8 + 512 * j);
        wl[j] = (f32x4){__builtin_bit_cast(float, q.x << 16), __builtin_bit_cast(float, q.x & 0xffff0000u), __builtin_bit_cast(float, q.y << 16), __builtin_bit_cast(float, q.y & 0xffff0000u)};
        wh[j] = (f32x4){__builtin_bit_cast(float, q.z << 16), __builtin_bit_cast(float, q.z & 0xffff0000u), __builtin_bit_cast(float, q.w << 16), __builtin_bit_cast(float, q.w & 0xffff0000u)}; }
#pragma unroll 1
    for (int c = 0; c < NCOND; ++c) { f32x4 s4 = (f32x4){0.f, 0.f, 0.f, 0.f};
#pragma unroll
        for (int j = 0; j < 4; ++j) { const f32x4 a = *(const f32x4*)(sh + c * D + lane * 8 + 512 * j), b = *(const f32x4*)(sh + c * D + lane * 8 + 512 * j + 4); s4 = s4 + wl[j] * a + wh[j] * b; }
        float s = wave_sum((s4[0] + s4[1]) + (s4[2] + s4[3])); if (lane == 0) bias_r[(size_t)c * bias_stride] = s; }
}

__global__ void __launch_bounds__(NWAVES * 64, 2) mega(MegaArgs args) {
    extern __shared__ __attribute__((aligned(16))) unsigned char lds[];
    LAS unsigned char* L = (LAS unsigned char*)lds;
    volatile LAS unsigned* MISC = (volatile LAS unsigned*)(L + MISC_OFF);
    const int G = gridDim.x, bx = blockIdx.x;
    gu32* ctl = (gu32*)(args.ws + WS_CTL);
    for (int u = threadIdx.x; u < (LDS_BYTES - MISC_OFF) / 4; u += NWAVES * 64) ((LAS unsigned*)(L + MISC_OFF))[u] = 0u;
    __syncthreads();
    XcdBarrier bar = xcd_barrier_post((unsigned*)(ctl + CW_BAR), MISC + 8);
    const int lo = args.ph_lo, hi = args.ph_hi;
#define IN(k) (lo <= (k) && (k) < hi)
#define PHASE_P int tid = threadIdx.x; asm volatile("" : "+v"(tid)); const int lane = tid & 63, wave = __builtin_amdgcn_readfirstlane(tid >> 6); (void)lane; (void)wave; unsigned char* wsp_ = args.ws; asm volatile("" : "+s"(wsp_)); const Ptrs P = make_ptrs_hd(args.in, args.out, wsp_); const float* mod_l = P.MOD + (size_t)l * NCOND * NMOD; (void)mod_l; float* const SS = (float*)(wsp_ + WS_SS); (void)SS
#define SEAM(k) do { if (IN(k) && IN((k) + 1)) xcd_barrier(bar); } while (0)
    if (IN(0)) {
        const int l = 0; PHASE_P;
        const int t = tid & 255, hf = __builtin_amdgcn_readfirstlane(tid >> 8), hw = bx * 2 + hf, NHW = 2 * G;
        float* sm = (float*)(lds + hf * 40960);
        for (int v0 = 0; v0 < 192; v0 += NHW) { const int vb = v0 + hw; prep_ada_vb(P.c, P.c_ctx, P.w_ada, P.b_ada, P.MOD, vb % 48, vb / 48, t, (float(*)[128])sm, vb < 192); }
#define TR_LOOP(W, K, LDW, WST, BT, BST, MODE, NX, NY) for (int v0 = 0; v0 < (NX) * (NY) * DEPTH; v0 += NHW) { const int vb = v0 + hw; \
            prep_transpose_vb(W, K, LDW, WST, BT, BST, MODE, vb % (NX), (vb / (NX)) % (NY), vb / ((NX) * (NY)), t, (float(*)[129])sm, vb < (NX) * (NY) * DEPTH); }
        TR_LOOP(P.w_in, D, N_INRAW, (size_t)D * N_INRAW, P.BT_IN, (size_t)N_IN * D, 1, D / 32, 3072 / 128)
        TR_LOOP(P.w_out, D, D, (size_t)D * D, P.BT_OUT, (size_t)D * D, 0, D / 32, D / 128)
        TR_LOOP(P.w_mi, D, DFF, (size_t)D * DFF, P.BT_MI, (size_t)DFF * D, 0, D / 32, DFF / 128)
        TR_LOOP(P.w_mo, DFF, D, (size_t)DFF * D, P.BT_MO, (size_t)D * DFF, 0, DFF / 32, D / 128)
#undef TR_LOOP
        {   float* ct = sm; float* st = sm + 128;
            if (t < 128) { float s, c; sincospif((float)t / 64.0f, &s, &c); ct[t] = c; st[t] = s; }
            __syncthreads();
            for (size_t idx = (size_t)hw * 256 + t; idx < (size_t)DEPTH * 4 * 2 * 128 * 128; idx += (size_t)NHW * 256) prep_G_idx(P.w_fourier, P.G, idx, ct, st);
            __syncthreads(); }
        prep_tables_gs(P.ROPE, P.DFT_L, P.DFT_C, P.LAM, P.lq1, P.lk1, P.lq2, P.lk2, (float*)(P.ws + WS_GAIN), P.qn_a, P.kn_a, P.qn_b, P.kn_b, (size_t)bx * 512 + tid, (size_t)G * 512);
        prep_cache_gs(P.cak, P.cav, P.cdk, P.cdv, P.KAL, P.VAL, P.KBL, P.VBL, (size_t)bx * 512 + tid, (size_t)G * 512);
    }
    SEAM(0);
    if (IN(1)) {
        const int l = 0; PHASE_P;
        const int gw = bx * NWAVES + wave, NGW = G * NWAVES;
        for (int row = gw; row < M_ALL; row += NGW) {
            const float* xrow = row < M_CTX ? P.x_prompt + (size_t)row * D : P.x_sample + (size_t)(row - M_CTX) * D;
            x0_row(xrow, P.out + (size_t)row * D, P.g_mix, mod_l + (size_t)cond_of_row(row) * NMOD + D, P.H + (size_t)row * D, SS + (size_t)row * 8, lane);
        }
        const int t = tid & 255, hf = __builtin_amdgcn_readfirstlane(tid >> 8), hw = bx * 2 + hf, NHW = 2 * G;
        float* sm = (float*)(lds + hf * 40960);
        for (int v0 = 0; v0 < 32 * 4 * DEPTH; v0 += NHW) { const int vb = v0 + hw; prep_fold_vb(P.w_in, P.G, P.BT_IN, vb & 31, (vb >> 5) & 3, vb >> 7, t, (float(*)[132])sm, vb < 32 * 4 * DEPTH); }
    }
    SEAM(1);
    if (IN(2)) {
        const int l = 0; PHASE_P;
        float* sh = (float*)lds;
        for (int item = bx; item < 8 * 32; item += G) {
            const int combo = item & 7, sub = item >> 3, ll = combo >> 1, which = combo & 1;
            const float* shsrc = P.MOD + (size_t)ll * NCOND * NMOD + (size_t)(which ? 3 : 0) * D;
            for (int i = tid; i < NCOND * D / 4; i += NWAVES * 64) { const int c = i / (D / 4), k4 = i % (D / 4); *(f32x4*)(sh + c * D + k4 * 4) = *(const f32x4*)(shsrc + (size_t)c * NMOD + k4 * 4); }
            __syncthreads();
            const int nrows = which ? DFF : N_IN, rps = nrows / 32;
            const bf16_t* bt = which ? P.BT_MI + (size_t)ll * DFF * D : P.BT_IN + (size_t)ll * N_IN * D;
            float* bo = which ? (float*)(P.ws + WS_BIAS_MI) + (size_t)ll * NCOND * DFF : (float*)(P.ws + WS_BIAS_IN) + (size_t)ll * NCOND * N_IN;
            for (int r = sub * rps + wave; r < (sub + 1) * rps; r += NWAVES) bias_row(bt + (size_t)r * D, sh, bo + r, nrows, lane);
            __syncthreads();
        }
    }
    SEAM(2);
#pragma unroll 1
    for (int l = 0; l < DEPTH; ++l) {
        const int pb = 3 + 5 * l;
        if (IN(pb + 0)) { PHASE_P;
            pg8::Gemm g{P.H, P.BT_IN + (size_t)l * N_IN * D, M_ALL, N_IN, D, D}; pg8::StaticOrder S; S.init(M_ALL, N_IN, G, bx);
            pg8::EpiIn E{l, P.ws, P.out, SS + (size_t)(2 * l) * M_ALL * 8, (const float*)(P.ws + WS_BIAS_IN) + (size_t)l * NCOND * N_IN};
            pg8::gemm_phase<pg8::EpiIn, pg8::StaticOrder, true, true>(L, g, S, E);
        }
        SEAM(pb + 0);
        if (IN(pb + 1)) { PHASE_P;
            char* al = (char*)lds;
            for (int id = bx; id < 256; id += G) { const int b = id >> 5, h = (id >> 3) & 3, qb = id & 7; const size_t kvrow = (size_t)(l * NB_LAT + b) * S_LAT;
                attn_b_unit(P, (size_t)M_CTX + (size_t)b * T_LAT + qb * 256, P.KBL + kvrow * 512, P.VBL + kvrow * 512, S_LAT, h, l, al); }
            for (int id = bx; id < 64; id += G) { const int b = id >> 2, h = id & 3;
                attn_b_unit(P, (size_t)b * T_CTX, P.KBC + (size_t)b * T_CTX * 512, P.VBC + (size_t)b * T_CTX * 512, T_CTX, h, l, al); }
            {   pg8::Gemm g{P.DFT_L, P.YTL, T_LAT, 512, 4096, 4096}; pg8::DftOrder S{1, 0, 128, G, bx}; pg8::EpiBf16Out E{P.MIX, D, 1536};
                pg8::gemm_phase<pg8::EpiBf16Out, pg8::DftOrder, true, true>(L, g, S, E); }
            {   pg8::Gemm g{P.DFT_C, P.YTC, T_CTX, 512, 512, 512}; pg8::DftOrder S{0, 64, 32, G, bx}; pg8::EpiBf16Out E{P.MIX, D, 1536};
                pg8::gemm_phase<pg8::EpiBf16Out, pg8::DftOrder, true, true>(L, g, S, E); }
            {   int first, cnt, stride;
                if (G == 256) { if (bx < 128) { first = bx; cnt = 1; stride = 1; } else { first = 128 + 3 * (bx - 128); cnt = 3; stride = 1; } }
                else { first = bx; cnt = (512 - bx + G - 1) / G; stride = G; }
                for (int k = 0; k < cnt; ++k) { const int id = first + k * stride; if (id >= 512) break; const int b = id >> 6, h = (id >> 3) & 7, qb = id & 7; const size_t kvrow = (size_t)(l * NB_LAT + b) * S_LAT;
                    attn_a_unit(P, (size_t)M_CTX + (size_t)b * T_LAT + qb * 256, P.KAL + kvrow * 256, P.VAL + kvrow * 256, S_LAT, h, al); } }
            for (int id = bx; id < 128; id += G) { const int b = id >> 3, h = id & 7;
                attn_a_unit(P, (size_t)b * T_CTX, P.KAC + (size_t)b * T_CTX * 256, P.VAC + (size_t)b * T_CTX * 256, T_CTX, h, al); }
        }
        SEAM(pb + 1);
        if (IN(pb + 2)) { PHASE_P;
            const pg8::ResNext nx{P.H, P.g_mlp + (size_t)l * D, mod_l + 4 * D, SS + (size_t)(2 * l + 1) * M_ALL * 8};
            pg8::Gemm g{P.MIX, P.BT_OUT + (size_t)l * D * D, M_ALL, D, D, D}; pg8::StaticOrder S; S.init(M_ALL, D, G, bx); if (G == 256) S.rounds = 2;
            pg8::EpiRes E{P.out, mod_l + 2 * D, nx};
            pg8::gemm_phase<pg8::EpiRes, pg8::StaticOrder, true, true>(L, g, S, E);
            {   pg8::Gemm g2{P.MIX, P.BT_OUT + (size_t)l * D * D, M_ALL, D, D / 2, D}; pg8::SplitOrder S2; S2.init(M_ALL, D, G, bx);
                pg8::EpiResSplit E2{E, P.OTMP, (unsigned*)(ctl + CW_FLAG) + (size_t)(l * 2 + 0) * 128 * 64, (unsigned*)(ctl + CW_TMO)};
                pg8::gemm_phase<pg8::EpiResSplit, pg8::SplitOrder, true, true>(L, g2, S2, E2); }
        }
        SEAM(pb + 2);
        if (IN(pb + 3)) { PHASE_P;
            pg8::Gemm g{P.H, P.BT_MI + (size_t)l * DFF * D, M_ALL, DFF, D, D}; pg8::StaticOrder S; S.init(M_ALL, DFF, G, bx);
            pg8::EpiRelu2 E{P.HID, DFF, SS + (size_t)(2 * l + 1) * M_ALL * 8, (const float*)(P.ws + WS_BIAS_MI) + (size_t)l * NCOND * DFF};
            pg8::gemm_phase<pg8::EpiRelu2, pg8::StaticOrder, true, true>(L, g, S, E);
        }
        SEAM(pb + 3);
        if (IN(pb + 4)) { PHASE_P;
            const bool more = l + 1 < DEPTH;
            const pg8::ResNext nx{more ? P.H : nullptr, P.g_mix + (size_t)(more ? l + 1 : l) * D, P.MOD + (size_t)(more ? l + 1 : l) * NCOND * NMOD + D, SS + (size_t)(more ? 2 * l + 2 : 0) * M_ALL * 8};
            pg8::Gemm g{P.HID, P.BT_MO + (size_t)l * D * DFF, M_ALL, D, DFF, DFF}; pg8::StaticOrder S; S.init(M_ALL, D, G, bx); if (G == 256) S.rounds = 2;
            pg8::EpiRes E{P.out, mod_l + 5 * D, nx};
            pg8::gemm_phase<pg8::EpiRes, pg8::StaticOrder, true, true>(L, g, S, E);
            {   pg8::Gemm g2{P.HID, P.BT_MO + (size_t)l * D * DFF, M_ALL, D, DFF / 2, DFF}; pg8::SplitOrder S2; S2.init(M_ALL, D, G, bx);
                pg8::EpiResSplit E2{E, P.OTMP, (unsigned*)(ctl + CW_FLAG) + (size_t)(l * 2 + 1) * 128 * 64, (unsigned*)(ctl + CW_TMO)};
                pg8::gemm_phase<pg8::EpiResSplit, pg8::SplitOrder, true, true>(L, g2, S2, E2); }
        }
        SEAM(pb + 4);
    }
#undef IN
#undef PHASE_P
#undef SEAM
}
#ifndef FAST_MASK
#define FAST_MASK 0x7f
#endif
#ifndef ONE_LAUNCH
#define ONE_LAUNCH 1
#endif
extern "C" void kernel_launch(void* const* d_in, const int* in_sizes, int n_in, void* d_out, int out_size, void* d_ws, size_t ws_size, hipStream_t stream) {
    if (n_in != 26 || (size_t)out_size != OUT_END || ws_size < WS_END) { fprintf(stderr, "kernel_launch: unexpected shapes (n_in %d out %d ws %zu)\n", n_in, out_size, ws_size); return; }
    static int grid = 0;
    if (grid == 0) {
        int dev = 0, cus = 0;
        if (hipGetDevice(&dev) != hipSuccess || hipDeviceGetAttribute(&cus, hipDeviceAttributeMultiprocessorCount, dev) != hipSuccess) { grid = -1; return; }
        if (hipFuncSetAttribute((const void*)mega, hipFuncAttributeMaxDynamicSharedMemorySize, LDS_BYTES) != hipSuccess) { grid = -1; return; }
        int per_cu = 0; (void)hipOccupancyMaxActiveBlocksPerMultiprocessor(&per_cu, (const void*)mega, NWAVES * 64, LDS_BYTES); (void)hipGetLastError();
        grid = cus;
    }
    if (grid < 0) return;
    const Ptrs p = make_ptrs(d_in, d_out, d_ws);
    (void)hipMemsetAsync((char*)d_ws + WS_CTL, 0, 1 * MiB, stream);
    MegaArgs a{}; for (int i = 0; i < 26; ++i) a.in[i] = (const float*)d_in[i]; a.out = (float*)d_out; a.ws = (unsigned char*)d_ws;
    a.ph_lo = 0; a.ph_hi = N_PHASES;
    hipLaunchKernelGGL(mega, dim3(grid), dim3(NWAVES * 64), LDS_BYTES, stream, a);
}
```

```cpp
#include <hip/hip_runtime.h>
#include <stdint.h>
#include <stdio.h>

typedef unsigned short bf16_t;
typedef short bf16x8 __attribute__((ext_vector_type(8)));
typedef float f32x4 __attribute__((ext_vector_type(4)));
typedef float f32x2 __attribute__((ext_vector_type(2)));
typedef unsigned u32x4 __attribute__((ext_vector_type(4)));
typedef unsigned u32x2 __attribute__((ext_vector_type(2)));

constexpr int D = 2048, NB_CTX = 16, T_CTX = 256, NB_LAT = 8, T_LAT = 2048, DEPTH = 4, PAST = 512;
constexpr int M_CTX = NB_CTX * T_CTX;
constexpr int M_LAT = NB_LAT * T_LAT;
constexpr int M_ALL = M_CTX + M_LAT;
constexpr int S_LAT = T_LAT + PAST;
constexpr int N_IN = 4096;
constexpr int N_INRAW = 3584;
constexpr int DFF = 8192;
constexpr int NMOD = 6 * D;
constexpr int NCOND = 9;
constexpr float EPS = 1e-6f;
constexpr size_t OUT_X = 0;
constexpr size_t OUT_SAK = (size_t)M_ALL * D;
constexpr size_t OUT_SAV = OUT_SAK + (size_t)NB_CTX * DEPTH * T_CTX * 256;
constexpr size_t OUT_SDK = OUT_SAV + (size_t)NB_CTX * DEPTH * T_CTX * 256;
constexpr size_t OUT_SDV = OUT_SDK + (size_t)NB_CTX * DEPTH * T_CTX * 512;
constexpr size_t OUT_END = OUT_SDV + (size_t)NB_CTX * DEPTH * T_CTX * 512;

constexpr size_t MiB = (size_t)1 << 20;
constexpr size_t WS_CTL = 0;
constexpr size_t WS_BT_IN = 1 * MiB;
constexpr size_t WS_BT_OUT = 65 * MiB;
constexpr size_t WS_BT_MI = 97 * MiB;
constexpr size_t WS_BT_MO = 225 * MiB;
constexpr size_t WS_DFT_L = 353 * MiB;
constexpr size_t WS_DFT_C = 369 * MiB;
constexpr size_t WS_MOD = 370 * MiB;
constexpr size_t WS_ROPE = 372 * MiB;
constexpr size_t WS_G = 374 * MiB;
constexpr size_t WS_LAM = 376 * MiB;
constexpr size_t WS_GAIN = WS_LAM + 4096;
constexpr size_t WS_H = 377 * MiB;
constexpr size_t WS_QA = 457 * MiB;
constexpr size_t WS_KAL = 497 * MiB;
constexpr size_t WS_VAL = 537 * MiB;
constexpr size_t WS_KAC = 577 * MiB;
constexpr size_t WS_VAC = 579 * MiB;
constexpr size_t WS_QB = 581 * MiB;
constexpr size_t WS_KBL = 601 * MiB;
constexpr size_t WS_VBL = 681 * MiB;
constexpr size_t WS_KBC = 761 * MiB;
constexpr size_t WS_VBC = 765 * MiB;
constexpr size_t WS_YTL = 769 * MiB;
constexpr size_t WS_YTC = 801 * MiB;
constexpr size_t WS_MIX = 809 * MiB;
constexpr size_t WS_HID = 889 * MiB;
constexpr size_t WS_OTMP = 1209 * MiB;
constexpr size_t WS_SS = 1273 * MiB;
constexpr size_t WS_BIAS_IN = 1279 * MiB;
constexpr size_t WS_BIAS_MI = 1280 * MiB;
constexpr size_t WS_END = 1282 * MiB;

__host__ __device__ __forceinline__ int map8(int p) { return (p & 96) | (((p >> 2) & 3) << 3) | (((p >> 4) & 1) << 2) | (p & 3); }
__host__ __device__ __forceinline__ int map8inv(int s) { return (s & 96) | (((s >> 2) & 1) << 4) | (((s >> 3) & 3) << 2) | (s & 3); }
__host__ __device__ __forceinline__ int sigma128(int s) { const int u = s >> 3, n = (s >> 2) & 1, e = s & 3; return (u < 8 ? 0 : 64) + 32 * n + 4 * (u & 7) + e; }
__host__ __device__ __forceinline__ int sigma64(int s) { const int u = s >> 3, n = (s >> 2) & 1, e = s & 3; return (u < 4 ? 0 : 32) + 16 * n + 4 * (u & 3) + e; }
__host__ __device__ __forceinline__ int in_logical_col(int t, int sc) {
    const int half = sc & 128, s = sc & 127;
    int l;
    if (t <= 4) l = sigma128(s);
    else if (t == 5 || t >= 10) l = s;
    else l = (s & 64) + sigma64(s & 63);
    return t * 256 + half + l;
}
__device__ __forceinline__ unsigned f2bf(float f) { unsigned u = __builtin_bit_cast(unsigned, f); return (u + 0x7fffu + ((u >> 16) & 1u)) >> 16; }
__device__ __forceinline__ float bf2f(unsigned short h) { return __builtin_bit_cast(float, (unsigned)h << 16); }
__device__ __forceinline__ unsigned pk2(float lo, float hi) { return f2bf(lo) | (f2bf(hi) << 16); }
__device__ __forceinline__ int cond_of_row(int row) { return row < M_CTX ? 0 : 1 + ((row - M_CTX) >> 11); }
__host__ __device__ __forceinline__ float lambda_init_of(int l) { return 0.8f - 0.6f * expf(-0.3f * (float)l); }

__device__ __forceinline__ void prep_transpose_vb(const float* __restrict__ W, int K, int ldw, size_t w_layer_stride, bf16_t* __restrict__ Bt, size_t bt_layer_stride, int mode, int vbx, int vby, int vbz, int t, float (*tile)[129], bool act) {
    const int k0 = vbx * 32, grp = vby, l = vbz;
    const float* Wl = W + (size_t)l * w_layer_stride; bf16_t* Bl = Bt + (size_t)l * bt_layer_stride;
    const int c0 = grp * 128;
    if (act) {   const int kk = t >> 3;
#pragma unroll
        for (int i = 0; i < 4; ++i) { const int c = ((t & 7) + 8 * i) * 4; const f32x4 v = *(const f32x4*)(Wl + (size_t)(k0 + kk) * ldw + c0 + c);
            tile[kk][c] = v[0]; tile[kk][c + 1] = v[1]; tile[kk][c + 2] = v[2]; tile[kk][c + 3] = v[3]; } }
    __syncthreads();
    if (act) {
    const int p = t >> 1, kh = (t & 1) * 16;
    int lc;
    if (mode == 0) lc = map8(p);
    else { const int tl = grp >> 1, half = (grp & 1) * 128; lc = in_logical_col(tl, half + map8(p)) - tl * 256 - half; }
    unsigned w[8];
#pragma unroll
    for (int j = 0; j < 8; ++j) w[j] = pk2(tile[kh + 2 * j][lc], tile[kh + 2 * j + 1][lc]);
    bf16_t* dst = Bl + (size_t)(c0 + p) * K + k0 + kh;
    *(u32x4*)dst = (u32x4){w[0], w[1], w[2], w[3]}; *(u32x4*)(dst + 8) = (u32x4){w[4], w[5], w[6], w[7]};
    }
    __syncthreads();
}
__global__ __launch_bounds__(256) void k_prep_transpose(const float* __restrict__ W, int K, int ldw, size_t w_layer_stride, bf16_t* __restrict__ Bt, size_t bt_layer_stride, int mode) {
    __shared__ float tile[32][129];
    prep_transpose_vb(W, K, ldw, w_layer_stride, Bt, bt_layer_stride, mode, blockIdx.x, blockIdx.y, blockIdx.z, threadIdx.x, tile, true);
}

__device__ __forceinline__ void prep_G_idx(const float* __restrict__ wf, float* __restrict__ G, size_t idx, const float* ct, const float* st) {
    const int d = idx & 127, c = (idx >> 7) & 127, cs = (idx >> 14) & 1, g = (idx >> 15) & 3, l = (int)(idx >> 17);
    const float* Wg = wf + ((size_t)(l * 4 + g) * 128) * 128;
    float acc = 0.f;
    for (int m = 0; m < 128; ++m) { const float tr = cs ? st[(m * c) & 127] : ct[(m * c) & 127]; acc += tr * Wg[(size_t)m * 128 + d]; }
    G[idx] = acc * 0.088388347648318440f;
}
__global__ __launch_bounds__(256) void k_prep_G(const float* __restrict__ wf, float* __restrict__ G) {
    __shared__ float ct[128], st[128];
    if (threadIdx.x < 128) { float s, c; sincospif((float)threadIdx.x / 64.0f, &s, &c); ct[threadIdx.x] = c; st[threadIdx.x] = s; }
    __syncthreads();
    prep_G_idx(wf, G, (size_t)blockIdx.x * 256 + threadIdx.x, ct, st);
}
__device__ __forceinline__ void prep_fold_vb(const float* __restrict__ w_in, const float* __restrict__ G, bf16_t* __restrict__ Bt_in, int vbx, int vby, int vbz, int t, float (*wt)[132], bool act) {
    const int j0 = vbx * 64, g = vby, l = vbz;
    const float* Wl = w_in + (size_t)l * D * N_INRAW;
    if (act) for (int i = t; i < 64 * 32; i += 256) { const int j = i >> 5, c4 = (i & 31) * 4; const f32x4 v = *(const f32x4*)(Wl + (size_t)(j0 + j) * N_INRAW + 3072 + 128 * g + c4);
        wt[j][c4] = v[0]; wt[j][c4 + 1] = v[1]; wt[j][c4 + 2] = v[2]; wt[j][c4 + 3] = v[3]; }
    __syncthreads();
    if (act) {
    const int cs = t >> 7, d = t & 127;
    const float* Gp = G + ((size_t)((l * 4 + g) * 2 + cs) * 128) * 128 + d;
    const int nl = cs * 512 + g * 128 + d;
    const int sc = nl & 255, pos = (nl & ~255) + (sc & 128) + map8inv(sc & 127);
    bf16_t* dst = Bt_in + (size_t)l * N_IN * D + (size_t)(3072 + pos) * D + j0;
    for (int jb = 0; jb < 64; jb += 8) {
        float a0 = 0, a1 = 0, a2 = 0, a3 = 0, a4 = 0, a5 = 0, a6 = 0, a7 = 0;
        for (int c = 0; c < 128; ++c) { const float gv = Gp[(size_t)c * 128];
            a0 += wt[jb + 0][c] * gv; a1 += wt[jb + 1][c] * gv; a2 += wt[jb + 2][c] * gv; a3 += wt[jb + 3][c] * gv;
            a4 += wt[jb + 4][c] * gv; a5 += wt[jb + 5][c] * gv; a6 += wt[jb + 6][c] * gv; a7 += wt[jb + 7][c] * gv; }
        *(u32x4*)(dst + jb) = (u32x4){pk2(a0, a1), pk2(a2, a3), pk2(a4, a5), pk2(a6, a7)};
    }
    }
    __syncthreads();
}
__global__ __launch_bounds__(256) void k_prep_fold(const float* __restrict__ w_in, const float* __restrict__ G, bf16_t* __restrict__ Bt_in) {
    __shared__ float wt[64][132];
    prep_fold_vb(w_in, G, Bt_in, blockIdx.x, blockIdx.y, blockIdx.z, threadIdx.x, wt, true);
}
__device__ __forceinline__ void prep_ada_vb(const float* __restrict__ c, const float* __restrict__ c_ctx, const float* __restrict__ w_ada, const float* __restrict__ b_ada, float* __restrict__ mod, int vbx, int vby, int t, float (*sv)[128], bool act) {
    const int j = vbx * 256 + t, l = vby;
    const float* W = w_ada + (size_t)l * D * NMOD + j;
    float acc[NCOND];
#pragma unroll
    for (int q = 0; q < NCOND; ++q) acc[q] = 0.f;
    for (int k0 = 0; k0 < D; k0 += 128) {
        __syncthreads();
        if (act) for (int i = t; i < NCOND * 128; i += 256) { const int q = i >> 7, kk = i & 127; const float v = (q == 0) ? c_ctx[k0 + kk] : c[(size_t)(q - 1) * D + k0 + kk]; sv[q][kk] = v / (1.f + expf(-v)); }
        __syncthreads();
        if (act) for (int kk = 0; kk < 128; ++kk) { const float w = W[(size_t)(k0 + kk) * NMOD];
#pragma unroll
            for (int q = 0; q < NCOND; ++q) acc[q] += sv[q][kk] * w; }
    }
    if (act) { const float bb = b_ada[(size_t)l * NMOD + j];
#pragma unroll
        for (int q = 0; q < NCOND; ++q) mod[((size_t)l * NCOND + q) * NMOD + j] = acc[q] + bb; }
    __syncthreads();
}
__global__ __launch_bounds__(256) void k_prep_ada(const float* __restrict__ c, const float* __restrict__ c_ctx, const float* __restrict__ w_ada, const float* __restrict__ b_ada, float* __restrict__ mod) {
    __shared__ float sv[NCOND][128];
    prep_ada_vb(c, c_ctx, w_ada, b_ada, mod, blockIdx.x, blockIdx.y, threadIdx.x, sv, true);
}
__device__ __forceinline__ void prep_tables_gs(float* __restrict__ rope, bf16_t* __restrict__ dftl, bf16_t* __restrict__ dftc, float* __restrict__ lam,
                                                     const float* lq1, const float* lk1, const float* lq2, const float* lk2,
                                                     float* __restrict__ gain, const float* qna, const float* kna, const float* qnb, const float* knb, size_t gid, size_t nth) {
    float* cosA = rope; float* sinA = rope + 2048 * 64; float* cosB = rope + 2 * 2048 * 64; float* sinB = cosB + 2048 * 32;
    for (size_t i = gid; i < (size_t)2048 * 64; i += nth) { const int tk = (int)(i >> 6), f = (int)(i & 63); const int fi = f & 31; const float pos = (f < 32) ? (float)(tk >> 6) : (float)(tk & 63);
        const float inv = powf(10000.0f, -(float)fi / 32.0f); const float ang = pos * inv; cosA[i] = cosf(ang); sinA[i] = sinf(ang); }
    for (size_t i = gid; i < (size_t)2048 * 32; i += nth) { const int tk = (int)(i >> 5), f = (int)(i & 31); const int fi = f & 15; const float pos = (f < 16) ? (float)(tk >> 6) : (float)(tk & 63);
        const float inv = powf(10000.0f, -(float)fi / 16.0f); const float ang = pos * inv; cosB[i] = cosf(ang); sinB[i] = sinf(ang); }
    for (size_t i = gid; i < (size_t)2048 * 4096; i += nth) { const int k = (int)(i >> 12), s = (int)(i & 4095); const int tt = s & 2047; const int ph = (k * tt) & 2047;
        float sn, cs; sincospif((float)ph / 1024.0f, &sn, &cs); const float v = (s < 2048 ? cs : -sn) * 0.022097086912079608f; dftl[i] = (bf16_t)f2bf(v); }
    for (size_t i = gid; i < (size_t)256 * 512; i += nth) { const int k = (int)(i >> 9), s = (int)(i & 511); const int tt = s & 255; const int ph = (k * tt) & 255;
        float sn, cs; sincospif((float)ph / 128.0f, &sn, &cs); const float v = (s < 256 ? cs : -sn) * 0.0625f; dftc[i] = (bf16_t)f2bf(v); }
    if (gid < DEPTH * 384) { const int l = (int)gid / 384, i = (int)gid % 384; gain[gid] = i < 128 ? qna[l * 128 + i] : i < 256 ? kna[l * 128 + i - 128] : i < 320 ? qnb[l * 64 + i - 256] : knb[l * 64 + i - 320]; }
    if (gid < DEPTH) { const int l = (int)gid; float s1 = 0.f, s2 = 0.f; for (int i = 0; i < 64; ++i) { s1 += lq1[l * 64 + i] * lk1[l * 64 + i]; s2 += lq2[l * 64 + i] * lk2[l * 64 + i]; }
        lam[l] = expf(s1) - expf(s2) + lambda_init_of(l); }
}
__global__ __launch_bounds__(256) void k_prep_tables(float* __restrict__ rope, bf16_t* __restrict__ dftl, bf16_t* __restrict__ dftc, float* __restrict__ lam,
                                                     const float* lq1, const float* lk1, const float* lq2, const float* lk2,
                                                     float* __restrict__ gain, const float* qna, const float* kna, const float* qnb, const float* knb) {
    prep_tables_gs(rope, dftl, dftc, lam, lq1, lk1, lq2, lk2, gain, qna, kna, qnb, knb, (size_t)blockIdx.x * 256 + threadIdx.x, (size_t)gridDim.x * 256);
}
__device__ __forceinline__ void prep_cache_gs(const float* __restrict__ cak, const float* __restrict__ cav, const float* __restrict__ cdk, const float* __restrict__ cdv,
                                                    bf16_t* __restrict__ KAL, bf16_t* __restrict__ VAL, bf16_t* __restrict__ KBL, bf16_t* __restrict__ VBL, size_t gid, size_t nth) {
    const size_t nrow = (size_t)NB_LAT * DEPTH * PAST;
    for (size_t i = gid; i < nrow * 32; i += nth) { const int it = (int)(i & 31); const size_t r = i >> 5; const int p = (int)(r & 511), l = (int)((r >> 9) & 3), b = (int)(r >> 11);
        const int head = it >> 4, s0 = (it & 15) * 8;
        const float* srck = cak + r * 256 + head * 128; const float* srcv = cav + r * 256 + head * 128;
        const int la = sigma128(s0), lb = sigma128(s0 + 4);
        const f32x4 ka = *(const f32x4*)(srck + la), kb = *(const f32x4*)(srck + lb), va = *(const f32x4*)(srcv + s0), vb = *(const f32x4*)(srcv + s0 + 4);
        const size_t orow = ((size_t)(l * NB_LAT + b) * S_LAT + T_LAT + p) * 256 + head * 128 + s0;
        *(u32x4*)(KAL + orow) = (u32x4){pk2(ka[0], ka[1]), pk2(ka[2], ka[3]), pk2(kb[0], kb[1]), pk2(kb[2], kb[3])};
        *(u32x4*)(VAL + orow) = (u32x4){pk2(va[0], va[1]), pk2(va[2], va[3]), pk2(vb[0], vb[1]), pk2(vb[2], vb[3])}; }
    for (size_t i = gid; i < nrow * 64; i += nth) { const int it = (int)(i & 63); const size_t r = i >> 6; const int p = (int)(r & 511), l = (int)((r >> 9) & 3), b = (int)(r >> 11);
        const int grp = it >> 3, s0 = (it & 7) * 8;
        const float* srck = cdk + r * 512 + grp * 64; const float* srcv = cdv + r * 512 + it * 8;
        const int la = sigma64(s0), lb = sigma64(s0 + 4);
        const f32x4 ka = *(const f32x4*)(srck + la), kb = *(const f32x4*)(srck + lb), va = *(const f32x4*)(srcv), vb = *(const f32x4*)(srcv + 4);
        const size_t orow = ((size_t)(l * NB_LAT + b) * S_LAT + T_LAT + p) * 512 + it * 8;
        *(u32x4*)(KBL + orow) = (u32x4){pk2(ka[0], ka[1]), pk2(ka[2], ka[3]), pk2(kb[0], kb[1]), pk2(kb[2], kb[3])};
        *(u32x4*)(VBL + orow) = (u32x4){pk2(va[0], va[1]), pk2(va[2], va[3]), pk2(vb[0], vb[1]), pk2(vb[2], vb[3])}; }
}
__global__ __launch_bounds__(256) void k_prep_cache(const float* __restrict__ cak, const float* __restrict__ cav, const float* __restrict__ cdk, const float* __restrict__ cdv,
                                                    bf16_t* __restrict__ KAL, bf16_t* __restrict__ VAL, bf16_t* __restrict__ KBL, bf16_t* __restrict__ VBL) {
    prep_cache_gs(cak, cav, cdk, cdv, KAL, VAL, KBL, VBL, (size_t)blockIdx.x * 256 + threadIdx.x, (size_t)gridDim.x * 256);
}

__device__ __forceinline__ float wave_sum(float v) {
#pragma unroll
    for (int o = 1; o < 64; o <<= 1) v += __shfl_xor(v, o);
    return v;
}
__device__ __forceinline__ void norm_row(const float* __restrict__ xrow, float* __restrict__ xcopy, const float* __restrict__ g, const float* __restrict__ shift, const float* __restrict__ scale, bf16_t* __restrict__ hrow, int lane) {
    f32x4 v[8]; float ss = 0.f;
#pragma unroll
    for (int j = 0; j < 8; ++j) { v[j] = *(const f32x4*)(xrow + lane * 4 + 256 * j); ss += (v[j][0] * v[j][0] + v[j][1] * v[j][1]) + (v[j][2] * v[j][2] + v[j][3] * v[j][3]); }
    if (xcopy) {
#pragma unroll
        for (int j = 0; j < 8; ++j) *(f32x4*)(xcopy + lane * 4 + 256 * j) = v[j]; }
    const float rinv = rsqrtf(wave_sum(ss) * (1.0f / D) + EPS);
#pragma unroll
    for (int j = 0; j < 8; ++j) { const int c = lane * 4 + 256 * j; const f32x4 gg = *(const f32x4*)(g + c), sc = *(const f32x4*)(scale + c), sh = *(const f32x4*)(shift + c);
        const f32x4 o = (v[j] * rinv) * gg * (sc + 1.0f) + sh;
        *(u32x2*)(hrow + c) = (u32x2){pk2(o[0], o[1]), pk2(o[2], o[3])}; }
}
__global__ __launch_bounds__(256) void k_norm(const float* __restrict__ xp, const float* __restrict__ xs, float* __restrict__ xout, int first, const float* __restrict__ g, const float* __restrict__ mod_l, int shift_chunk, bf16_t* __restrict__ H) {
    const int row = blockIdx.x * 4 + (threadIdx.x >> 6), lane = threadIdx.x & 63;
    const float* xrow = first ? (row < M_CTX ? xp + (size_t)row * D : xs + (size_t)(row - M_CTX) * D) : xout + (size_t)row * D;
    const float* mc = mod_l + (size_t)cond_of_row(row) * NMOD;
    norm_row(xrow, first ? xout + (size_t)row * D : nullptr, g, mc + (size_t)shift_chunk * D, mc + (size_t)(shift_chunk + 1) * D, H + (size_t)row * D, lane);
}

struct ZOff { int d1, d2; long s1, s2; };
__device__ __forceinline__ long zoff(const ZOff& o, int z) { return (long)(z / o.d1) * o.s1 + (long)((z % o.d1) / o.d2) * o.s2; }
template <bool BT, int MODE, bool COLMAP>
__global__ __launch_bounds__(256) void k_gemm(const bf16_t* __restrict__ A, long lda, ZOff oa, const bf16_t* __restrict__ B, long ldb, ZOff ob, void* __restrict__ Cv, long ldc, ZOff oc, int K, const float* __restrict__ gate  ) {
    const int z = blockIdx.z, w = threadIdx.x >> 6, lane = threadIdx.x & 63, r16 = lane & 15, q = lane >> 4;
    const int m0 = blockIdx.y * 128 + (w >> 1) * 64, n0 = blockIdx.x * 128 + (w & 1) * 64;
    const bf16_t* Ap = A + zoff(oa, z) + (long)(m0 + r16) * lda + q * 8;
    const bf16_t* Bp = B + zoff(ob, z);
    f32x4 acc[4][4];
#pragma unroll
    for (int i = 0; i < 4; ++i)
#pragma unroll
        for (int j = 0; j < 4; ++j) acc[i][j] = (f32x4){0.f, 0.f, 0.f, 0.f};
    for (int k0 = 0; k0 < K; k0 += 32) {
        bf16x8 a[4], b[4];
#pragma unroll
        for (int i = 0; i < 4; ++i) a[i] = *(const bf16x8*)(Ap + (long)(16 * i) * lda + k0);
#pragma unroll
        for (int j = 0; j < 4; ++j) {
            if (BT) b[j] = *(const bf16x8*)(Bp + (long)(n0 + 16 * j + r16) * ldb + k0 + q * 8);
            else {
#pragma unroll
                for (int e = 0; e < 8; ++e) b[j][e] = (short)Bp[(long)(k0 + q * 8 + e) * ldb + n0 + 16 * j + r16]; }
        }
#pragma unroll
        for (int i = 0; i < 4; ++i)
#pragma unroll
            for (int j = 0; j < 4; ++j) acc[i][j] = __builtin_amdgcn_mfma_f32_16x16x32_bf16(a[i], b[j], acc[i][j], 0, 0, 0);
    }
    const long co = zoff(oc, z);
#pragma unroll
    for (int i = 0; i < 4; ++i)
#pragma unroll
        for (int j = 0; j < 4; ++j)
#pragma unroll
            for (int r = 0; r < 4; ++r) {
                const int m = m0 + 16 * i + 4 * q + r, n = n0 + 16 * j + r16; const int nc = COLMAP ? ((n & ~127) | map8(n & 127)) : n; const float v = acc[i][j][r];
                if (MODE == 0) ((float*)Cv)[co + (long)m * ldc + nc] = v;
                else if (MODE == 1) { const float rl = v > 0.f ? v : 0.f; ((bf16_t*)Cv)[co + (long)m * ldc + nc] = (bf16_t)f2bf(rl * rl); }
                else if (MODE == 2) { float* x = (float*)Cv + co + (long)m * ldc + nc; *x = *x + gate[(size_t)cond_of_row(m) * NMOD + nc] * v; }
                else ((bf16_t*)Cv)[co + (long)m * ldc + nc] = (bf16_t)f2bf(v);
            }
}

struct EpiInArgs {
    const float* Z; int l;
    bf16_t *QA, *KAL, *VAL, *KAC, *VAC, *QB, *KBL, *VBL, *KBC, *VBC, *YTL, *YTC;
    float* out;
    const float *gqa, *gka, *gqb, *gkb;
    const float* rope;
};
__global__ __launch_bounds__(256) void k_epi_in(EpiInArgs a) {
    const size_t gid = (size_t)blockIdx.x * 256 + threadIdx.x;
    const int unit = (int)(gid % 40), row = (int)(gid / 40);
    if (row >= M_ALL) return;
    const bool lat = row >= M_CTX; const int b = lat ? (row - M_CTX) >> 11 : row >> 8, tk = lat ? (row - M_CTX) & 2047 : row & 255;
    const float* zr = a.Z + (size_t)row * N_IN; const int l = a.l;
    const float* cosA = a.rope; const float* sinA = cosA + 2048 * 64; const float* cosB = cosA + 2 * 2048 * 64; const float* sinB = cosB + 2048 * 32;
    if (unit < 10) {
        const bool isq = unit < 8; const int head = isq ? unit : unit - 8; const int colbase = isq ? head * 128 : 1024 + head * 128;
        const float* g = isq ? a.gqa : a.gka;
        float ss = 0.f; for (int s = 0; s < 128; ++s) { const float v = zr[colbase + map8inv(s)]; ss += v * v; }
        const float rinv = rsqrtf(ss * (1.0f / 128.0f) + EPS);
        bf16_t* dst; float* st = nullptr;
        if (isq) dst = a.QA + (size_t)row * 1024 + head * 128;
        else if (lat) dst = a.KAL + ((size_t)(l * NB_LAT + b) * S_LAT + tk) * 256 + head * 128;
        else { dst = a.KAC + (size_t)row * 256 + head * 128; st = a.out + OUT_SAK + ((size_t)(b * DEPTH + l) * T_CTX + tk) * 256 + head * 128; }
        for (int u = 0; u < 16; ++u) for (int e = 0; e < 4; ++e) { const int s1 = 8 * u + e, s2 = s1 + 4; const int l1 = sigma128(s1), l2 = sigma128(s2);
            float x1 = zr[colbase + map8inv(s1)] * rinv * g[l1], x2 = zr[colbase + map8inv(s2)] * rinv * g[l2];
            if (st) { st[l1] = x1; st[l2] = x2; }
            if (lat) { const int fi = (u < 8 ? 0 : 32) + 4 * (u & 7) + e; const float c = cosA[tk * 64 + fi], sn = sinA[tk * 64 + fi]; const float y1 = x1 * c - x2 * sn, y2 = x2 * c + x1 * sn; x1 = y1; x2 = y2; }
            dst[s1] = (bf16_t)f2bf(x1); dst[s2] = (bf16_t)f2bf(x2); }
    } else if (unit < 12) {
        const int head = unit - 10; const int colbase = 1280 + head * 128;
        bf16_t* dst = lat ? a.VAL + ((size_t)(l * NB_LAT + b) * S_LAT + tk) * 256 + head * 128 : a.VAC + (size_t)row * 256 + head * 128;
        float* st = lat ? nullptr : a.out + OUT_SAV + ((size_t)(b * DEPTH + l) * T_CTX + tk) * 256 + head * 128;
        for (int s = 0; s < 128; ++s) { const float v = zr[colbase + map8inv(s)]; if (st) st[s] = v; dst[s] = (bf16_t)f2bf(v); }
    } else if (unit < 28) {
        const bool isq = unit < 20; const int hc = isq ? unit - 12 : unit - 20; const int colbase = (isq ? 1536 : 2048) + (hc >> 1) * 128;
        const int sb = (hc & 1) * 64; const float* g = isq ? a.gqb : a.gkb;
        float ss = 0.f; for (int s = 0; s < 64; ++s) { const float v = zr[colbase + map8inv(sb + s)]; ss += v * v; }
        const float rinv = rsqrtf(ss * (1.0f / 64.0f) + EPS);
        bf16_t* dst; float* st = nullptr;
        if (isq) dst = a.QB + (size_t)row * 512 + hc * 64;
        else if (lat) dst = a.KBL + ((size_t)(l * NB_LAT + b) * S_LAT + tk) * 512 + hc * 64;
        else { dst = a.KBC + (size_t)row * 512 + hc * 64; st = a.out + OUT_SDK + ((size_t)(b * DEPTH + l) * T_CTX + tk) * 512 + hc * 64; }
        for (int u = 0; u < 8; ++u) for (int e = 0; e < 4; ++e) { const int s1 = 8 * u + e, s2 = s1 + 4; const int l1 = sigma64(s1), l2 = sigma64(s2);
            float x1 = zr[colbase + map8inv(sb + s1)] * rinv * g[l1], x2 = zr[colbase + map8inv(sb + s2)] * rinv * g[l2];
            if (st) { st[l1] = x1; st[l2] = x2; }
            if (lat) { const int fi = (u < 4 ? 0 : 16) + 4 * (u & 3) + e; const float c = cosB[tk * 32 + fi], sn = sinB[tk * 32 + fi]; const float y1 = x1 * c - x2 * sn, y2 = x2 * c + x1 * sn; x1 = y1; x2 = y2; }
            dst[s1] = (bf16_t)f2bf(x1); dst[s2] = (bf16_t)f2bf(x2); }
    } else if (unit < 32) {
        const int head = unit - 28; const int colbase = 2560 + head * 128;
        bf16_t* dst = lat ? a.VBL + ((size_t)(l * NB_LAT + b) * S_LAT + tk) * 512 + head * 128 : a.VBC + (size_t)row * 512 + head * 128;
        float* st = lat ? nullptr : a.out + OUT_SDV + ((size_t)(b * DEPTH + l) * T_CTX + tk) * 512 + head * 128;
        for (int s = 0; s < 128; ++s) { const float v = zr[colbase + map8inv(s)]; if (st) st[s] = v; dst[s] = (bf16_t)f2bf(v); }
    } else {
        const int j = unit - 32; const int cs = j >> 2; const int colbase = 3072 + j * 128;
        for (int p = 0; p < 128; ++p) { const float v = zr[colbase + p]; const int yrow = ((j & 3) * 128) + p;
            if (lat) a.YTL[((size_t)b * 512 + yrow) * 4096 + cs * 2048 + tk] = (bf16_t)f2bf(v);
            else a.YTC[((size_t)b * 512 + yrow) * 512 + cs * 256 + tk] = (bf16_t)f2bf(v); }
    }
}
__global__ __launch_bounds__(256) void k_softmax(const float* __restrict__ S, bf16_t* __restrict__ P, int ncols, float scale, long nrows) {
    const long row = (long)blockIdx.x * 4 + (threadIdx.x >> 6); const int lane = threadIdx.x & 63; if (row >= nrows) return;
    const float* s = S + row * ncols; float mx = -3.0e38f;
    for (int c = lane; c < ncols; c += 64) mx = fmaxf(mx, s[c]);
#pragma unroll
    for (int o = 1; o < 64; o <<= 1) mx = fmaxf(mx, __shfl_xor(mx, o));
    float sum = 0.f; for (int c = lane; c < ncols; c += 64) sum += expf((s[c] - mx) * scale);
    sum = wave_sum(sum); const float inv = 1.0f / sum;
    for (int c = lane; c < ncols; c += 64) P[row * ncols + c] = (bf16_t)f2bf(expf((s[c] - mx) * scale) * inv);
}
__global__ __launch_bounds__(256) void k_softmax_diff(const float* __restrict__ S, bf16_t* __restrict__ P, int ncols, int nq, float scale, const float* __restrict__ lamp, long nrows) {
    const long row = (long)blockIdx.x * 4 + (threadIdx.x >> 6); const int lane = threadIdx.x & 63; if (row >= nrows) return;
    const long zz = row / nq, qq = row % nq; const float lam = *lamp;
    const float* s1 = S + ((2 * zz) * nq + qq) * ncols; const float* s2 = S + ((2 * zz + 1) * nq + qq) * ncols;
    float m1 = -3.0e38f, m2 = -3.0e38f;
    for (int c = lane; c < ncols; c += 64) { m1 = fmaxf(m1, s1[c]); m2 = fmaxf(m2, s2[c]); }
#pragma unroll
    for (int o = 1; o < 64; o <<= 1) { m1 = fmaxf(m1, __shfl_xor(m1, o)); m2 = fmaxf(m2, __shfl_xor(m2, o)); }
    float a1 = 0.f, a2 = 0.f; for (int c = lane; c < ncols; c += 64) { a1 += expf((s1[c] - m1) * scale); a2 += expf((s2[c] - m2) * scale); }
    a1 = 1.0f / wave_sum(a1); a2 = lam / wave_sum(a2);
    for (int c = lane; c < ncols; c += 64) P[row * ncols + c] = (bf16_t)f2bf(expf((s1[c] - m1) * scale) * a1 - expf((s2[c] - m2) * scale) * a2);
}
__global__ __launch_bounds__(256) void k_subln(const float* __restrict__ O, bf16_t* __restrict__ MIX, int nq, long row0, const float* __restrict__ g, float post, long nrows) {
    const long row = (long)blockIdx.x * 4 + (threadIdx.x >> 6); const int lane = threadIdx.x & 63; if (row >= nrows) return;
    const long z = row / nq, qq = row % nq; const int h = (int)(z & 3); const long zb = z >> 2;
    const float v0 = O[row * 128 + lane], v1 = O[row * 128 + 64 + lane];
    const float rinv = rsqrtf(wave_sum(v0 * v0 + v1 * v1) * (1.0f / 128.0f) + EPS) * post;
    bf16_t* dst = MIX + (size_t)(row0 + zb * nq + qq) * D + 1024 + h * 128;
    dst[lane] = (bf16_t)f2bf(v0 * rinv * g[lane]); dst[64 + lane] = (bf16_t)f2bf(v1 * rinv * g[64 + lane]);
}
struct Ptrs {
    const float *x_prompt, *x_sample, *cak, *cav, *cdk, *cdv, *c, *c_ctx, *w_ada, *b_ada, *g_mix, *g_mlp, *w_in, *qn_a, *kn_a, *qn_b, *kn_b, *lq1, *lk1, *lq2, *lk2, *subln, *w_fourier, *w_out, *w_mi, *w_mo;
    float* out; unsigned char* ws;
    bf16_t *BT_IN, *BT_OUT, *BT_MI, *BT_MO, *DFT_L, *DFT_C, *H, *QA, *KAL, *VAL, *KAC, *VAC, *QB, *KBL, *VBL, *KBC, *VBC, *YTL, *YTC, *MIX, *HID;
    float *MOD, *ROPE, *G, *LAM, *OTMP;
};
__host__ __device__ __forceinline__ Ptrs make_ptrs_hd(const float* const* in, float* out, unsigned char* w) {
    Ptrs p{};
    p.x_prompt = in[0]; p.x_sample = in[1]; p.cak = in[2]; p.cav = in[3]; p.cdk = in[4]; p.cdv = in[5]; p.c = in[6]; p.c_ctx = in[7]; p.w_ada = in[8]; p.b_ada = in[9];
    p.g_mix = in[10]; p.g_mlp = in[11]; p.w_in = in[12]; p.qn_a = in[13]; p.kn_a = in[14]; p.qn_b = in[15]; p.kn_b = in[16]; p.lq1 = in[17]; p.lk1 = in[18]; p.lq2 = in[19]; p.lk2 = in[20];
    p.subln = in[21]; p.w_fourier = in[22]; p.w_out = in[23]; p.w_mi = in[24]; p.w_mo = in[25];
    p.out = out; p.ws = w;
    p.BT_IN = (bf16_t*)(w + WS_BT_IN); p.BT_OUT = (bf16_t*)(w + WS_BT_OUT); p.BT_MI = (bf16_t*)(w + WS_BT_MI); p.BT_MO = (bf16_t*)(w + WS_BT_MO);
    p.DFT_L = (bf16_t*)(w + WS_DFT_L); p.DFT_C = (bf16_t*)(w + WS_DFT_C); p.MOD = (float*)(w + WS_MOD); p.ROPE = (float*)(w + WS_ROPE); p.G = (float*)(w + WS_G); p.LAM = (float*)(w + WS_LAM);
    p.H = (bf16_t*)(w + WS_H); p.QA = (bf16_t*)(w + WS_QA); p.KAL = (bf16_t*)(w + WS_KAL); p.VAL = (bf16_t*)(w + WS_VAL); p.KAC = (bf16_t*)(w + WS_KAC); p.VAC = (bf16_t*)(w + WS_VAC);
    p.QB = (bf16_t*)(w + WS_QB); p.KBL = (bf16_t*)(w + WS_KBL); p.VBL = (bf16_t*)(w + WS_VBL); p.KBC = (bf16_t*)(w + WS_KBC); p.VBC = (bf16_t*)(w + WS_VBC);
    p.YTL = (bf16_t*)(w + WS_YTL); p.YTC = (bf16_t*)(w + WS_YTC); p.MIX = (bf16_t*)(w + WS_MIX); p.HID = (bf16_t*)(w + WS_HID); p.OTMP = (float*)(w + WS_OTMP);
    return p;
}
static Ptrs make_ptrs(void* const* d_in, void* d_out, void* d_ws) { return make_ptrs_hd((const float* const*)d_in, (float*)d_out, (unsigned char*)d_ws); }
static void launch_prologue(const Ptrs& p, hipStream_t st) {
    hipLaunchKernelGGL(k_prep_transpose, dim3(D / 32, 3072 / 128, DEPTH), dim3(256), 0, st, p.w_in, D, N_INRAW, (size_t)D * N_INRAW, p.BT_IN, (size_t)N_IN * D, 1);
    hipLaunchKernelGGL(k_prep_transpose, dim3(D / 32, D / 128, DEPTH), dim3(256), 0, st, p.w_out, D, D, (size_t)D * D, p.BT_OUT, (size_t)D * D, 0);
    hipLaunchKernelGGL(k_prep_transpose, dim3(D / 32, DFF / 128, DEPTH), dim3(256), 0, st, p.w_mi, D, DFF, (size_t)D * DFF, p.BT_MI, (size_t)DFF * D, 0);
    hipLaunchKernelGGL(k_prep_transpose, dim3(DFF / 32, D / 128, DEPTH), dim3(256), 0, st, p.w_mo, DFF, D, (size_t)DFF * D, p.BT_MO, (size_t)D * DFF, 0);
    hipLaunchKernelGGL(k_prep_G, dim3(DEPTH * 4 * 2 * 128 * 128 / 256), dim3(256), 0, st, p.w_fourier, p.G);
    hipLaunchKernelGGL(k_prep_fold, dim3(D / 64, 4, DEPTH), dim3(256), 0, st, p.w_in, p.G, p.BT_IN);
    hipLaunchKernelGGL(k_prep_ada, dim3(NMOD / 256, DEPTH), dim3(256), 0, st, p.c, p.c_ctx, p.w_ada, p.b_ada, p.MOD);
    hipLaunchKernelGGL(k_prep_tables, dim3(2048), dim3(256), 0, st, p.ROPE, p.DFT_L, p.DFT_C, p.LAM, p.lq1, p.lk1, p.lq2, p.lk2, (float*)(p.ws + WS_GAIN), p.qn_a, p.kn_a, p.qn_b, p.kn_b);
    hipLaunchKernelGGL(k_prep_cache, dim3(2048), dim3(256), 0, st, p.cak, p.cav, p.cdk, p.cdv, p.KAL, p.VAL, p.KBL, p.VBL);
}
static const ZOff Z0{1 << 30, 1, 0, 0};
static void simple_layer(const Ptrs& p, int l, hipStream_t st, unsigned mask = 0x7f) {
    const float* mod_l = p.MOD + (size_t)l * NCOND * NMOD;
    float* ZF = (float*)p.HID;
    bf16_t* PB = p.H;
    const float HUGE_S = 0.f; (void)HUGE_S;
    if (mask & 1u) hipLaunchKernelGGL(k_norm, dim3(M_ALL / 4), dim3(256), 0, st, p.x_prompt, p.x_sample, p.out, l == 0 ? 1 : 0, p.g_mix + (size_t)l * D, mod_l, 0, p.H);
    if (mask & 2u) {
    hipLaunchKernelGGL((k_gemm<true, 0, false>), dim3(N_IN / 128, M_ALL / 128, 1), dim3(256), 0, st, p.H, (long)D, Z0, p.BT_IN + (size_t)l * N_IN * D, (long)D, Z0, (void*)ZF, (long)N_IN, Z0, D, (const float*)nullptr);
    EpiInArgs ea{}; ea.Z = ZF; ea.l = l; ea.QA = p.QA; ea.KAL = p.KAL; ea.VAL = p.VAL; ea.KAC = p.KAC; ea.VAC = p.VAC; ea.QB = p.QB; ea.KBL = p.KBL; ea.VBL = p.VBL; ea.KBC = p.KBC; ea.VBC = p.VBC;
    ea.YTL = p.YTL; ea.YTC = p.YTC; ea.out = p.out; ea.gqa = p.qn_a + l * 128; ea.gka = p.kn_a + l * 128; ea.gqb = p.qn_b + l * 64; ea.gkb = p.kn_b + l * 64; ea.rope = p.ROPE;
    hipLaunchKernelGGL(k_epi_in, dim3((M_ALL * 40 + 255) / 256), dim3(256), 0, st, ea);
    }
    if (mask & 4u) {
    const float scA = 0.088388347648318440f, scB = 0.125f; const float post = 1.0f - lambda_init_of(l);
    {   ZOff oa{8, 1, (long)T_CTX * 1024, 128}, ob{8, 4, (long)T_CTX * 256, 128}, oc{1 << 30, 1, 0, (long)T_CTX * T_CTX};
        hipLaunchKernelGGL((k_gemm<true, 0, false>), dim3(T_CTX / 128, T_CTX / 128, NB_CTX * 8), dim3(256), 0, st, p.QA, 1024L, oa, p.KAC, 256L, ob, (void*)ZF, (long)T_CTX, oc, 128, (const float*)nullptr);
        const long nr = (long)NB_CTX * 8 * T_CTX; hipLaunchKernelGGL(k_softmax, dim3((unsigned)(nr / 4)), dim3(256), 0, st, ZF, PB, T_CTX, scA, nr);
        ZOff pa{1 << 30, 1, 0, (long)T_CTX * T_CTX}, pb{8, 4, (long)T_CTX * 256, 128}, pc{8, 1, (long)T_CTX * D, 128};
        hipLaunchKernelGGL((k_gemm<false, 3, false>), dim3(1, T_CTX / 128, NB_CTX * 8), dim3(256), 0, st, PB, (long)T_CTX, pa, p.VAC, 256L, pb, (void*)p.MIX, (long)D, pc, T_CTX, (const float*)nullptr); }
    {   ZOff oa{8, 1, (long)T_CTX * 512, 64}, ob{8, 1, (long)T_CTX * 512, 64}, oc{1 << 30, 1, 0, (long)T_CTX * T_CTX};
        hipLaunchKernelGGL((k_gemm<true, 0, false>), dim3(T_CTX / 128, T_CTX / 128, NB_CTX * 8), dim3(256), 0, st, p.QB, 512L, oa, p.KBC, 512L, ob, (void*)ZF, (long)T_CTX, oc, 64, (const float*)nullptr);
        const long nr = (long)NB_CTX * 4 * T_CTX; hipLaunchKernelGGL(k_softmax_diff, dim3((unsigned)(nr / 4)), dim3(256), 0, st, ZF, PB, T_CTX, T_CTX, scB, p.LAM + l, nr);
        ZOff pa{1 << 30, 1, 0, (long)T_CTX * T_CTX}, pb{4, 1, (long)T_CTX * 512, 128}, pc{1 << 30, 1, 0, (long)T_CTX * 128};
        hipLaunchKernelGGL((k_gemm<false, 0, false>), dim3(1, T_CTX / 128, NB_CTX * 4), dim3(256), 0, st, PB, (long)T_CTX, pa, p.VBC, 512L, pb, (void*)p.OTMP, 128L, pc, T_CTX, (const float*)nullptr);
        hipLaunchKernelGGL(k_subln, dim3((unsigned)(nr / 4)), dim3(256), 0, st, p.OTMP, p.MIX, T_CTX, 0L, p.subln + l * 128, post, nr); }
    {   ZOff ob{1 << 30, 1, 0, 512L * 512}, oc{1 << 30, 1, 0, (long)T_CTX * D};
        hipLaunchKernelGGL((k_gemm<true, 3, true>), dim3(512 / 128, T_CTX / 128, NB_CTX), dim3(256), 0, st, p.DFT_C, 512L, Z0, p.YTC, 512L, ob, (void*)(p.MIX + 1536), (long)D, oc, 512, (const float*)nullptr); }
    for (int b = 0; b < NB_LAT; ++b) {
        const size_t row0 = (size_t)M_CTX + (size_t)b * T_LAT;
        const bf16_t* kal = p.KAL + (size_t)(l * NB_LAT + b) * S_LAT * 256; const bf16_t* val = p.VAL + (size_t)(l * NB_LAT + b) * S_LAT * 256;
        const bf16_t* kbl = p.KBL + (size_t)(l * NB_LAT + b) * S_LAT * 512; const bf16_t* vbl = p.VBL + (size_t)(l * NB_LAT + b) * S_LAT * 512;
        {   ZOff oa{1 << 30, 1, 0, 128}, ob{1 << 30, 4, 0, 128}, oc{1 << 30, 1, 0, (long)T_LAT * S_LAT};
            hipLaunchKernelGGL((k_gemm<true, 0, false>), dim3(S_LAT / 128, T_LAT / 128, 8), dim3(256), 0, st, p.QA + row0 * 1024, 1024L, oa, kal, 256L, ob, (void*)ZF, (long)S_LAT, oc, 128, (const float*)nullptr);
            const long nr = 8L * T_LAT; hipLaunchKernelGGL(k_softmax, dim3((unsigned)(nr / 4)), dim3(256), 0, st, ZF, PB, S_LAT, scA, nr);
            ZOff pa{1 << 30, 1, 0, (long)T_LAT * S_LAT}, pb{1 << 30, 4, 0, 128}, pc{1 << 30, 1, 0, 128};
            hipLaunchKernelGGL((k_gemm<false, 3, false>), dim3(1, T_LAT / 128, 8), dim3(256), 0, st, PB, (long)S_LAT, pa, val, 256L, pb, (void*)(p.MIX + row0 * D), (long)D, pc, S_LAT, (const float*)nullptr); }
        {   ZOff oa{1 << 30, 1, 0, 64}, ob{1 << 30, 1, 0, 64}, oc{1 << 30, 1, 0, (long)T_LAT * S_LAT};
            hipLaunchKernelGGL((k_gemm<true, 0, false>), dim3(S_LAT / 128, T_LAT / 128, 8), dim3(256), 0, st, p.QB + row0 * 512, 512L, oa, kbl, 512L, ob, (void*)ZF, (long)S_LAT, oc, 64, (const float*)nullptr);
            const long nr = 4L * T_LAT; hipLaunchKernelGGL(k_softmax_diff, dim3((unsigned)(nr / 4)), dim3(256), 0, st, ZF, PB, S_LAT, T_LAT, scB, p.LAM + l, nr);
            ZOff pa{1 << 30, 1, 0, (long)T_LAT * S_LAT}, pb{1 << 30, 1, 0, 128}, pc{1 << 30, 1, 0, (long)T_LAT * 128};
            hipLaunchKernelGGL((k_gemm<false, 0, false>), dim3(1, T_LAT / 128, 4), dim3(256), 0, st, PB, (long)S_LAT, pa, vbl, 512L, pb, (void*)p.OTMP, 128L, pc, S_LAT, (const float*)nullptr);
            hipLaunchKernelGGL(k_subln, dim3((unsigned)(nr / 4)), dim3(256), 0, st, p.OTMP, p.MIX, T_LAT, (long)row0, p.subln + l * 128, post, nr); }
        {   hipLaunchKernelGGL((k_gemm<true, 3, true>), dim3(512 / 128, T_LAT / 128, 1), dim3(256), 0, st, p.DFT_L, 4096L, Z0, p.YTL + (size_t)b * 512 * 4096, 4096L, Z0, (void*)(p.MIX + row0 * D + 1536), (long)D, Z0, 4096, (const float*)nullptr); }
    }
    }
    if (mask & 8u) hipLaunchKernelGGL((k_gemm<true, 2, true>), dim3(D / 128, M_ALL / 128, 1), dim3(256), 0, st, p.MIX, (long)D, Z0, p.BT_OUT + (size_t)l * D * D, (long)D, Z0, (void*)p.out, (long)D, Z0, D, mod_l + 2 * D);
    if (mask & 16u) hipLaunchKernelGGL(k_norm, dim3(M_ALL / 4), dim3(256), 0, st, p.x_prompt, p.x_sample, p.out, 0, p.g_mlp + (size_t)l * D, mod_l, 3, p.H);
    if (mask & 32u) hipLaunchKernelGGL((k_gemm<true, 1, true>), dim3(DFF / 128, M_ALL / 128, 1), dim3(256), 0, st, p.H, (long)D, Z0, p.BT_MI + (size_t)l * DFF * D, (long)D, Z0, (void*)p.HID, (long)DFF, Z0, D, (const float*)nullptr);
    if (mask & 64u) hipLaunchKernelGGL((k_gemm<true, 2, true>), dim3(D / 128, M_ALL / 128, 1), dim3(256), 0, st, p.HID, (long)DFF, Z0, p.BT_MO + (size_t)l * D * DFF, (long)DFF, Z0, (void*)p.out, (long)D, Z0, DFF, mod_l + 5 * D);
}
namespace pg8 {
#define PG8_LAS __attribute__((address_space(3)))
typedef unsigned short bf16_t;
typedef short bf16x8 __attribute__((ext_vector_type(8)));
typedef float f32x4 __attribute__((ext_vector_type(4)));
typedef unsigned u32x4 __attribute__((ext_vector_type(4)));
constexpr int BM = 256, BK = 64, HALF = 128, HTB = HALF * BK * 2  , STAGE_BYTES = 8 * HTB, NXCD = 8, WGM = 8;

__host__ __device__ __forceinline__ int lds_byte(int r, int c) { const int st = (r >> 4) * 2 + (c >> 5), rr = r & 15, cc = c & 31, ob = rr * 64 + cc * 2; return st * 1024 + (ob ^ (((ob >> 9) & 1) << 5)); }
__host__ __device__ __forceinline__ void stage_rc(int b, int& R, int& C) { const int st = b / 1024, sb = b % 1024, swz = sb ^ (((sb >> 9) & 1) << 5); R = (st >> 1) * 16 + swz / 64; C = (st & 1) * 32 + (swz % 64) / 2; }
__host__ __device__ __forceinline__ int perm32(int rho) { const int n = rho >> 4, i = rho & 15; return 8 * (i >> 2) + 4 * n + (i & 3); }

struct Unit { int pm, pn, kh, aux; };
struct Gemm { const bf16_t* A; const bf16_t* Bt; int M, N, K, ld; };

struct StaticOrder {
    int nM, nN, nwg, G, c; int rounds = 1 << 30;
    __device__ __forceinline__ const char* aptr(const Unit& u, const Gemm& g) const { return (const char*)g.A + (size_t)u.pm * ((size_t)BM * g.ld * 2) + (size_t)u.kh * ((size_t)g.K * 2); }
    __device__ __forceinline__ const char* bptr(const Unit& u, const Gemm& g) const { return (const char*)g.Bt + (size_t)u.pn * ((size_t)BM * g.ld * 2) + (size_t)u.kh * ((size_t)g.K * 2); }
    __host__ __device__ void init(int M, int N, int G_, int c_) { nM = M / BM; nN = N / BM; nwg = nM * nN; G = G_; c = c_; }
    __host__ __device__ bool next(int i, Unit& u) const {
        const long L = (long)i * G + c; if (L >= nwg || i >= rounds) return false; u.kh = 0; u.aux = 0;
        int wgid = (int)L; { const int q = nwg / NXCD, r = nwg % NXCD, xcd = wgid % NXCD, off = wgid / NXCD; wgid = (xcd < r ? xcd * (q + 1) : r * (q + 1) + (xcd - r) * q) + off; }
        const int nig = WGM * nN, gid = wgid / nig, fm = gid * WGM, gsz = (nM - fm) < WGM ? (nM - fm) : WGM;
        u.pm = fm + ((wgid % nig) % gsz); u.pn = (wgid % nig) / gsz; return true;
    }
    __device__ __forceinline__ void a_ready(const Unit&) const {}
    __device__ __forceinline__ void done(const Unit&) const {}
};


__device__ __forceinline__ unsigned cvt_pk_bf16(float lo, float hi) { unsigned r; asm volatile("v_cvt_pk_bf16_f32 %0, %1, %2" : "=v"(r) : "v"(lo), "v"(hi)); return r; }
__device__ __forceinline__ u32x4 pack8(const f32x4 a, const f32x4 b) { u32x4 w; w.x = cvt_pk_bf16(a[0], a[1]); w.y = cvt_pk_bf16(a[2], a[3]); w.z = cvt_pk_bf16(b[0], b[1]); w.w = cvt_pk_bf16(b[2], b[3]); return w; }
constexpr int EPIX_OFF = STAGE_BYTES + 8192 + 1024, EPIX_SLOT = 9216, EPIX_END = EPIX_OFF + 2 * EPIX_SLOT;
__device__ __forceinline__ void stage_ss_bias(const float* ss, const float* bias_row256, const Unit& u, PG8_LAS unsigned char* lds, int ui) {
    int t_ = threadIdx.x; asm volatile("" : "+v"(t_)); const int wid_ = __builtin_amdgcn_readfirstlane(t_ >> 6), lane_ = t_ & 63;
    PG8_LAS unsigned char* slot = lds + EPIX_OFF + (ui & 1) * EPIX_SLOT;
    __builtin_amdgcn_global_load_lds((const unsigned*)((const char*)(ss + (size_t)u.pm * BM * 8) + wid_ * 1024 + lane_ * 16), (PG8_LAS unsigned*)(slot + wid_ * 1024), 16, 0, 0);
    if (wid_ == 0) __builtin_amdgcn_global_load_lds((const unsigned*)((const char*)bias_row256 + lane_ * 16), (PG8_LAS unsigned*)(slot + 8192), 16, 0, 0);
}
#define EPI_LANE_COORDS int t_ = threadIdx.x; asm volatile("" : "+v"(t_)); const int wid_ = __builtin_amdgcn_readfirstlane(t_ >> 6), wr = wid_ >> 2, wc = wid_ & 3, fr = t_ & 15, fq = (t_ >> 4) & 3
__device__ __forceinline__ float row_rinv(const PG8_LAS float* ssl, int row) {
    const f32x4 a = *(const PG8_LAS f32x4*)(ssl + row * 8), b = *(const PG8_LAS f32x4*)(ssl + row * 8 + 4);
    return __builtin_amdgcn_rsqf((((a[0] + a[1]) + (a[2] + a[3])) + ((b[0] + b[1]) + (b[2] + b[3]))) * (1.0f / D) + EPS);
}
struct EpiRelu2 {
    static constexpr bool PERM = false, AFTER_DRAIN = false;
    bf16_t* O; int ldc; const float* ss; const float* bias;
    __device__ __forceinline__ void stage(const Unit& u, PG8_LAS unsigned char* lds, int ui) const { const int cond = u.pm < 16 ? 0 : 1 + ((u.pm - 16) >> 3); stage_ss_bias(ss, bias + (size_t)cond * ldc + u.pn * BM, u, lds, ui); }
    __device__ __forceinline__ void operator()(f32x4 (&acc)[2][2][4][2], const Unit& u, int ui, int, int, int, PG8_LAS unsigned char* lds) const {
        EPI_LANE_COORDS;
        PG8_LAS unsigned char* xs = lds + EPIX_OFF + (ui & 1) * EPIX_SLOT;
        const PG8_LAS float* ssl = (const PG8_LAS float*)xs; const PG8_LAS float* bp = (const PG8_LAS float*)(xs + 8192) + wc * 32 + 4 * fq;
        f32x4 bv[2][2];
#pragma unroll
        for (int bj = 0; bj < 2; ++bj) { bv[bj][0] = *(const PG8_LAS f32x4*)(bp + bj * HALF); bv[bj][1] = *(const PG8_LAS f32x4*)(bp + bj * HALF + 16); }
        const int row0 = u.pm * BM + wr * 64 + fr;
        bf16_t* base = O + (size_t)row0 * ldc + u.pn * BM + wc * 32 + 8 * fq;
#pragma unroll
        for (int ai = 0; ai < 2; ++ai)
#pragma unroll
            for (int m = 0; m < 4; ++m) { bf16_t* rowp = base + (size_t)(ai * HALF + m * 16) * ldc;
                const float r = row_rinv(ssl, wr * 64 + fr + ai * HALF + m * 16);
#pragma unroll
                for (int bj = 0; bj < 2; ++bj) { f32x4 v0 = acc[ai][bj][m][0] * r + bv[bj][0], v1 = acc[ai][bj][m][1] * r + bv[bj][1];
#pragma unroll
                    for (int e = 0; e < 4; ++e) { const float a = v0[e] > 0.f ? v0[e] : 0.f, b = v1[e] > 0.f ? v1[e] : 0.f; v0[e] = a * a; v1[e] = b * b; }
                    *(u32x4*)(rowp + bj * HALF) = pack8(v0, v1); } }
    }
};
struct EpiBf16Out {
    static constexpr bool PERM = false, AFTER_DRAIN = false;
    bf16_t* O; int ldc; int col_off;
    __device__ __forceinline__ void stage(const Unit&, PG8_LAS unsigned char*, int) const {}
    __device__ __forceinline__ void operator()(f32x4 (&acc)[2][2][4][2], const Unit& u, int, int, int, int, PG8_LAS unsigned char*) const {
        EPI_LANE_COORDS;
        bf16_t* base = O + (size_t)(u.pm * BM + wr * 64 + fr) * ldc + col_off + u.pn * BM + wc * 32 + 8 * fq;
#pragma unroll
        for (int ai = 0; ai < 2; ++ai)
#pragma unroll
            for (int m = 0; m < 4; ++m) { bf16_t* rowp = base + (size_t)(ai * HALF + m * 16) * ldc;
#pragma unroll
                for (int bj = 0; bj < 2; ++bj) *(u32x4*)(rowp + bj * HALF) = pack8(acc[ai][bj][m][0], acc[ai][bj][m][1]); }
    }
};
struct ResNext { bf16_t* XA; const float* gn; const float* scn; float* ssn; };
struct EpiRes {
    static constexpr bool PERM = false, AFTER_DRAIN = false;
    float* X; const float* gate; ResNext nx;
    __device__ __forceinline__ void stage(const Unit&, PG8_LAS unsigned char*, int) const {}
    template <bool SPLIT>
    __device__ __forceinline__ void run(f32x4 (&acc)[2][2][4][2], const Unit& u, int wr, int wc, int fr, int fq, const float* pb, PG8_LAS unsigned char* lds, int t_) const {
        PG8_LAS float* PT = (PG8_LAS float*)(lds + STAGE_BYTES);
        const int cond = u.pm < 16 ? 0 : 1 + ((u.pm - 16) >> 3); const int col0 = u.pn * BM + wc * 32 + 8 * fq;
        const float* gp = gate + (size_t)cond * NMOD + col0;
        f32x4 gv[2][2], av[2][2];
        const bool has_next = nx.XA != nullptr;
#pragma unroll
        for (int bj = 0; bj < 2; ++bj) { gv[bj][0] = *(const f32x4*)(gp + bj * HALF); gv[bj][1] = *(const f32x4*)(gp + bj * HALF + 4); av[bj][0] = (f32x4){0.f, 0.f, 0.f, 0.f}; av[bj][1] = av[bj][0]; }
        if (has_next) { const float* g2 = nx.gn + col0; const float* s2 = nx.scn + (size_t)cond * NMOD + col0;
#pragma unroll
            for (int bj = 0; bj < 2; ++bj) { av[bj][0] = *(const f32x4*)(g2 + bj * HALF) * (*(const f32x4*)(s2 + bj * HALF) + 1.0f); av[bj][1] = *(const f32x4*)(g2 + bj * HALF + 4) * (*(const f32x4*)(s2 + bj * HALF + 4) + 1.0f); } }
        const int row0 = u.pm * BM + wr * 64 + fr;
        float* base = X + (size_t)row0 * D + col0;
#pragma unroll
        for (int ai = 0; ai < 2; ++ai)
#pragma unroll
            for (int m = 0; m < 4; ++m) { const int ro = ai * HALF + m * 16; float* rowp = base + (size_t)ro * D; float sq = 0.f;
#pragma unroll
                for (int bj = 0; bj < 2; ++bj) { f32x4 x0 = *(const f32x4*)(rowp + bj * HALF), x1 = *(const f32x4*)(rowp + bj * HALF + 4);
                    f32x4 a0 = acc[ai][bj][m][0], a1 = acc[ai][bj][m][1];
                    if (SPLIT) { a0 = a0 + *(const f32x4*)(pb + (size_t)(((ai * 2 + bj) * 4 + m) * 2 + 0) * 2048); a1 = a1 + *(const f32x4*)(pb + (size_t)(((ai * 2 + bj) * 4 + m) * 2 + 1) * 2048); }
                    x0 = x0 + gv[bj][0] * a0; x1 = x1 + gv[bj][1] * a1;
                    *(f32x4*)(rowp + bj * HALF) = x0; *(f32x4*)(rowp + bj * HALF + 4) = x1;
                    if (has_next) { *(u32x4*)(nx.XA + (size_t)(row0 + ro) * D + col0 + bj * HALF) = pack8(x0 * av[bj][0], x1 * av[bj][1]);
                        sq += (x0[0] * x0[0] + x0[1] * x0[1]) + (x0[2] * x0[2] + x0[3] * x0[3]) + (x1[0] * x1[0] + x1[1] * x1[1]) + (x1[2] * x1[2] + x1[3] * x1[3]); } }
                if (has_next) { sq += __shfl_xor(sq, 16); sq += __shfl_xor(sq, 32); if (fq == 0) PT[(ro + wr * 64 + fr) * 4 + wc] = sq; }
                asm volatile("" ::: "memory"); }
        if (has_next) {
            asm volatile("s_waitcnt lgkmcnt(0)" ::: "memory"); __builtin_amdgcn_s_barrier(); asm volatile("" ::: "memory");
            if (t_ < 256) { const f32x4 p = *(const PG8_LAS f32x4*)(PT + t_ * 4); nx.ssn[(size_t)(u.pm * BM + t_) * 8 + u.pn] = (p[0] + p[1]) + (p[2] + p[3]); }
        }
    }
    __device__ __forceinline__ void operator()(f32x4 (&acc)[2][2][4][2], const Unit& u, int, int, int, int, PG8_LAS unsigned char* lds) const {
        EPI_LANE_COORDS;
        run<false>(acc, u, wr, wc, fr, fq, nullptr, lds, t_);
    }
};
struct EpiIn {
    static constexpr bool PERM = false, AFTER_DRAIN = false;
    __device__ __forceinline__ void stage(const Unit& u, PG8_LAS unsigned char* lds, int ui) const { const int cond = u.pm < 16 ? 0 : 1 + ((u.pm - 16) >> 3); stage_ss_bias(ss, bias + (size_t)cond * N_IN + u.pn * BM, u, lds, ui); }
    int l;
    unsigned char* ws; float* out_; const float* ss; const float* bias;
    __device__ __forceinline__ void operator()(f32x4 (&acc)[2][2][4][2], const Unit& u, int ui, int, int, int, PG8_LAS unsigned char* lds) const {
        EPI_LANE_COORDS;
        unsigned char* w = ws; float* out = out_; asm volatile("" : "+s"(w), "+s"(out));
        bf16_t* const QA = (bf16_t*)(w + WS_QA); bf16_t* const KAL = (bf16_t*)(w + WS_KAL); bf16_t* const VAL = (bf16_t*)(w + WS_VAL); bf16_t* const KAC = (bf16_t*)(w + WS_KAC); bf16_t* const VAC = (bf16_t*)(w + WS_VAC);
        bf16_t* const QB = (bf16_t*)(w + WS_QB); bf16_t* const KBL = (bf16_t*)(w + WS_KBL); bf16_t* const VBL = (bf16_t*)(w + WS_VBL); bf16_t* const KBC = (bf16_t*)(w + WS_KBC); bf16_t* const VBC = (bf16_t*)(w + WS_VBC);
        bf16_t* const YTL = (bf16_t*)(w + WS_YTL); bf16_t* const YTC = (bf16_t*)(w + WS_YTC); const float* const rope = (const float*)(w + WS_ROPE); const float* const gains = (const float*)(w + WS_GAIN) + l * 384;
        const int pn = u.pn, pm = u.pm; const bool lat = pm >= 16; const int b = lat ? (pm - 16) >> 3 : pm; const int tbase = lat ? ((pm - 16) & 7) * 256 : 0;
        const int rl0 = wr * 64 + fr;
        {
            PG8_LAS unsigned char* xs = lds + EPIX_OFF + (ui & 1) * EPIX_SLOT;
            const PG8_LAS float* ssl = (const PG8_LAS float*)xs; const PG8_LAS float* bp = (const PG8_LAS float*)(xs + 8192) + wc * 32 + 4 * fq;
            f32x4 bv[2][2];
#pragma unroll
            for (int bj = 0; bj < 2; ++bj) { bv[bj][0] = *(const PG8_LAS f32x4*)(bp + bj * HALF); bv[bj][1] = *(const PG8_LAS f32x4*)(bp + bj * HALF + 16); }
#pragma unroll
            for (int ai = 0; ai < 2; ++ai)
#pragma unroll
                for (int m = 0; m < 4; ++m) { const float r = row_rinv(ssl, ai * HALF + m * 16 + rl0);
#pragma unroll
                    for (int bj = 0; bj < 2; ++bj) { acc[ai][bj][m][0] = acc[ai][bj][m][0] * r + bv[bj][0]; acc[ai][bj][m][1] = acc[ai][bj][m][1] * r + bv[bj][1]; } }
        }
        const size_t lrow = (size_t)(l * NB_LAT + b) * S_LAT;
        PG8_LAS float* P = (PG8_LAS float*)(lds + STAGE_BYTES);
        const bool normed = (pn <= 4) || (pn >= 6 && pn <= 9);
        if (normed) {
            const bool is128 = pn <= 4;
#pragma unroll
            for (int ai = 0; ai < 2; ++ai)
#pragma unroll
                for (int m = 0; m < 4; ++m)
#pragma unroll
                    for (int bj = 0; bj < 2; ++bj) { const f32x4 a0 = acc[ai][bj][m][0], a1 = acc[ai][bj][m][1];
                        float s = (a0[0] * a0[0] + a0[1] * a0[1]) + (a0[2] * a0[2] + a0[3] * a0[3]) + (a1[0] * a1[0] + a1[1] * a1[1]) + (a1[2] * a1[2] + a1[3] * a1[3]);
                        s += __shfl_xor(s, 16); s += __shfl_xor(s, 32);
                        if (fq == 0) P[(bj * 256 + ai * HALF + m * 16 + rl0) * 4 + wc] = s; }
            asm volatile("s_waitcnt lgkmcnt(0)" ::: "memory"); __builtin_amdgcn_s_barrier(); asm volatile("" ::: "memory");
            int lbase, pstep, fbase, sbase;
            const float *cosT, *sinT; int tstride; const float* g;
            if (is128) { const int u16 = 4 * wc + fq; lbase = (u16 < 8 ? 0 : 64) + 4 * (u16 & 7); pstep = 32; fbase = (u16 < 8 ? 0 : 32) + 4 * (u16 & 7); sbase = 8 * u16;
                cosT = rope; sinT = rope + 2048 * 64; tstride = 64; g = gains + ((pn < 4) ? 0 : 128); }
            else { const int u8 = 4 * (wc & 1) + fq; lbase = (u8 < 4 ? 0 : 32) + 4 * (u8 & 3); pstep = 16; fbase = (u8 < 4 ? 0 : 16) + 4 * (u8 & 3); sbase = 64 * (wc >> 1) + 8 * u8;
                cosT = rope + 2 * 2048 * 64; sinT = cosT + 2048 * 32; tstride = 32; g = gains + ((pn < 8) ? 256 : 320); }
            const f32x4 g0 = *(const f32x4*)(g + lbase), g1 = *(const f32x4*)(g + lbase + pstep);
            const float invdim = is128 ? (1.0f / 128.0f) : (1.0f / 64.0f);
            const bool isq = (pn < 4) || (pn == 6) || (pn == 7);
#pragma unroll
            for (int ai = 0; ai < 2; ++ai)
#pragma unroll
                for (int m = 0; m < 4; ++m) { const int rl = ai * HALF + m * 16 + rl0; const int tk = tbase + rl; const size_t row = (size_t)pm * BM + rl;
                    f32x4 cs4 = (f32x4){1.f, 1.f, 1.f, 1.f}, sn4 = (f32x4){0.f, 0.f, 0.f, 0.f};
                    if (lat) { cs4 = *(const f32x4*)(cosT + (size_t)tk * tstride + fbase); sn4 = *(const f32x4*)(sinT + (size_t)tk * tstride + fbase); }
#pragma unroll
                    for (int bj = 0; bj < 2; ++bj) { const f32x4 pp = *(const PG8_LAS f32x4*)(P + (bj * 256 + rl) * 4);
                        const float tot = is128 ? ((pp[0] + pp[1]) + (pp[2] + pp[3])) : (wc < 2 ? pp[0] + pp[1] : pp[2] + pp[3]);
                        const float rinv = __builtin_amdgcn_rsqf(tot * invdim + EPS);
                        f32x4 x1 = acc[ai][bj][m][0] * rinv * g0, x2 = acc[ai][bj][m][1] * rinv * g1;
                        bf16_t* dst;
                        if (is128) { if (pn < 4) dst = QA + row * 1024 + (2 * pn + bj) * 128 + sbase;
                            else if (lat) dst = KAL + (lrow + tk) * 256 + bj * 128 + sbase;
                            else { dst = KAC + row * 256 + bj * 128 + sbase; float* st = out + OUT_SAK + ((size_t)(b * DEPTH + l) * T_CTX + tk) * 256 + bj * 128 + lbase; *(f32x4*)st = x1; *(f32x4*)(st + pstep) = x2; } }
                        else { const int h = 2 * ((pn - 6) & 1) + bj;
                            if (pn < 8) dst = QB + row * 512 + h * 128 + sbase;
                            else if (lat) dst = KBL + (lrow + tk) * 512 + h * 128 + sbase;
                            else { dst = KBC + row * 512 + h * 128 + sbase; float* st = out + OUT_SDK + ((size_t)(b * DEPTH + l) * T_CTX + tk) * 512 + h * 128 + 64 * (wc >> 1) + lbase; *(f32x4*)st = x1; *(f32x4*)(st + pstep) = x2; } }
                        if (lat) { const f32x4 y1 = x1 * cs4 - x2 * sn4, y2 = x2 * cs4 + x1 * sn4; x1 = y1; x2 = y2; }
                        *(u32x4*)dst = pack8(x1, x2); }
                    asm volatile("" ::: "memory");
                }
            (void)isq;
        } else if (pn == 5 || pn == 10 || pn == 11) {
            const bool isa = pn == 5; const int pitch = isa ? 256 : 512; const int hb = isa ? 0 : 2 * (pn - 10);
            const int sb = wc * 32 + 8 * fq;
#pragma unroll
            for (int ai = 0; ai < 2; ++ai)
#pragma unroll
                for (int m = 0; m < 4; ++m) { const int rl = ai * HALF + m * 16 + rl0; const int tk = tbase + rl; const size_t row = (size_t)pm * BM + rl;
#pragma unroll
                    for (int bj = 0; bj < 2; ++bj) { const int col = (hb + bj) * 128 + sb; const f32x4 x1 = acc[ai][bj][m][0], x2 = acc[ai][bj][m][1];
                        bf16_t* dst;
                        if (lat) dst = (isa ? VAL : VBL) + (lrow + tk) * pitch + col;
                        else { dst = (isa ? VAC : VBC) + row * pitch + col; float* st = out + (isa ? OUT_SAV : OUT_SDV) + ((size_t)(b * DEPTH + l) * T_CTX + tk) * pitch + col; *(f32x4*)st = x1; *(f32x4*)(st + 4) = x2; }
                        *(u32x4*)dst = pack8(x1, x2); } }
        } else {
            const int cs = (pn - 12) >> 1; const int g2 = 2 * ((pn - 12) & 1);
            bf16_t* ybase = lat ? YTL + (size_t)b * 512 * 4096 + cs * T_LAT + tbase : YTC + (size_t)b * 512 * 512 + cs * T_CTX;
            const size_t ypitch = lat ? 4096 : 512;
#pragma unroll
            for (int ai = 0; ai < 2; ++ai)
#pragma unroll
                for (int m = 0; m < 4; ++m) { const int rl = ai * HALF + m * 16 + rl0;
#pragma unroll
                    for (int bj = 0; bj < 2; ++bj)
#pragma unroll
                        for (int n = 0; n < 2; ++n) { const f32x4 v = acc[ai][bj][m][n];
#pragma unroll
                            for (int e = 0; e < 4; ++e) { const int yrow = (g2 + bj) * 128 + wc * 32 + 16 * n + 4 * fq + e; ybase[(size_t)yrow * ypitch + rl] = (bf16_t)(cvt_pk_bf16(v[e], 0.f) & 0xffffu); } } }
        }
    }
};
struct SplitOrder {
    StaticOrder base; int c, on;
    __device__ __forceinline__ void init(int M, int N, int G, int c_) { base.init(M, N, 256, c_ & 127); c = c_; on = (G == 256); }
    __device__ __forceinline__ bool next(int i, Unit& u) const { if (!on || i > 0) return false; const bool ok = base.next(2, u); u.kh = c >> 7; u.aux = c & 127; return ok; }
    __device__ __forceinline__ const char* aptr(const Unit& u, const Gemm& g) const { return base.aptr(u, g); }
    __device__ __forceinline__ const char* bptr(const Unit& u, const Gemm& g) const { return base.bptr(u, g); }
    __device__ __forceinline__ void a_ready(const Unit&) const {}
    __device__ __forceinline__ void done(const Unit&) const {}
};
struct EpiResSplit {
    static constexpr bool PERM = false, AFTER_DRAIN = false;
    __device__ __forceinline__ void stage(const Unit&, PG8_LAS unsigned char*, int) const {}
    EpiRes R; float* part; unsigned* flags; unsigned* tmo;
    __device__ __forceinline__ void operator()(f32x4 (&acc)[2][2][4][2], const Unit& u, int, int, int, int, PG8_LAS unsigned char* lds) const {
        EPI_LANE_COORDS;
        float* pb = part + (size_t)u.aux * 65536 + (size_t)t_ * 4;
        unsigned* flag = flags + (size_t)u.aux * 64;
        if (u.kh == 1) {
#pragma unroll
            for (int ai = 0; ai < 2; ++ai)
#pragma unroll
                for (int bj = 0; bj < 2; ++bj)
#pragma unroll
                    for (int m = 0; m < 4; ++m)
#pragma unroll
                        for (int n = 0; n < 2; ++n) *(f32x4*)(pb + (size_t)(((ai * 2 + bj) * 4 + m) * 2 + n) * 2048) = acc[ai][bj][m][n];
            asm volatile("s_waitcnt vmcnt(0)" ::: "memory");
            __builtin_amdgcn_s_barrier(); asm volatile("" ::: "memory");
            if (t_ == 0) { __builtin_amdgcn_fence(__ATOMIC_RELEASE, "agent"); asm volatile("s_waitcnt vmcnt(0)" ::: "memory");
                __hip_atomic_store(flag, 1u, __ATOMIC_RELAXED, __HIP_MEMORY_SCOPE_AGENT); }
        } else {
            if (wid_ == 0) {
                unsigned sp = 0;
                while ((unsigned)__builtin_amdgcn_readfirstlane(__hip_atomic_load(flag, __ATOMIC_RELAXED, __HIP_MEMORY_SCOPE_AGENT)) == 0u) {
                    __builtin_amdgcn_s_sleep(2);
                    if ((++sp & 1023u) == 0u) { if (__builtin_amdgcn_readfirstlane(__hip_atomic_load(tmo, __ATOMIC_RELAXED, __HIP_MEMORY_SCOPE_AGENT)) != 0u) break;
                        if (sp > (1u << 22)) { if (t_ == 0) __hip_atomic_store(tmo, 1u, __ATOMIC_RELAXED, __HIP_MEMORY_SCOPE_AGENT); break; } } }
                __builtin_amdgcn_fence(__ATOMIC_ACQUIRE, "agent");
                asm volatile("s_waitcnt vmcnt(0)" ::: "memory");
            }
            __builtin_amdgcn_s_barrier(); asm volatile("" ::: "memory");
            R.run<true>(acc, u, wr, wc, fr, fq, pb, lds, t_);
        }
    }
};
struct DftOrder {
    int lat, first, count, G, c;
    __device__ __forceinline__ bool next(int i, Unit& u) const {
        const int nu = lat ? 128 : 32; const int k = c - first; if (k < 0 || k >= count) return false; const int id = k + i * count; if (id >= nu) return false;
        u.kh = 0; u.aux = 0;
        if (lat) { const int b = id >> 4, pmm = (id >> 1) & 7; u.pm = 16 + b * 8 + pmm; u.pn = id & 1; } else { u.pm = id >> 1; u.pn = id & 1; }
        return true;
    }
    __device__ __forceinline__ const char* aptr(const Unit& u, const Gemm& g) const { return lat ? (const char*)g.A + (size_t)((u.pm - 16) & 7) * ((size_t)BM * g.ld * 2) : (const char*)g.A; }
    __device__ __forceinline__ const char* bptr(const Unit& u, const Gemm& g) const { const int b = lat ? (u.pm - 16) >> 3 : u.pm; return (const char*)g.Bt + ((size_t)b * 512 + (size_t)u.pn * BM) * ((size_t)g.ld * 2); }
    __device__ __forceinline__ void a_ready(const Unit&) const {}
    __device__ __forceinline__ void done(const Unit&) const {}
};
template <class Epi, class Sched, bool ALIGN_EPI = false, bool SP2 = false>
__device__ __forceinline__ void gemm_phase(PG8_LAS unsigned char* lds, const Gemm g, const Sched& S, const Epi& E) {
    int tid = threadIdx.x; asm volatile("" : "+v"(tid));
    const int wid = __builtin_amdgcn_readfirstlane(tid >> 6), lane = tid & 63, wr = wid >> 2, wc = wid & 3, fr = lane & 15, fq = lane >> 4;
    const int K = g.ld, nt = g.K / BK;
    unsigned voffA[2], voffB[2];
#pragma unroll
    for (int i = 0; i < 2; ++i) { int R, C; stage_rc(tid * 16 + i * 8192, R, C); const int Rb = Epi::PERM ? ((R & ~31) + perm32(R & 31)) : R;
        voffA[i] = (unsigned)(R * K + C) * 2u; voffB[i] = (unsigned)(Rb * K + C) * 2u; }
    const size_t kstep = (size_t)(BK * 2);
    const size_t hstep = (size_t)HALF * K * 2;
    const size_t tstep = 2 * hstep;
    const unsigned ldsw = (unsigned)wid * 1024u;
    const int aoff = lds_byte(wr * 64 + fr, fq * 8), boff = lds_byte(wc * 32 + fr, fq * 8);
#define PG8_SA(b, h) (((b) * 2 + (h)) * HTB)
#define PG8_SB(b, h) ((4 + (b) * 2 + (h)) * HTB)
#define PG8_STAGE(bufoff, gbase, voff) do { _Pragma("unroll") for (int _i = 0; _i < 2; ++_i) \
        __builtin_amdgcn_global_load_lds((const unsigned*)((const char*)(gbase) + (voff)[_i]), (PG8_LAS unsigned*)(lds + (bufoff) + ldsw + _i * 8192), 16, 0, 0); } while (0)
#define PG8_LDA(dst, b, h) do { _Pragma("unroll") for (int m = 0; m < 4; ++m) _Pragma("unroll") for (int k = 0; k < 2; ++k) dst[m][k] = *(const PG8_LAS bf16x8*)(lds + PG8_SA(b, h) + aoff + m * 2048 + k * 1024); } while (0)
#define PG8_LDB(dst, b, h) do { _Pragma("unroll") for (int n = 0; n < 2; ++n) _Pragma("unroll") for (int k = 0; k < 2; ++k) dst[n][k] = *(const PG8_LAS bf16x8*)(lds + PG8_SB(b, h) + boff + n * 2048 + k * 1024); } while (0)
#define PG8_MMA(ai, bj, At, Bt) do { __builtin_amdgcn_s_setprio(1); _Pragma("unroll") for (int m = 0; m < 4; ++m) _Pragma("unroll") for (int n = 0; n < 2; ++n) _Pragma("unroll") for (int k = 0; k < 2; ++k) \
        acc[ai][bj][m][n] = __builtin_amdgcn_mfma_f32_16x16x32_bf16(Bt[n][k], At[m][k], acc[ai][bj][m][n], 0, 0, 0); __builtin_amdgcn_s_setprio(0); } while (0)
#define PG8_WAIT_V(n) asm volatile("s_waitcnt vmcnt(" #n ")" ::: "memory")
#define PG8_WAIT_L(n) asm volatile("s_waitcnt lgkmcnt(" #n ")" ::: "memory")
#define PG8_BAR __builtin_amdgcn_s_barrier()
#define PG8_SCHED __builtin_amdgcn_sched_barrier(0)
    Unit cur, nxt; int ui = 0;
    if (!S.next(0, cur)) return;
    f32x4 acc[2][2][4][2];
#pragma unroll
    for (int a = 0; a < 2; ++a)
#pragma unroll
        for (int b = 0; b < 2; ++b)
#pragma unroll
            for (int m = 0; m < 4; ++m)
#pragma unroll
                for (int n = 0; n < 2; ++n) acc[a][b][m][n] = (f32x4){0.f, 0.f, 0.f, 0.f};
    bf16x8 At[4][2], B0[2][2], B1[2][2];
    const char* cA = S.aptr(cur, g); const char* cB = S.bptr(cur, g);
    S.a_ready(cur);
    E.stage(cur, lds, 0);
    if constexpr (SP2) {
        PG8_STAGE(PG8_SB(0, 0), cB, voffB); PG8_STAGE(PG8_SB(0, 1), cB + hstep, voffB); PG8_STAGE(PG8_SA(0, 0), cA, voffA); PG8_STAGE(PG8_SA(0, 1), cA + hstep, voffA);
        if (wr == 1) PG8_BAR;
        PG8_WAIT_V(2); PG8_BAR;
        PG8_STAGE(PG8_SB(1, 0), cB + kstep, voffB); PG8_STAGE(PG8_SA(1, 0), cA + kstep, voffA); PG8_STAGE(PG8_SB(1, 1), cB + hstep + kstep, voffB);
        PG8_WAIT_V(6); PG8_BAR;
    } else {
        PG8_STAGE(PG8_SB(0, 0), cB, voffB); PG8_STAGE(PG8_SA(0, 0), cA, voffA); PG8_STAGE(PG8_SB(0, 1), cB + hstep, voffB); PG8_STAGE(PG8_SA(0, 1), cA + hstep, voffA);
        if (wr == 1) PG8_BAR;
        PG8_WAIT_V(4); PG8_BAR;
        PG8_STAGE(PG8_SB(1, 0), cB + kstep, voffB); PG8_STAGE(PG8_SA(1, 0), cA + kstep, voffA); PG8_STAGE(PG8_SB(1, 1), cB + hstep + kstep, voffB);
        PG8_WAIT_V(6); PG8_BAR;
    }
    for (;;) {
        const bool has_next = S.next(ui + 1, nxt);
        const char* nA = has_next ? S.aptr(nxt, g) : cA; const char* nB = has_next ? S.bptr(nxt, g) : cB;
        for (int t = 0; t < nt; t += 2) {
            const bool last = (t == nt - 2);
            const char* a1 = cA + (size_t)(t + 1) * kstep;
            const char* a2 = last ? nA : cA + (size_t)(t + 2) * kstep; const char* b2 = last ? nB : cB + (size_t)(t + 2) * kstep;
            const char* a3 = a2 + kstep; const char* b3 = b2 + kstep;
            if (last && has_next) S.a_ready(nxt);
            if constexpr (SP2) {
            PG8_LDB(B0, 0, 0); PG8_LDB(B1, 0, 1); PG8_SCHED; PG8_LDA(At, 0, 0); PG8_STAGE(PG8_SA(1, 1), a1 + hstep, voffA);
            PG8_WAIT_V(8); PG8_WAIT_L(0); PG8_BAR; PG8_MMA(0, 0, At, B0); PG8_MMA(0, 1, At, B1); PG8_BAR; PG8_SCHED;
            PG8_LDA(At, 0, 1); PG8_STAGE(PG8_SB(0, 0), b2, voffB); PG8_STAGE(PG8_SB(0, 1), b2 + hstep, voffB); PG8_STAGE(PG8_SA(0, 0), a2, voffA);
            PG8_WAIT_V(8); PG8_WAIT_L(0); PG8_BAR; PG8_MMA(1, 0, At, B0); PG8_MMA(1, 1, At, B1); PG8_BAR; PG8_SCHED;
            PG8_LDB(B0, 1, 0); PG8_LDB(B1, 1, 1); PG8_SCHED; PG8_LDA(At, 1, 0); PG8_STAGE(PG8_SA(0, 1), a2 + hstep, voffA);
            PG8_WAIT_V(8); PG8_WAIT_L(0); PG8_BAR; PG8_MMA(0, 0, At, B0); PG8_MMA(0, 1, At, B1); PG8_BAR; PG8_SCHED;
            PG8_LDA(At, 1, 1); PG8_STAGE(PG8_SB(1, 0), b3, voffB); PG8_STAGE(PG8_SB(1, 1), b3 + hstep, voffB); PG8_STAGE(PG8_SA(1, 0), a3, voffA);
            PG8_WAIT_V(8); PG8_WAIT_L(0); PG8_BAR; PG8_MMA(1, 0, At, B0); PG8_MMA(1, 1, At, B1); PG8_BAR; PG8_SCHED;
            } else {
            PG8_LDB(B0, 0, 0); PG8_SCHED; PG8_LDA(At, 0, 0); PG8_STAGE(PG8_SA(1, 1), a1 + hstep, voffA);
            PG8_WAIT_L(8); PG8_BAR; PG8_WAIT_L(0); PG8_MMA(0, 0, At, B0); PG8_BAR; PG8_SCHED;
            PG8_LDB(B1, 0, 1); PG8_STAGE(PG8_SB(0, 0), b2, voffB);
            PG8_BAR; PG8_WAIT_L(0); PG8_MMA(0, 1, At, B1); PG8_BAR;
            PG8_LDA(At, 0, 1); PG8_STAGE(PG8_SA(0, 0), a2, voffA);
            PG8_BAR; PG8_WAIT_L(0); PG8_MMA(1, 0, At, B0); PG8_BAR; PG8_SCHED;
            PG8_STAGE(PG8_SB(0, 1), b2 + hstep, voffB);
            PG8_WAIT_V(6); PG8_BAR; PG8_MMA(1, 1, At, B1); PG8_BAR;
            PG8_LDB(B0, 1, 0); PG8_SCHED; PG8_LDA(At, 1, 0); PG8_STAGE(PG8_SA(0, 1), a2 + hstep, voffA);
            PG8_WAIT_L(8); PG8_BAR; PG8_WAIT_L(0); PG8_MMA(0, 0, At, B0); PG8_BAR; PG8_SCHED;
            PG8_LDB(B1, 1, 1); PG8_STAGE(PG8_SB(1, 0), b3, voffB);
            PG8_BAR; PG8_WAIT_L(0); PG8_MMA(0, 1, At, B1); PG8_BAR;
            PG8_LDA(At, 1, 1); PG8_STAGE(PG8_SA(1, 0), a3, voffA);
            PG8_BAR; PG8_WAIT_L(0); PG8_MMA(1, 0, At, B0); PG8_BAR; PG8_SCHED;
            PG8_STAGE(PG8_SB(1, 1), b3 + hstep, voffB);
            PG8_WAIT_V(6); PG8_BAR; PG8_MMA(1, 1, At, B1); PG8_BAR;
            }
        }
        if constexpr (ALIGN_EPI) { if (wr == 0) PG8_BAR; }
        if constexpr (!Epi::AFTER_DRAIN) { E(acc, cur, ui, 0, 0, 0, lds); S.done(cur); }
        if (!has_next) break;
#pragma unroll
        for (int a = 0; a < 2; ++a)
#pragma unroll
            for (int b = 0; b < 2; ++b)
#pragma unroll
                for (int m = 0; m < 4; ++m)
#pragma unroll
                    for (int n = 0; n < 2; ++n) acc[a][b][m][n] = (f32x4){0.f, 0.f, 0.f, 0.f};
        cur = nxt; cA = nA; cB = nB; ++ui;
        E.stage(cur, lds, ui);
        if constexpr (ALIGN_EPI) { if (wr == 1) PG8_BAR; }
    }
    PG8_WAIT_V(0);
    if constexpr (!ALIGN_EPI) { if (wr == 0) PG8_BAR; }
    PG8_BAR;
    if constexpr (Epi::AFTER_DRAIN) { E.fused(acc, cur, wr, wc, fr, fq, lds, wid, lane); S.done(cur); }
#undef PG8_SA
#undef PG8_SB
#undef PG8_STAGE
#undef PG8_LDA
#undef PG8_LDB
#undef PG8_MMA
#undef PG8_WAIT_V
#undef PG8_WAIT_L
#undef PG8_BAR
#undef PG8_SCHED
}
}
namespace att {
constexpr int DV = 128, NW = 8, QBLK = 32, KVBLK = 64;
constexpr float THR = 8.f;
constexpr size_t SHM_V = KVBLK * DV * 2, SHM_K = KVBLK * DV * 2, SHM_ATTN = 2 * SHM_V + 2 * SHM_K + NW * 64 * 4;
using s16x4 = __attribute__((ext_vector_type(4))) short;
using f32x16 = __attribute__((ext_vector_type(16))) float;
#define KSWZ(row, colB) ((row) * 256 + ((colB) ^ (((row) & 7) << 4)))
#define SBAR() __builtin_amdgcn_sched_barrier(0)
__device__ __forceinline__ int crow(int r, int hi) { return (r & 3) + 8 * (r >> 2) + 4 * hi; }
__device__ __forceinline__ unsigned cvtpk(float lo, float hi) { unsigned r; asm volatile("v_cvt_pk_bf16_f32 %0, %1, %2" : "=v"(r) : "v"(lo), "v"(hi)); return r; }

template <int DQK>
__device__ __forceinline__ void partialSM(f32x16& p0, f32x16& p1, float& m_reg, float& mn, float& alpha) {
  constexpr float SCALE = DQK == 128 ? 0.088388347648318440f : 0.125f;
  constexpr float C = SCALE * 1.4426950408889634f;
  float pmax = p0[0];
#pragma unroll
  for (int r = 1; r < 16; ++r) pmax = fmaxf(pmax, p0[r]);
#pragma unroll
  for (int r = 0; r < 16; ++r) pmax = fmaxf(pmax, p1[r]);
  { auto rr = __builtin_amdgcn_permlane32_swap(__float_as_uint(pmax), __float_as_uint(pmax), false, false);
    pmax = fmaxf(__uint_as_float(rr[0]), __uint_as_float(rr[1])); }
  if (__builtin_expect(__all(pmax - m_reg <= THR / SCALE), 1)) { mn = m_reg; alpha = 1.f; }
  else { mn = fmaxf(m_reg, pmax); alpha = __builtin_amdgcn_exp2f((m_reg - mn) * C); m_reg = mn; }
  float mnC = -mn * C;
#pragma unroll
  for (int r = 0; r < 16; ++r) p0[r] = fmaf(p0[r], C, mnC);
#pragma unroll
  for (int r = 0; r < 16; ++r) p1[r] = fmaf(p1[r], C, mnC);
#pragma unroll
  for (int r = 0; r < 16; ++r) p0[r] = __builtin_amdgcn_exp2f(p0[r]);
}
__device__ __forceinline__ void finishSM(f32x16& p0, f32x16& p1, float alpha, float& l_reg, bf16x8& pa0, bf16x8& pa1, bf16x8& pa2, bf16x8& pa3) {
#pragma unroll
  for (int r = 0; r < 16; ++r) p1[r] = __builtin_amdgcn_exp2f(p1[r]);
  float ps = 0;
#pragma unroll
  for (int r = 0; r < 16; ++r) ps += p0[r];
#pragma unroll
  for (int r = 0; r < 16; ++r) ps += p1[r];
  { auto rr = __builtin_amdgcn_permlane32_swap(__float_as_uint(ps), __float_as_uint(ps), false, false);
    ps = __uint_as_float(rr[0]) + __uint_as_float(rr[1]); }
  l_reg = l_reg * alpha + ps;
#define PK4(P, BASE, OUT) do { unsigned a0 = cvtpk(P[BASE + 0], P[BASE + 1]), a1 = cvtpk(P[BASE + 2], P[BASE + 3]);   \
    unsigned b0 = cvtpk(P[BASE + 4], P[BASE + 5]), b1 = cvtpk(P[BASE + 6], P[BASE + 7]);                              \
    auto r0 = __builtin_amdgcn_permlane32_swap(a0, b0, false, false); auto r1 = __builtin_amdgcn_permlane32_swap(a1, b1, false, false); \
    u32x4 w = {r0[0], r1[0], r0[1], r1[1]}; OUT = *reinterpret_cast<bf16x8*>(&w); } while (0)
  PK4(p0, 0, pa0); PK4(p0, 8, pa1); PK4(p1, 0, pa2); PK4(p1, 8, pa3);
#undef PK4
}
template <int DQK>
__device__ __forceinline__ void qkt(f32x16& p0, f32x16& p1, const char* Ks, const bf16x8* qr, int r32, int hi, int koffB) {
  p0 = f32x16{}; p1 = f32x16{};
  Ks += koffB;
#pragma unroll
  for (int d0 = 0; d0 < DQK / 16; ++d0) { int cb = (d0 * 16 + hi * 8) * 2;
    bf16x8 b0 = *reinterpret_cast<const bf16x8*>(Ks + KSWZ(r32, cb));
    bf16x8 b1 = *reinterpret_cast<const bf16x8*>(Ks + KSWZ(32 + r32, cb));
    p0 = __builtin_amdgcn_mfma_f32_32x32x16_bf16(b0, qr[d0], p0, 0, 0, 0);
    p1 = __builtin_amdgcn_mfma_f32_32x32x16_bf16(b1, qr[d0], p1, 0, 0, 0); }
}
__device__ __forceinline__ int v_st(int k, int c) { const int kk = (k & ~0xC) | ((k & 4) << 1) | ((k & 8) >> 1); return ((kk >> 3) * 4 + (c >> 5)) * 512 + ((kk & 7) * 32 + (c & 31)) * 2; }
__device__ __forceinline__ int v_rd_base(int lane) { return ((lane & 3) << 3) | (((lane >> 2) & 3) << 6) | (((lane >> 4) & 1) << 5) | (((lane >> 5) & 1) << 8); }
constexpr int v_rd_off(int d0, int ks, int half) { return d0 * 512 + ks * 4096 + half * 2048; }
template <int OFF> __device__ __forceinline__ s16x4 tr_read(int vb) {
  s16x4 r; asm volatile("ds_read_b64_tr_b16 %0, %1 offset:%2" : "=&v"(r) : "v"(vb), "i"(OFF) : "memory"); return r;
}
template <int D0> __device__ __forceinline__ void pv_one(f32x16& od, int vb, bf16x8 pa0, bf16x8 pa1, bf16x8 pa2, bf16x8 pa3) {
  const s16x4 l0 = tr_read<v_rd_off(D0, 0, 0)>(vb), h0 = tr_read<v_rd_off(D0, 0, 1)>(vb), l1 = tr_read<v_rd_off(D0, 1, 0)>(vb), h1 = tr_read<v_rd_off(D0, 1, 1)>(vb);
  const s16x4 l2 = tr_read<v_rd_off(D0, 2, 0)>(vb), h2 = tr_read<v_rd_off(D0, 2, 1)>(vb), l3 = tr_read<v_rd_off(D0, 3, 0)>(vb), h3 = tr_read<v_rd_off(D0, 3, 1)>(vb);
  asm volatile("s_waitcnt lgkmcnt(0)" ::: "memory"); SBAR();
#define PK(L, H) (bf16x8){L[0], L[1], L[2], L[3], H[0], H[1], H[2], H[3]}
  od = __builtin_amdgcn_mfma_f32_32x32x16_bf16(pa0, PK(l0, h0), od, 0, 0, 0);
  od = __builtin_amdgcn_mfma_f32_32x32x16_bf16(pa1, PK(l1, h1), od, 0, 0, 0);
  od = __builtin_amdgcn_mfma_f32_32x32x16_bf16(pa2, PK(l2, h2), od, 0, 0, 0);
  od = __builtin_amdgcn_mfma_f32_32x32x16_bf16(pa3, PK(l3, h3), od, 0, 0, 0);
#undef PK
}
__device__ __forceinline__ void pv_d0(f32x16* o, int vb, bf16x8 pa0, bf16x8 pa1, bf16x8 pa2, bf16x8 pa3) {
  pv_one<0>(o[0], vb, pa0, pa1, pa2, pa3); pv_one<1>(o[1], vb, pa0, pa1, pa2, pa3); pv_one<2>(o[2], vb, pa0, pa1, pa2, pa3); pv_one<3>(o[3], vb, pa0, pa1, pa2, pa3);
}
template <int DQK, int LDQ, int LDK>
__device__ __forceinline__ void body(const bf16_t* __restrict__ Qb, const bf16_t* __restrict__ Kh, const bf16_t* __restrict__ Vh, int seq, int koffB, char* lds, f32x16 (&o)[4], float (&rli)[16]) {
  int tid = threadIdx.x; asm volatile("" : "+v"(tid));
  const int wid = tid >> 6, lane = tid & 63, r32 = lane & 31, hi = lane >> 5;
  char* V_lds = lds; char* K_lds = lds + 2 * SHM_V;
  float* ws = (float*)(lds + 2 * SHM_V + 2 * SHM_K) + wid * 64; float* li_l = ws; float* al_l = ws + 32;
  float m_reg = -1e30f, l_reg = 0;
#pragma unroll
  for (int d = 0; d < 4; ++d) o[d] = f32x16{};
  bf16x8 qr[DQK / 16];
  const bf16_t* Qw = Qb + (long)(wid * QBLK + r32) * LDQ + hi * 8;
#pragma unroll
  for (int d0 = 0; d0 < DQK / 16; ++d0) qr[d0] = *reinterpret_cast<const bf16x8*>(Qw + d0 * 16);
  const int sr = tid >> 4, sc = (tid & 15) * 8, vst0 = v_st(sr, sc), vst1 = v_st(32 + sr, sc);
  const int vb0 = (int)(uintptr_t)V_lds + v_rd_base(lane);
  bf16x8 sv0a, sv1a, sk0a, sk1a, sv0b, sv1b, sk0b, sk1b;
#define SLOAD_A(k0) do { sv0a = *(const bf16x8*)&Vh[(long)((k0) + sr) * LDK + sc]; sv1a = *(const bf16x8*)&Vh[(long)((k0) + 32 + sr) * LDK + sc]; \
    sk0a = *(const bf16x8*)&Kh[(long)((k0) + sr) * LDK + sc]; sk1a = *(const bf16x8*)&Kh[(long)((k0) + 32 + sr) * LDK + sc]; } while (0)
#define SLOAD_B(k0) do { sv0b = *(const bf16x8*)&Vh[(long)((k0) + sr) * LDK + sc]; sv1b = *(const bf16x8*)&Vh[(long)((k0) + 32 + sr) * LDK + sc]; \
    sk0b = *(const bf16x8*)&Kh[(long)((k0) + sr) * LDK + sc]; sk1b = *(const bf16x8*)&Kh[(long)((k0) + 32 + sr) * LDK + sc]; } while (0)
#define SWRITE(b, V0, V1, K0, K1) do { *(bf16x8*)(V_lds + (b) * SHM_V + vst0) = V0; *(bf16x8*)(V_lds + (b) * SHM_V + vst1) = V1; const int kc = sc * 2; \
    *(bf16x8*)(K_lds + (b) * SHM_K + KSWZ(sr, kc)) = K0; *(bf16x8*)(K_lds + (b) * SHM_K + KSWZ(32 + sr, kc)) = K1; } while (0)
#define SWAIT() asm volatile("s_waitcnt vmcnt(4)" ::: "memory")
#define RESC(a) do { if (__any((a) < 1.f)) { if (hi == 0) al_l[r32] = (a); asm volatile("s_waitcnt lgkmcnt(0)" ::: "memory"); \
    _Pragma("unroll") for (int d = 0; d < 4; ++d) _Pragma("unroll") for (int r = 0; r < 16; ++r) o[d][r] *= al_l[crow(r, hi)]; } } while (0)
  f32x16 pA0, pA1, pB0, pB1; float mnA, mnB, alA, alB; bf16x8 pa0, pa1, pa2, pa3; const int NT = seq / KVBLK;
  SLOAD_A(0); asm volatile("s_waitcnt vmcnt(0)" ::: "memory"); SWRITE(0, sv0a, sv1a, sk0a, sk1a); __syncthreads();
  qkt<DQK>(pA0, pA1, K_lds, qr, r32, hi, koffB); partialSM<DQK>(pA0, pA1, m_reg, mnA, alA);
  SLOAD_B(KVBLK); if (2 < NT) SLOAD_A(2 * KVBLK);
  SWAIT(); SWRITE(1, sv0b, sv1b, sk0b, sk1b); __syncthreads();
  for (int j = 1; j + 1 < NT; j += 2) {
    SBAR(); qkt<DQK>(pB0, pB1, K_lds + SHM_K, qr, r32, hi, koffB);
    finishSM(pA0, pA1, alA, l_reg, pa0, pa1, pa2, pa3); SBAR();
    SLOAD_B((j + 2) * KVBLK); SBAR();
    pv_d0(o, vb0, pa0, pa1, pa2, pa3); partialSM<DQK>(pB0, pB1, m_reg, mnB, alB);
    __syncthreads(); SWAIT(); SWRITE(0, sv0a, sv1a, sk0a, sk1a);
    RESC(alB); __syncthreads();
    SBAR(); qkt<DQK>(pA0, pA1, K_lds, qr, r32, hi, koffB);
    finishSM(pB0, pB1, alB, l_reg, pa0, pa1, pa2, pa3); SBAR();
    if (j + 3 < NT) SLOAD_A((j + 3) * KVBLK); SBAR();
    pv_d0(o, vb0 + (int)SHM_V, pa0, pa1, pa2, pa3); partialSM<DQK>(pA0, pA1, m_reg, mnA, alA);
    __syncthreads(); SWAIT(); SWRITE(1, sv0b, sv1b, sk0b, sk1b);
    RESC(alA); __syncthreads();
  }
  SBAR(); qkt<DQK>(pB0, pB1, K_lds + SHM_K, qr, r32, hi, koffB);
  finishSM(pA0, pA1, alA, l_reg, pa0, pa1, pa2, pa3); SBAR();
  pv_d0(o, vb0, pa0, pa1, pa2, pa3); partialSM<DQK>(pB0, pB1, m_reg, mnB, alB);
  __syncthreads(); RESC(alB);
  finishSM(pB0, pB1, alB, l_reg, pa0, pa1, pa2, pa3); SBAR();
  pv_d0(o, vb0 + (int)SHM_V, pa0, pa1, pa2, pa3);
  if (hi == 0) li_l[r32] = l_reg; asm volatile("s_waitcnt lgkmcnt(0)" ::: "memory");
#pragma unroll
  for (int r = 0; r < 16; ++r) rli[r] = __builtin_amdgcn_rcpf(li_l[crow(r, hi)]);
  __syncthreads();
#undef SLOAD_A
#undef SLOAD_B
#undef SWRITE
#undef SWAIT
#undef RESC
}
#undef KSWZ
#undef SBAR
}
#define GAS __attribute__((address_space(1)))
#define LAS __attribute__((address_space(3)))
typedef GAS unsigned gu32;
#define RLX_AGENT __ATOMIC_RELAXED, __HIP_MEMORY_SCOPE_AGENT
#define XB_TMO      128
#define XB_XCNT(j)  (256  + 64 * (j))
#define XB_XSUB(j)  (1280 + 64 * (j))
#define XB_XGEN(j)  (2304 + 64 * (j))
#define XB_TOP      3328
#define XB_TOPGEN   3392
#define XCD_BAR_WORDS 3456
#define XB_SPIN_CAP (1u << 18)

__device__ __forceinline__ unsigned xb_ld(unsigned* p)              { return __hip_atomic_load(p, __ATOMIC_RELAXED, __HIP_MEMORY_SCOPE_AGENT); }
__device__ __forceinline__ unsigned xb_add(unsigned* p, unsigned v) { return __hip_atomic_fetch_add(p, v, __ATOMIC_RELAXED, __HIP_MEMORY_SCOPE_AGENT); }
__device__ __forceinline__ unsigned xb_xcc_id() { return (unsigned)__builtin_amdgcn_s_getreg((3 << 11) | 20) & 0xFu; }
#define XB_SPIN(cond, bar) do { unsigned _sp = 0; while (cond) { __builtin_amdgcn_s_sleep(1); \
    if ((++_sp & 255u) == 0u) { if (xb_ld(&(bar)[XB_TMO])) break; if (_sp > XB_SPIN_CAP) { atomicAdd(&(bar)[XB_TMO], 1u); break; } } } } while (0)

struct XcdBarrier {
    unsigned* bar; unsigned x;
    volatile LAS unsigned* st;
};

__device__ __forceinline__ XcdBarrier xcd_barrier_post(unsigned* bar, volatile LAS unsigned* st) {
    XcdBarrier b; b.bar = bar; b.x = xb_xcc_id(); b.st = st;
    if (threadIdx.x == 0) (void)xb_add(&bar[XB_XCNT(b.x)], 1u);
    return b;
}
__device__ __forceinline__ void xcd_barrier_complete(unsigned* bar, unsigned x, unsigned& nloc, unsigned& nx) {
    const unsigned G = gridDim.x * gridDim.y * gridDim.z;
    unsigned sum, cnt, mine, sp = 0u;
    for (;;) {
        sum = 0u; cnt = 0u; mine = 0u;
#pragma unroll
        for (unsigned j = 0; j < 16; ++j) { const unsigned c = xb_ld(&bar[XB_XCNT(j)]); sum += c; cnt += (c > 0u) ? 1u : 0u; mine = (j == x) ? c : mine; }
        if (sum == G) break;
        __builtin_amdgcn_s_sleep(1);
        if ((++sp & 255u) == 0u) { if (xb_ld(&bar[XB_TMO])) break; if (sp > XB_SPIN_CAP) { atomicAdd(&bar[XB_TMO], 1u); break; } }
    }
    nloc = mine > 0u ? mine : 1u; nx = cnt > 0u ? cnt : 1u;
}

__device__ __forceinline__ void xcd_barrier(const XcdBarrier& b) {
    asm volatile("s_waitcnt vmcnt(0)" ::: "memory");
    __syncthreads();
    if (threadIdx.x == 0) {
        unsigned* bar = b.bar;
        __builtin_amdgcn_s_waitcnt(0);
        unsigned nloc = b.st[0], nx = b.st[1];
        if (nloc == 0u) { xcd_barrier_complete(bar, b.x, nloc, nx); b.st[0] = nloc; b.st[1] = nx; }
        const unsigned old = xb_add(&bar[XB_XSUB(b.x)], 1u);
        const unsigned gen = old / nloc;
        if (old + 1u == (gen + 1u) * nloc) {
            __builtin_amdgcn_fence(__ATOMIC_RELEASE, "agent");
            asm volatile("s_waitcnt vmcnt(0)" ::: "memory");
            const unsigned og = xb_add(&bar[XB_TOP], 1u);
            const unsigned tg = og / nx;
            if (og + 1u == (tg + 1u) * nx) xb_add(&bar[XB_TOPGEN], 1u);
            else XB_SPIN(xb_ld(&bar[XB_TOPGEN]) == tg, bar);
            __builtin_amdgcn_fence(__ATOMIC_ACQUIRE, "agent");
            xb_add(&bar[XB_XGEN(b.x)], 1u);
            asm volatile("s_waitcnt vmcnt(0)" ::: "memory");
        } else {
            XB_SPIN(xb_ld(&bar[XB_XGEN(b.x)]) == gen, bar);
            __builtin_amdgcn_fence(__ATOMIC_ACQUIRE, "agent");
            asm volatile("s_waitcnt vmcnt(0)" ::: "memory");
        }
    }
    __syncthreads();
}

#ifndef DUP_MASK
#define DUP_MASK 0
#endif
#ifndef PROLOGUE_IN_KERNEL
#define PROLOGUE_IN_KERNEL 1
#endif
#ifndef MIX_PARTS
#define MIX_PARTS 7
#endif
#ifndef PH_MASK
#define PH_MASK 0x7f
#endif
constexpr int NWAVES = 8;
constexpr int RING_BYTES = 131072;
constexpr int PTAB_OFF = RING_BYTES;
constexpr int MISC_OFF = PTAB_OFF + 8192;
constexpr int LDS_BYTES = 159744;
static_assert(pg8::STAGE_BYTES == RING_BYTES && MISC_OFF + 128 <= pg8::EPIX_OFF && pg8::EPIX_END <= LDS_BYTES && (int)att::SHM_ATTN <= RING_BYTES, "LDS map");
constexpr int CW_TMO = 64;
constexpr int CW_FLAG = 16384;
constexpr int CW_BAR = 4096;
constexpr int N_PHASES = 3 + 5 * DEPTH;

struct MegaArgs { const float* in[26]; float* out; unsigned char* ws; int ph_lo, ph_hi, pad0, pad1; };

__device__ __forceinline__ void attn_a_unit(const Ptrs& P, size_t row0, const bf16_t* Kb, const bf16_t* Vb, int seq, int h, char* lds) {
    att::f32x16 o[4]; float rli[16];
    att::body<128, 1024, 256>(P.QA + row0 * 1024 + h * 128, Kb + (h >> 2) * 128, Vb + (h >> 2) * 128, seq, 0, lds, o, rli);
    int tid = threadIdx.x; asm volatile("" : "+v"(tid));
    const int wid = tid >> 6, lane = tid & 63, r32 = lane & 31, hi = lane >> 5;
    bf16_t* ob = P.MIX + (row0 + wid * 32) * D + h * 128 + r32;
#pragma unroll
    for (int r = 0; r < 16; ++r) { const int orow = att::crow(r, hi);
#pragma unroll
        for (int d0 = 0; d0 < 4; ++d0) ob[(size_t)orow * D + d0 * 32] = (bf16_t)f2bf(o[d0][r] * rli[r]); }
}
__device__ __forceinline__ void attn_b_unit(const Ptrs& P, size_t row0, const bf16_t* Kb, const bf16_t* Vb, int seq, int h, int l, char* lds) {
    float* slot = P.OTMP + (size_t)blockIdx.x * (2 * 256 * 128);
#pragma unroll 1
    for (int c = 0; c < 2; ++c) {
        att::f32x16 o[4]; float rli[16];
        att::body<64, 512, 512>(P.QB + row0 * 512 + h * 128 + c * 64, Kb + h * 128, Vb + h * 128, seq, c * 128, lds, o, rli);
        int tid = threadIdx.x; asm volatile("" : "+v"(tid));
        const int wid = tid >> 6, lane = tid & 63, r32 = lane & 31, hi = lane >> 5;
        float* o1 = slot + (size_t)c * (256 * 128) + (size_t)(wid * 32) * 128 + r32;
#pragma unroll
        for (int r = 0; r < 16; ++r) { const int orow = att::crow(r, hi);
#pragma unroll
            for (int d0 = 0; d0 < 4; ++d0) o1[(size_t)orow * 128 + d0 * 32] = o[d0][r] * rli[r]; }
    }
    asm volatile("s_waitcnt vmcnt(0)" ::: "memory"); __syncthreads();
    {   int tid = threadIdx.x; asm volatile("" : "+v"(tid));
        const int wid = tid >> 6, lane = tid & 63;
        const float lam = P.LAM[l]; const float post = 1.0f - lambda_init_of(l); const float g0 = P.subln[l * 128 + lane], g1 = P.subln[l * 128 + 64 + lane];
#pragma unroll 4
        for (int i = 0; i < 32; ++i) { const int row = wid * 32 + i; const float* a = slot + (size_t)row * 128 + lane; const float* b = a + 256 * 128;
            const float v0 = a[0] - lam * b[0], v1 = a[64] - lam * b[64];
            const float rinv = __builtin_amdgcn_rsqf(wave_sum(v0 * v0 + v1 * v1) * (1.0f / 128.0f) + EPS) * post;
            bf16_t* ob = P.MIX + (row0 + row) * D + 1024 + h * 128 + lane;
            ob[0] = (bf16_t)f2bf(v0 * rinv * g0); ob[64] = (bf16_t)f2bf(v1 * rinv * g1); }
    }
    __syncthreads();
}

__device__ __forceinline__ void x0_row(const float* __restrict__ xrow, float* __restrict__ xcopy, const float* __restrict__ g, const float* __restrict__ scale, bf16_t* __restrict__ xa, float* __restrict__ ssrow, int lane) {
    f32x4 v[8]; float ss = 0.f;
#pragma unroll
    for (int j = 0; j < 8; ++j) { v[j] = *(const f32x4*)(xrow + lane * 4 + 256 * j); ss += (v[j][0] * v[j][0] + v[j][1] * v[j][1]) + (v[j][2] * v[j][2] + v[j][3] * v[j][3]); }
#pragma unroll
    for (int j = 0; j < 8; ++j) *(f32x4*)(xcopy + lane * 4 + 256 * j) = v[j];
    ss = wave_sum(ss); if (lane < 8) ssrow[lane] = (lane == 0) ? ss : 0.f;
#pragma unroll
    for (int j = 0; j < 8; ++j) { const int c = lane * 4 + 256 * j; const f32x4 o = v[j] * (*(const f32x4*)(g + c)) * (*(const f32x4*)(scale + c) + 1.0f);
        *(u32x2*)(xa + c) = (u32x2){pk2(o[0], o[1]), pk2(o[2], o[3])}; }
}
__device__ __forceinline__ void bias_row(const bf16_t* __restrict__ btrow, const float* sh, float* __restrict__ bias_r, int bias_stride, int lane) {
    f32x4 wl[4], wh[4];
#pragma unroll
    for (int j = 0; j < 4; ++j) { const u32x4 q = *(const u32x4*)(btrow + lane * 8 + 512 * j);
        wl[j] = (f32x4){__builtin_bit_cast(float, q.x << 16), __builtin_bit_cast(float, q.x & 0xffff0000u), __builtin_bit_cast(float, q.y << 16), __builtin_bit_cast(float, q.y & 0xffff0000u)};
        wh[j] = (f32x4){__builtin_bit_cast(float, q.z << 16), __builtin_bit_cast(float, q.z & 0xffff0000u), __builtin_bit_cast(float, q.w << 16), __builtin_bit_cast(float, q.w & 0xffff0000u)}; }
#pragma unroll 1
    for (int c = 0; c < NCOND; ++c) { f32x4 s4 = (f32x4){0.f, 0.f, 0.f, 0.f};
#pragma unroll
        for (int j = 0; j < 4; ++j) { const f32x4 a = *(const f32x4*)(sh + c * D + lane * 8 + 512 * j), b = *(const f32x4*)(sh + c * D + lane * 8 + 512 * j + 4); s4 = s4 + wl[j] * a + wh[j] * b; }
        float s = wave_sum((s4[0] + s4[1]) + (s4[2] + s4[3])); if (lane == 0) bias_r[(size_t)c * bias_stride] = s; }
}

__global__ void __launch_bounds__(NWAVES * 64, 2) mega(MegaArgs args) {
    extern __shared__ __attribute__((aligned(16))) unsigned char lds[];
    LAS unsigned char* L = (LAS unsigned char*)lds;
    volatile LAS unsigned* MISC = (volatile LAS unsigned*)(L + MISC_OFF);
    const int G = gridDim.x, bx = blockIdx.x;
    gu32* ctl = (gu32*)(args.ws + WS_CTL);
    for (int u = threadIdx.x; u < 32; u += NWAVES * 64) ((LAS unsigned*)(L + MISC_OFF))[u] = 0u;
    __syncthreads();
    XcdBarrier bar = xcd_barrier_post((unsigned*)(ctl + CW_BAR), MISC + 8);
    const int lo = args.ph_lo, hi = args.ph_hi;
#define IN(k) (lo <= (k) && (k) < hi)
#define PHASE_P int tid = threadIdx.x; asm volatile("" : "+v"(tid)); const int lane = tid & 63, wave = __builtin_amdgcn_readfirstlane(tid >> 6); (void)lane; (void)wave; unsigned char* wsp_ = args.ws; asm volatile("" : "+s"(wsp_)); const Ptrs P = make_ptrs_hd(args.in, args.out, wsp_); const float* mod_l = P.MOD + (size_t)l * NCOND * NMOD; (void)mod_l; float* const SS = (float*)(wsp_ + WS_SS); (void)SS
#define SEAM(k) do { if (IN(k) && IN((k) + 1)) xcd_barrier(bar); } while (0)
    if (IN(0)) {
        const int l = 0; PHASE_P;
        const int t = tid & 255, hf = __builtin_amdgcn_readfirstlane(tid >> 8), hw = bx * 2 + hf, NHW = 2 * G;
        float* sm = (float*)(lds + hf * 40960);
        for (int v0 = 0; v0 < 192; v0 += NHW) { const int vb = v0 + hw; prep_ada_vb(P.c, P.c_ctx, P.w_ada, P.b_ada, P.MOD, vb % 48, vb / 48, t, (float(*)[128])sm, vb < 192); }
#define TR_LOOP(W, K, LDW, WST, BT, BST, MODE, NX, NY) for (int v0 = 0; v0 < (NX) * (NY) * DEPTH; v0 += NHW) { const int vb = v0 + hw; \
            prep_transpose_vb(W, K, LDW, WST, BT, BST, MODE, vb % (NX), (vb / (NX)) % (NY), vb / ((NX) * (NY)), t, (float(*)[129])sm, vb < (NX) * (NY) * DEPTH); }
        TR_LOOP(P.w_in, D, N_INRAW, (size_t)D * N_INRAW, P.BT_IN, (size_t)N_IN * D, 1, D / 32, 3072 / 128)
        TR_LOOP(P.w_out, D, D, (size_t)D * D, P.BT_OUT, (size_t)D * D, 0, D / 32, D / 128)
        TR_LOOP(P.w_mi, D, DFF, (size_t)D * DFF, P.BT_MI, (size_t)DFF * D, 0, D / 32, DFF / 128)
        TR_LOOP(P.w_mo, DFF, D, (size_t)DFF * D, P.BT_MO, (size_t)D * DFF, 0, DFF / 32, D / 128)
#undef TR_LOOP
        {   float* ct = sm; float* st = sm + 128;
            if (t < 128) { float s, c; sincospif((float)t / 64.0f, &s, &c); ct[t] = c; st[t] = s; }
            __syncthreads();
            for (size_t idx = (size_t)hw * 256 + t; idx < (size_t)DEPTH * 4 * 2 * 128 * 128; idx += (size_t)NHW * 256) prep_G_idx(P.w_fourier, P.G, idx, ct, st);
            __syncthreads(); }
        prep_tables_gs(P.ROPE, P.DFT_L, P.DFT_C, P.LAM, P.lq1, P.lk1, P.lq2, P.lk2, (float*)(P.ws + WS_GAIN), P.qn_a, P.kn_a, P.qn_b, P.kn_b, (size_t)bx * 512 + tid, (size_t)G * 512);
        prep_cache_gs(P.cak, P.cav, P.cdk, P.cdv, P.KAL, P.VAL, P.KBL, P.VBL, (size_t)bx * 512 + tid, (size_t)G * 512);
    }
    SEAM(0);
    if (IN(1)) {
        const int l = 0; PHASE_P;
        const int gw = bx * NWAVES + wave, NGW = G * NWAVES;
        for (int row = gw; row < M_ALL; row += NGW) {
            const float* xrow = row < M_CTX ? P.x_prompt + (size_t)row * D : P.x_sample + (size_t)(row - M_CTX) * D;
            x0_row(xrow, P.out + (size_t)row * D, P.g_mix, mod_l + (size_t)cond_of_row(row) * NMOD + D, P.H + (size_t)row * D, SS + (size_t)row * 8, lane);
        }
        const int t = tid & 255, hf = __builtin_amdgcn_readfirstlane(tid >> 8), hw = bx * 2 + hf, NHW = 2 * G;
        float* sm = (float*)(lds + hf * 40960);
        for (int v0 = 0; v0 < 32 * 4 * DEPTH; v0 += NHW) { const int vb = v0 + hw; prep_fold_vb(P.w_in, P.G, P.BT_IN, vb & 31, (vb >> 5) & 3, vb >> 7, t, (float(*)[132])sm, vb < 32 * 4 * DEPTH); }
    }
    SEAM(1);
    if (IN(2)) {
        const int l = 0; PHASE_P;
        float* sh = (float*)lds;
        for (int item = bx; item < 8 * 32; item += G) {
            const int combo = item & 7, sub = item >> 3, ll = combo >> 1, which = combo & 1;
            const float* shsrc = P.MOD + (size_t)ll * NCOND * NMOD + (size_t)(which ? 3 : 0) * D;
            for (int i = tid; i < NCOND * D / 4; i += NWAVES * 64) { const int c = i / (D / 4), k4 = i % (D / 4); *(f32x4*)(sh + c * D + k4 * 4) = *(const f32x4*)(shsrc + (size_t)c * NMOD + k4 * 4); }
            __syncthreads();
            const int nrows = which ? DFF : N_IN, rps = nrows / 32;
            const bf16_t* bt = which ? P.BT_MI + (size_t)ll * DFF * D : P.BT_IN + (size_t)ll * N_IN * D;
            float* bo = which ? (float*)(P.ws + WS_BIAS_MI) + (size_t)ll * NCOND * DFF : (float*)(P.ws + WS_BIAS_IN) + (size_t)ll * NCOND * N_IN;
            for (int r = sub * rps + wave; r < (sub + 1) * rps; r += NWAVES) bias_row(bt + (size_t)r * D, sh, bo + r, nrows, lane);
            __syncthreads();
        }
    }
    SEAM(2);
#pragma unroll 1
    for (int l = 0; l < DEPTH; ++l) {
        const int pb = 3 + 5 * l;
        if (IN(pb + 0)) { PHASE_P;
            pg8::Gemm g{P.H, P.BT_IN + (size_t)l * N_IN * D, M_ALL, N_IN, D, D}; pg8::StaticOrder S; S.init(M_ALL, N_IN, G, bx);
            pg8::EpiIn E{l, P.ws, P.out, SS + (size_t)(2 * l) * M_ALL * 8, (const float*)(P.ws + WS_BIAS_IN) + (size_t)l * NCOND * N_IN};
            pg8::gemm_phase<pg8::EpiIn, pg8::StaticOrder, true, true>(L, g, S, E);
        }
        SEAM(pb + 0);
        if (IN(pb + 1)) { PHASE_P;
            char* al = (char*)lds;
            for (int id = bx; id < 256; id += G) { const int b = id >> 5, h = (id >> 3) & 3, qb = id & 7; const size_t kvrow = (size_t)(l * NB_LAT + b) * S_LAT;
                attn_b_unit(P, (size_t)M_CTX + (size_t)b * T_LAT + qb * 256, P.KBL + kvrow * 512, P.VBL + kvrow * 512, S_LAT, h, l, al); }
            for (int id = bx; id < 64; id += G) { const int b = id >> 2, h = id & 3;
                attn_b_unit(P, (size_t)b * T_CTX, P.KBC + (size_t)b * T_CTX * 512, P.VBC + (size_t)b * T_CTX * 512, T_CTX, h, l, al); }
            {   pg8::Gemm g{P.DFT_L, P.YTL, T_LAT, 512, 4096, 4096}; pg8::DftOrder S{1, 0, 128, G, bx}; pg8::EpiBf16Out E{P.MIX, D, 1536};
                pg8::gemm_phase<pg8::EpiBf16Out, pg8::DftOrder, true, true>(L, g, S, E); }
            {   pg8::Gemm g{P.DFT_C, P.YTC, T_CTX, 512, 512, 512}; pg8::DftOrder S{0, 64, 32, G, bx}; pg8::EpiBf16Out E{P.MIX, D, 1536};
                pg8::gemm_phase<pg8::EpiBf16Out, pg8::DftOrder, true, true>(L, g, S, E); }
            {   int first, cnt, stride;
                if (G == 256) { if (bx < 128) { first = bx; cnt = 1; stride = 1; } else { first = 128 + 3 * (bx - 128); cnt = 3; stride = 1; } }
                else { first = bx; cnt = (512 - bx + G - 1) / G; stride = G; }
                for (int k = 0; k < cnt; ++k) { const int id = first + k * stride; if (id >= 512) break; const int b = id >> 6, h = (id >> 3) & 7, qb = id & 7; const size_t kvrow = (size_t)(l * NB_LAT + b) * S_LAT;
                    attn_a_unit(P, (size_t)M_CTX + (size_t)b * T_LAT + qb * 256, P.KAL + kvrow * 256, P.VAL + kvrow * 256, S_LAT, h, al); } }
            for (int id = bx; id < 128; id += G) { const int b = id >> 3, h = id & 7;
                attn_a_unit(P, (size_t)b * T_CTX, P.KAC + (size_t)b * T_CTX * 256, P.VAC + (size_t)b * T_CTX * 256, T_CTX, h, al); }
        }
        SEAM(pb + 1);
        if (IN(pb + 2)) { PHASE_P;
            const pg8::ResNext nx{P.H, P.g_mlp + (size_t)l * D, mod_l + 4 * D, SS + (size_t)(2 * l + 1) * M_ALL * 8};
            pg8::Gemm g{P.MIX, P.BT_OUT + (size_t)l * D * D, M_ALL, D, D, D}; pg8::StaticOrder S; S.init(M_ALL, D, G, bx); if (G == 256) S.rounds = 2;
            pg8::EpiRes E{P.out, mod_l + 2 * D, nx};
            pg8::gemm_phase<pg8::EpiRes, pg8::StaticOrder, true, true>(L, g, S, E);
            {   pg8::Gemm g2{P.MIX, P.BT_OUT + (size_t)l * D * D, M_ALL, D, D / 2, D}; pg8::SplitOrder S2; S2.init(M_ALL, D, G, bx);
                pg8::EpiResSplit E2{E, P.OTMP, (unsigned*)(ctl + CW_FLAG) + (size_t)(l * 2 + 0) * 128 * 64, (unsigned*)(ctl + CW_TMO)};
                pg8::gemm_phase<pg8::EpiResSplit, pg8::SplitOrder, true, true>(L, g2, S2, E2); }
        }
        SEAM(pb + 2);
        if (IN(pb + 3)) { PHASE_P;
            pg8::Gemm g{P.H, P.BT_MI + (size_t)l * DFF * D, M_ALL, DFF, D, D}; pg8::StaticOrder S; S.init(M_ALL, DFF, G, bx);
            pg8::EpiRelu2 E{P.HID, DFF, SS + (size_t)(2 * l + 1) * M_ALL * 8, (const float*)(P.ws + WS_BIAS_MI) + (size_t)l * NCOND * DFF};
            pg8::gemm_phase<pg8::EpiRelu2, pg8::StaticOrder, true, true>(L, g, S, E);
        }
        SEAM(pb + 3);
        if (IN(pb + 4)) { PHASE_P;
            const bool more = l + 1 < DEPTH;
            const pg8::ResNext nx{more ? P.H : nullptr, P.g_mix + (size_t)(more ? l + 1 : l) * D, P.MOD + (size_t)(more ? l + 1 : l) * NCOND * NMOD + D, SS + (size_t)(more ? 2 * l + 2 : 0) * M_ALL * 8};
            pg8::Gemm g{P.HID, P.BT_MO + (size_t)l * D * DFF, M_ALL, D, DFF, DFF}; pg8::StaticOrder S; S.init(M_ALL, D, G, bx); if (G == 256) S.rounds = 2;
            pg8::EpiRes E{P.out, mod_l + 5 * D, nx};
            pg8::gemm_phase<pg8::EpiRes, pg8::StaticOrder, true, true>(L, g, S, E);
            {   pg8::Gemm g2{P.HID, P.BT_MO + (size_t)l * D * DFF, M_ALL, D, DFF / 2, DFF}; pg8::SplitOrder S2; S2.init(M_ALL, D, G, bx);
                pg8::EpiResSplit E2{E, P.OTMP, (unsigned*)(ctl + CW_FLAG) + (size_t)(l * 2 + 1) * 128 * 64, (unsigned*)(ctl + CW_TMO)};
                pg8::gemm_phase<pg8::EpiResSplit, pg8::SplitOrder, true, true>(L, g2, S2, E2); }
        }
        SEAM(pb + 4);
    }
#undef IN
#undef PHASE_P
#undef SEAM
}
#ifndef FAST_MASK
#define FAST_MASK 0x7f
#endif
#ifndef ONE_LAUNCH
#define ONE_LAUNCH 1
#endif
extern "C" void kernel_launch(void* const* d_in, const int* in_sizes, int n_in, void* d_out, int out_size, void* d_ws, size_t ws_size, hipStream_t stream) {
    if (n_in != 26 || (size_t)out_size != OUT_END || ws_size < WS_END) { fprintf(stderr, "kernel_launch: unexpected shapes (n_in %d out %d ws %zu)\n", n_in, out_size, ws_size); return; }
    static int grid = 0;
    if (grid == 0) {
        int dev = 0, cus = 0;
        if (hipGetDevice(&dev) != hipSuccess || hipDeviceGetAttribute(&cus, hipDeviceAttributeMultiprocessorCount, dev) != hipSuccess) { grid = -1; return; }
        if (hipFuncSetAttribute((const void*)mega, hipFuncAttributeMaxDynamicSharedMemorySize, LDS_BYTES) != hipSuccess) { grid = -1; return; }
        int per_cu = 0; (void)hipOccupancyMaxActiveBlocksPerMultiprocessor(&per_cu, (const void*)mega, NWAVES * 64, LDS_BYTES); (void)hipGetLastError();
        grid = cus;
    }
    if (grid < 0) return;
    const Ptrs p = make_ptrs(d_in, d_out, d_ws);
    (void)hipMemsetAsync((char*)d_ws + WS_CTL, 0, 1 * MiB, stream);
    MegaArgs a{}; for (int i = 0; i < 26; ++i) a.in[i] = (const float*)d_in[i]; a.out = (float*)d_out; a.ws = (unsigned char*)d_ws;
    a.ph_lo = 0; a.ph_hi = N_PHASES;
    hipLaunchKernelGGL(mega, dim3(grid), dim3(NWAVES * 64), LDS_BYTES, stream, a);
}
```

```cpp
#include <hip/hip_runtime.h>
#include <stdint.h>
#include <stdio.h>

typedef unsigned short bf16_t;
typedef short bf16x8 __attribute__((ext_vector_type(8)));
typedef float f32x4 __attribute__((ext_vector_type(4)));
typedef float f32x2 __attribute__((ext_vector_type(2)));
typedef unsigned u32x4 __attribute__((ext_vector_type(4)));
typedef unsigned u32x2 __attribute__((ext_vector_type(2)));

constexpr int D = 2048, NB_CTX = 16, T_CTX = 256, NB_LAT = 8, T_LAT = 2048, DEPTH = 4, PAST = 512;
constexpr int M_CTX = NB_CTX * T_CTX;
constexpr int M_LAT = NB_LAT * T_LAT;
constexpr int M_ALL = M_CTX + M_LAT;
constexpr int S_LAT = T_LAT + PAST;
constexpr int N_IN = 4096;
constexpr int N_INRAW = 3584;
constexpr int DFF = 8192;
constexpr int NMOD = 6 * D;
constexpr int NCOND = 9;
constexpr float EPS = 1e-6f;
constexpr size_t OUT_X = 0;
constexpr size_t OUT_SAK = (size_t)M_ALL * D;
constexpr size_t OUT_SAV = OUT_SAK + (size_t)NB_CTX * DEPTH * T_CTX * 256;
constexpr size_t OUT_SDK = OUT_SAV + (size_t)NB_CTX * DEPTH * T_CTX * 256;
constexpr size_t OUT_SDV = OUT_SDK + (size_t)NB_CTX * DEPTH * T_CTX * 512;
constexpr size_t OUT_END = OUT_SDV + (size_t)NB_CTX * DEPTH * T_CTX * 512;

constexpr size_t MiB = (size_t)1 << 20;
constexpr size_t WS_CTL = 0;
constexpr size_t WS_BT_IN = 1 * MiB;
constexpr size_t WS_BT_OUT = 65 * MiB;
constexpr size_t WS_BT_MI = 97 * MiB;
constexpr size_t WS_BT_MO = 225 * MiB;
constexpr size_t WS_DFT_L = 353 * MiB;
constexpr size_t WS_DFT_C = 369 * MiB;
constexpr size_t WS_MOD = 370 * MiB;
constexpr size_t WS_ROPE = 372 * MiB;
constexpr size_t WS_G = 374 * MiB;
constexpr size_t WS_LAM = 376 * MiB;
constexpr size_t WS_GAIN = WS_LAM + 4096;
constexpr size_t WS_H = 377 * MiB;
constexpr size_t WS_QA = 457 * MiB;
constexpr size_t WS_KAL = 497 * MiB;
constexpr size_t WS_VAL = 537 * MiB;
constexpr size_t WS_KAC = 577 * MiB;
constexpr size_t WS_VAC = 579 * MiB;
constexpr size_t WS_QB = 581 * MiB;
constexpr size_t WS_KBL = 601 * MiB;
constexpr size_t WS_VBL = 681 * MiB;
constexpr size_t WS_KBC = 761 * MiB;
constexpr size_t WS_VBC = 765 * MiB;
constexpr size_t WS_YTL = 769 * MiB;
constexpr size_t WS_YTC = 801 * MiB;
constexpr size_t WS_MIX = 809 * MiB;
constexpr size_t WS_HID = 889 * MiB;
constexpr size_t WS_OTMP = 1209 * MiB;
constexpr size_t WS_SS = 1273 * MiB;
constexpr size_t WS_BIAS_IN = 1279 * MiB;
constexpr size_t WS_BIAS_MI = 1280 * MiB;
constexpr size_t WS_YPL = 1282 * MiB;
constexpr size_t WS_YPC = 1298 * MiB;
constexpr size_t WS_XB = 1302 * MiB;
constexpr size_t WS_END = 1382 * MiB;

#ifndef AS_GLOBAL
#define AS_GLOBAL 1
#endif
template <class T> __device__ __forceinline__ T* as_global(T* p) {
#if defined(__HIP_DEVICE_COMPILE__) && AS_GLOBAL
    __attribute__((address_space(1))) T* g = (__attribute__((address_space(1))) T*)p; asm volatile("" : "+s"(g));
    return (T*)g;
#else
    return p;
#endif
}
__host__ __device__ __forceinline__ int map8(int p) { return (p & 96) | (((p >> 2) & 3) << 3) | (((p >> 4) & 1) << 2) | (p & 3); }
__host__ __device__ __forceinline__ int map8inv(int s) { return (s & 96) | (((s >> 2) & 1) << 4) | (((s >> 3) & 3) << 2) | (s & 3); }
__host__ __device__ __forceinline__ int sigma128(int s) { const int u = s >> 3, n = (s >> 2) & 1, e = s & 3; return (u < 8 ? 0 : 64) + 32 * n + 4 * (u & 7) + e; }
__host__ __device__ __forceinline__ int sigma64(int s) { const int u = s >> 3, n = (s >> 2) & 1, e = s & 3; return (u < 4 ? 0 : 32) + 16 * n + 4 * (u & 3) + e; }
__host__ __device__ __forceinline__ int in_logical_col(int t, int sc) {
    const int half = sc & 128, s = sc & 127;
    int l;
    if (t <= 4) l = sigma128(s);
    else if (t == 5 || t >= 10) l = s;
    else l = (s & 64) + sigma64(s & 63);
    return t * 256 + half + l;
}
__device__ __forceinline__ unsigned f2bf(float f) { unsigned u = __builtin_bit_cast(unsigned, f); return (u + 0x7fffu + ((u >> 16) & 1u)) >> 16; }
__device__ __forceinline__ float bf2f(unsigned short h) { return __builtin_bit_cast(float, (unsigned)h << 16); }
__device__ __forceinline__ unsigned pk2(float lo, float hi) { return f2bf(lo) | (f2bf(hi) << 16); }
__device__ __forceinline__ int cond_of_row(int row) { return row < M_CTX ? 0 : 1 + ((row - M_CTX) >> 11); }
__host__ __device__ __forceinline__ float lambda_init_of(int l) { return 0.8f - 0.6f * expf(-0.3f * (float)l); }
__device__ __forceinline__ float wave_sum(float v) {
#pragma unroll
    for (int o = 1; o < 64; o <<= 1) v += __shfl_xor(v, o);
    return v;
}
struct Ptrs {
    const float *x_prompt, *x_sample, *cak, *cav, *cdk, *cdv, *c, *c_ctx, *w_ada, *b_ada, *g_mix, *g_mlp, *w_in, *qn_a, *kn_a, *qn_b, *kn_b, *lq1, *lk1, *lq2, *lk2, *subln, *w_fourier, *w_out, *w_mi, *w_mo;
    float* out; unsigned char* ws;
    bf16_t *BT_IN, *BT_OUT, *BT_MI, *BT_MO, *DFT_L, *DFT_C, *H, *QA, *KAL, *VAL, *KAC, *VAC, *QB, *KBL, *VBL, *KBC, *VBC, *YTL, *YTC, *MIX, *HID;
    float *MOD, *ROPE, *G, *LAM, *OTMP;
};
__host__ __device__ __forceinline__ Ptrs make_ptrs_hd(const float* const* in, float* out, unsigned char* w) {
    Ptrs p{}; w = as_global(w); out = as_global(out);
#define in_(i) as_global(in[i])
    p.x_prompt = in_(0); p.x_sample = in_(1); p.cak = in_(2); p.cav = in_(3); p.cdk = in_(4); p.cdv = in_(5); p.c = in_(6); p.c_ctx = in_(7); p.w_ada = in_(8); p.b_ada = in_(9);
    p.g_mix = in_(10); p.g_mlp = in_(11); p.w_in = in_(12); p.qn_a = in_(13); p.kn_a = in_(14); p.qn_b = in_(15); p.kn_b = in_(16); p.lq1 = in_(17); p.lk1 = in_(18); p.lq2 = in_(19); p.lk2 = in_(20);
    p.subln = in_(21); p.w_fourier = in_(22); p.w_out = in_(23); p.w_mi = in_(24); p.w_mo = in_(25);
    p.out = out; p.ws = w;
    p.BT_IN = (bf16_t*)(w + WS_BT_IN); p.BT_OUT = (bf16_t*)(w + WS_BT_OUT); p.BT_MI = (bf16_t*)(w + WS_BT_MI); p.BT_MO = (bf16_t*)(w + WS_BT_MO);
    p.DFT_L = (bf16_t*)(w + WS_DFT_L); p.DFT_C = (bf16_t*)(w + WS_DFT_C); p.MOD = (float*)(w + WS_MOD); p.ROPE = (float*)(w + WS_ROPE); p.G = (float*)(w + WS_G); p.LAM = (float*)(w + WS_LAM);
    p.H = (bf16_t*)(w + WS_H); p.QA = (bf16_t*)(w + WS_QA); p.KAL = (bf16_t*)(w + WS_KAL); p.VAL = (bf16_t*)(w + WS_VAL); p.KAC = (bf16_t*)(w + WS_KAC); p.VAC = (bf16_t*)(w + WS_VAC);
    p.QB = (bf16_t*)(w + WS_QB); p.KBL = (bf16_t*)(w + WS_KBL); p.VBL = (bf16_t*)(w + WS_VBL); p.KBC = (bf16_t*)(w + WS_KBC); p.VBC = (bf16_t*)(w + WS_VBC);
    p.YTL = (bf16_t*)(w + WS_YTL); p.YTC = (bf16_t*)(w + WS_YTC); p.MIX = (bf16_t*)(w + WS_MIX); p.HID = (bf16_t*)(w + WS_HID); p.OTMP = (float*)(w + WS_OTMP);
#undef in_
    return p;
}


__device__ __forceinline__ void prep_G_idx(const float* __restrict__ wf, float* __restrict__ G, size_t idx, const float* ct, const float* st) {
    const int d = idx & 127, c = (idx >> 7) & 127, cs = (idx >> 14) & 1, g = (idx >> 15) & 3, l = (int)(idx >> 17);
    const float* Wg = wf + ((size_t)(l * 4 + g) * 128) * 128;
    float acc = 0.f;
    for (int m = 0; m < 128; ++m) { const float tr = cs ? st[(m * c) & 127] : ct[(m * c) & 127]; acc += tr * Wg[(size_t)m * 128 + d]; }
    G[idx] = acc * 0.088388347648318440f;
}
__device__ __forceinline__ void prep_fold_vb(const float* __restrict__ w_in, const float* __restrict__ G, bf16_t* __restrict__ Bt_in, int vbx, int vby, int vbz, int t, float (*wt)[132], bool act) {
    const int j0 = vbx * 64, g = vby, l = vbz;
    const float* Wl = w_in + (size_t)l * D * N_INRAW;
    if (act) for (int i = t; i < 64 * 32; i += 256) { const int j = i >> 5, c4 = (i & 31) * 4; const f32x4 v = *(const f32x4*)(Wl + (size_t)(j0 + j) * N_INRAW + 3072 + 128 * g + c4);
        wt[j][c4] = v[0]; wt[j][c4 + 1] = v[1]; wt[j][c4 + 2] = v[2]; wt[j][c4 + 3] = v[3]; }
    __syncthreads();
    if (act) {
    const int cs = t >> 7, d = t & 127;
    const float* Gp = G + ((size_t)((l * 4 + g) * 2 + cs) * 128) * 128 + d;
    const int nl = cs * 512 + g * 128 + d;
    const int sc = nl & 255, pos = (nl & ~255) + (sc & 128) + map8inv(sc & 127);
    bf16_t* dst = Bt_in + (size_t)l * N_IN * D + (size_t)(3072 + pos) * D + j0;
    for (int jb = 0; jb < 64; jb += 8) {
        float a0 = 0, a1 = 0, a2 = 0, a3 = 0, a4 = 0, a5 = 0, a6 = 0, a7 = 0;
        for (int c = 0; c < 128; ++c) { const float gv = Gp[(size_t)c * 128];
            a0 += wt[jb + 0][c] * gv; a1 += wt[jb + 1][c] * gv; a2 += wt[jb + 2][c] * gv; a3 += wt[jb + 3][c] * gv;
            a4 += wt[jb + 4][c] * gv; a5 += wt[jb + 5][c] * gv; a6 += wt[jb + 6][c] * gv; a7 += wt[jb + 7][c] * gv; }
        *(u32x4*)(dst + jb) = (u32x4){pk2(a0, a1), pk2(a2, a3), pk2(a4, a5), pk2(a6, a7)};
    }
    }
    __syncthreads();
}
__device__ __forceinline__ void prep_tables_gs(float* __restrict__ rope, bf16_t* __restrict__ dftl, bf16_t* __restrict__ dftc, float* __restrict__ lam,
                                                     const float* lq1, const float* lk1, const float* lq2, const float* lk2,
                                                     float* __restrict__ gain, const float* qna, const float* kna, const float* qnb, const float* knb, size_t gid, size_t nth) {
    float* cosA = rope; float* sinA = rope + 2048 * 64; float* cosB = rope + 2 * 2048 * 64; float* sinB = cosB + 2048 * 32;
    for (size_t i = gid; i < (size_t)2048 * 64; i += nth) { const int tk = (int)(i >> 6), f = (int)(i & 63); const int fi = f & 31; const float pos = (f < 32) ? (float)(tk >> 6) : (float)(tk & 63);
        const float inv = powf(10000.0f, -(float)fi / 32.0f); const float ang = pos * inv; cosA[i] = cosf(ang); sinA[i] = sinf(ang); }
    for (size_t i = gid; i < (size_t)2048 * 32; i += nth) { const int tk = (int)(i >> 5), f = (int)(i & 31); const int fi = f & 15; const float pos = (f < 16) ? (float)(tk >> 6) : (float)(tk & 63);
        const float inv = powf(10000.0f, -(float)fi / 16.0f); const float ang = pos * inv; cosB[i] = cosf(ang); sinB[i] = sinf(ang); }
    for (size_t i = gid; i < (size_t)2048 * 2048; i += nth) { const int k = (int)(i >> 11), j = (int)(i & 2047); const int tt = j & 1023; const int ph = (k * tt) & 2047;
        float sn, cs; sincospif((float)ph / 1024.0f, &sn, &cs); const float v = (j < 1024 ? cs : (j == 1024 ? ((k & 1) ? -1.0f : 1.0f) : -sn)) * 0.022097086912079608f; dftl[i] = (bf16_t)f2bf(v); }
    for (size_t i = gid; i < (size_t)256 * 256; i += nth) { const int k = (int)(i >> 8), j = (int)(i & 255); const int tt = j & 127; const int ph = (k * tt) & 255;
        float sn, cs; sincospif((float)ph / 128.0f, &sn, &cs); const float v = (j < 128 ? cs : (j == 128 ? ((k & 1) ? -1.0f : 1.0f) : -sn)) * 0.0625f; dftc[i] = (bf16_t)f2bf(v); }
    if (gid < DEPTH * 384) { const int l = (int)gid / 384, i = (int)gid % 384; gain[gid] = i < 128 ? qna[l * 128 + i] : i < 256 ? kna[l * 128 + i - 128] : i < 320 ? qnb[l * 64 + i - 256] : knb[l * 64 + i - 320]; }
    if (gid < DEPTH) { const int l = (int)gid; float s1 = 0.f, s2 = 0.f; for (int i = 0; i < 64; ++i) { s1 += lq1[l * 64 + i] * lk1[l * 64 + i]; s2 += lq2[l * 64 + i] * lk2[l * 64 + i]; }
        lam[l] = expf(s1) - expf(s2) + lambda_init_of(l); }
}
__device__ __forceinline__ void prep_cache_gs(const float* __restrict__ cak, const float* __restrict__ cav, const float* __restrict__ cdk, const float* __restrict__ cdv,
                                                    bf16_t* __restrict__ KAL, bf16_t* __restrict__ VAL, bf16_t* __restrict__ KBL, bf16_t* __restrict__ VBL, size_t gid, size_t nth, int lsel) {
    const size_t nrow = (size_t)NB_LAT * (lsel < 0 ? DEPTH : 1) * PAST;
    for (size_t i = gid; i < nrow * 32; i += nth) { const int it = (int)(i & 31); size_t r = i >> 5; if (lsel >= 0) r = ((r >> 9) * DEPTH + (size_t)lsel) * PAST + (r & 511); const int p = (int)(r & 511), l = (int)((r >> 9) & 3), b = (int)(r >> 11);
        const int head = it >> 4, s0 = (it & 15) * 8;
        const float* srck = cak + r * 256 + head * 128; const float* srcv = cav + r * 256 + head * 128;
        const int la = sigma128(s0), lb = sigma128(s0 + 4);
        const f32x4 ka = *(const f32x4*)(srck + la), kb = *(const f32x4*)(srck + lb), va = *(const f32x4*)(srcv + s0), vb = *(const f32x4*)(srcv + s0 + 4);
        const size_t orow = ((size_t)(l * NB_LAT + b) * S_LAT + T_LAT + p) * 256 + head * 128 + s0;
        *(u32x4*)(KAL + orow) = (u32x4){pk2(ka[0], ka[1]), pk2(ka[2], ka[3]), pk2(kb[0], kb[1]), pk2(kb[2], kb[3])};
        *(u32x4*)(VAL + orow) = (u32x4){pk2(va[0], va[1]), pk2(va[2], va[3]), pk2(vb[0], vb[1]), pk2(vb[2], vb[3])}; }
    for (size_t i = gid; i < nrow * 64; i += nth) { const int it = (int)(i & 63); size_t r = i >> 6; if (lsel >= 0) r = ((r >> 9) * DEPTH + (size_t)lsel) * PAST + (r & 511); const int p = (int)(r & 511), l = (int)((r >> 9) & 3), b = (int)(r >> 11);
        const int grp = it >> 3, s0 = (it & 7) * 8;
        const float* srck = cdk + r * 512 + grp * 64; const float* srcv = cdv + r * 512 + it * 8;
        const int la = sigma64(s0), lb = sigma64(s0 + 4);
        const f32x4 ka = *(const f32x4*)(srck + la), kb = *(const f32x4*)(srck + lb), va = *(const f32x4*)(srcv), vb = *(const f32x4*)(srcv + 4);
        const size_t orow = ((size_t)(l * NB_LAT + b) * S_LAT + T_LAT + p) * 512 + it * 8;
        *(u32x4*)(KBL + orow) = (u32x4){pk2(ka[0], ka[1]), pk2(ka[2], ka[3]), pk2(kb[0], kb[1]), pk2(kb[2], kb[3])};
        *(u32x4*)(VBL + orow) = (u32x4){pk2(va[0], va[1]), pk2(va[2], va[3]), pk2(vb[0], vb[1]), pk2(vb[2], vb[3])}; }
}

__device__ __forceinline__ void prep_transpose256_vb(const float* __restrict__ W, int K, int ldw, size_t w_layer_stride, bf16_t* __restrict__ Bt, size_t bt_layer_stride, int mode, int vbx, int vby, int vbz, int t, float (*tile)[257], bool act, int nblk = 0) {
    const int k0 = vbx * 64, grp = vby, l = vbz;
    const float* Wl = W + (size_t)l * w_layer_stride; bf16_t* Bl = Bt + (size_t)l * bt_layer_stride;
    const int c0 = grp * 256;
    if (act) {
        f32x4 v[16];
#pragma unroll
        for (int i = 0; i < 16; ++i) { const int idx = t + 256 * i, row = idx >> 6, c = (idx & 63) * 4; v[i] = *(const f32x4*)(Wl + (size_t)(k0 + row) * ldw + c0 + c); }
#pragma unroll
        for (int i = 0; i < 16; ++i) { const int idx = t + 256 * i, row = idx >> 6, c = (idx & 63) * 4;
            tile[row][c] = v[i][0]; tile[row][c + 1] = v[i][1]; tile[row][c + 2] = v[i][2]; tile[row][c + 3] = v[i][3]; } }
    __syncthreads();
    if (act) {
        const int p = t, sc = (p & 128) | map8(p & 127);
        const int lc = (mode == 0) ? sc : in_logical_col(grp, sc) - grp * 256;
        bf16_t* dst = nblk ? Bl + ((size_t)vbx * nblk + c0 + p) * 64 : Bl + (size_t)(c0 + p) * K + k0;
#pragma unroll
        for (int q = 0; q < 8; ++q) { unsigned w[4];
#pragma unroll
            for (int j = 0; j < 4; ++j) w[j] = pk2(tile[8 * q + 2 * j][lc], tile[8 * q + 2 * j + 1][lc]);
            *(u32x4*)(dst + 8 * q) = (u32x4){w[0], w[1], w[2], w[3]}; }
    }
    __syncthreads();
}
__device__ __forceinline__ void prep_ada96_vb(const float* __restrict__ c, const float* __restrict__ c_ctx, const float* __restrict__ w_ada, const float* __restrict__ b_ada, float* __restrict__ mod, int vb, int t, float* sm, bool act) {
    float (*sv)[128] = (float(*)[128])sm; float (*red)[96] = (float(*)[96])(sm + NCOND * 128);
    const int l = vb >> 7, col = (vb & 127) * 96 + (t % 96), kh = t / 96; const bool work = act && t < 192;
    const float* W = w_ada + (size_t)l * D * NMOD + col;
    float acc[NCOND];
#pragma unroll
    for (int q = 0; q < NCOND; ++q) acc[q] = 0.f;
    for (int k0 = 0; k0 < D; k0 += 128) {
        __syncthreads();
        if (act) for (int i = t; i < NCOND * 128; i += 256) { const int q = i >> 7, kk = i & 127; const float v = (q == 0) ? c_ctx[k0 + kk] : c[(size_t)(q - 1) * D + k0 + kk]; sv[q][kk] = v / (1.f + expf(-v)); }
        __syncthreads();
        if (work) {
#pragma unroll 2
            for (int kk = kh * 64; kk < kh * 64 + 64; kk += 4) {
                const float w0 = W[(size_t)(k0 + kk) * NMOD], w1 = W[(size_t)(k0 + kk + 1) * NMOD], w2 = W[(size_t)(k0 + kk + 2) * NMOD], w3 = W[(size_t)(k0 + kk + 3) * NMOD];
#pragma unroll
                for (int q = 0; q < NCOND; ++q) { const f32x4 s = *(const f32x4*)&sv[q][kk]; acc[q] += (s[0] * w0 + s[1] * w1) + (s[2] * w2 + s[3] * w3); }
            }
        }
    }
    if (work && kh == 1) {
#pragma unroll
        for (int q = 0; q < NCOND; ++q) red[q][t - 96] = acc[q]; }
    __syncthreads();
    if (work && kh == 0) { const float bb = b_ada[(size_t)l * NMOD + col];
#pragma unroll
        for (int q = 0; q < NCOND; ++q) mod[((size_t)l * NCOND + q) * NMOD + col] = (acc[q] + red[q][t]) + bb; }
    __syncthreads();
}
#ifndef PG8_WGM
#define PG8_WGM 4
#endif
namespace pg8 {
#define PG8_LAS __attribute__((address_space(3)))
typedef unsigned short bf16_t;
typedef short bf16x8 __attribute__((ext_vector_type(8)));
typedef float f32x4 __attribute__((ext_vector_type(4)));
typedef unsigned u32x4 __attribute__((ext_vector_type(4)));
constexpr int BM = 256, BK = 64, HALF = 128, HTB = HALF * BK * 2  , STAGE_BYTES = 8 * HTB, NXCD = 8, WGM = PG8_WGM;

__host__ __device__ __forceinline__ int lds_byte(int r, int c) { const int st = (r >> 4) * 2 + (c >> 5), rr = r & 15, cc = c & 31, ob = rr * 64 + cc * 2; return st * 1024 + (ob ^ (((ob >> 9) & 1) << 5)); }
__host__ __device__ __forceinline__ void stage_rc(int b, int& R, int& C) { const int st = b / 1024, sb = b % 1024, swz = sb ^ (((sb >> 9) & 1) << 5); R = (st >> 1) * 16 + swz / 64; C = (st & 1) * 32 + (swz % 64) / 2; }
__host__ __device__ __forceinline__ int perm32(int rho) { const int n = rho >> 4, i = rho & 15; return 8 * (i >> 2) + 4 * n + (i & 3); }

struct Unit { int pm, pn, kh, aux; };
struct Gemm { const bf16_t* A; const bf16_t* Bt; int M, N, K, ld; int lda = 0; size_t kstepA = 0; int ldb = 0; size_t kstepB = 0; };

struct StaticOrder {
    int nM, nN, nwg, G, c; int rounds = 1 << 30; int wgm = WGM; int rev = 0;
    __device__ __forceinline__ const char* aptr(const Unit& u, const Gemm& g) const { return (const char*)g.A + (size_t)u.pm * ((size_t)BM * (g.lda ? g.lda : g.ld) * 2) + (size_t)u.kh * (size_t)(g.K / BK) * (g.kstepA ? g.kstepA : (size_t)BK * 2); }
    __device__ __forceinline__ const char* bptr(const Unit& u, const Gemm& g) const { return (const char*)g.Bt + (size_t)u.pn * ((size_t)BM * (g.ldb ? g.ldb : g.ld) * 2) + (size_t)u.kh * (size_t)(g.K / BK) * (g.kstepB ? g.kstepB : (size_t)BK * 2); }
    __host__ __device__ void init(int M, int N, int G_, int c_) { nM = M / BM; nN = N / BM; nwg = nM * nN; G = G_; c = c_; }
    __host__ __device__ bool next(int i, Unit& u) const {
        const long L = (long)i * G + c; if (L >= nwg || i >= rounds) return false; u.kh = 0; u.aux = 0;
        int wgid = (int)L; { const int q = nwg / NXCD, r = nwg % NXCD, xcd = wgid % NXCD, off = wgid / NXCD; wgid = (xcd < r ? xcd * (q + 1) : r * (q + 1) + (xcd - r) * q) + off; }
        const int nig = wgm * nN, gid = wgid / nig, fm = gid * wgm, gsz = (nM - fm) < wgm ? (nM - fm) : wgm;
        u.pm = fm + ((wgid % nig) % gsz); u.pn = (wgid % nig) / gsz; if (rev) u.pm = nM - 1 - u.pm;
        return true;
    }
    __device__ __forceinline__ void a_ready(const Unit&) const {}
    __device__ __forceinline__ void done(const Unit&) const {}
};


__device__ __forceinline__ unsigned cvt_pk_bf16(float lo, float hi) { unsigned r; asm volatile("v_cvt_pk_bf16_f32 %0, %1, %2" : "=v"(r) : "v"(lo), "v"(hi)); return r; }
__device__ __forceinline__ u32x4 pack8(const f32x4 a, const f32x4 b) { u32x4 w; w.x = cvt_pk_bf16(a[0], a[1]); w.y = cvt_pk_bf16(a[2], a[3]); w.z = cvt_pk_bf16(b[0], b[1]); w.w = cvt_pk_bf16(b[2], b[3]); return w; }
constexpr int EPIX_OFF = STAGE_BYTES + 8192 + 1024, EPIX_SLOT = 9216, EPIX_END = EPIX_OFF + 2 * EPIX_SLOT;
__device__ __forceinline__ void stage_ss_bias(const float* ss, const float* bias_row256, const Unit& u, PG8_LAS unsigned char* lds, int ui) {
    int t_ = threadIdx.x; asm volatile("" : "+v"(t_)); const int wid_ = __builtin_amdgcn_readfirstlane(t_ >> 6), lane_ = t_ & 63;
    PG8_LAS unsigned char* slot = lds + EPIX_OFF + (ui & 1) * EPIX_SLOT;
    __builtin_amdgcn_global_load_lds((const unsigned*)((const char*)(ss + (size_t)u.pm * BM * 8) + wid_ * 1024 + lane_ * 16), (PG8_LAS unsigned*)(slot + wid_ * 1024), 16, 0, 0);
    if (wid_ == 0) __builtin_amdgcn_global_load_lds((const unsigned*)((const char*)bias_row256 + lane_ * 16), (PG8_LAS unsigned*)(slot + 8192), 16, 0, 0);
}
#define EPI_LANE_COORDS int t_ = threadIdx.x; asm volatile("" : "+v"(t_)); const int wid_ = __builtin_amdgcn_readfirstlane(t_ >> 6), wr = wid_ >> 2, wc = wid_ & 3, fr = t_ & 15, fq = (t_ >> 4) & 3
__device__ __forceinline__ float row_rinv(const PG8_LAS float* ssl, int row) {
    const f32x4 a = *(const PG8_LAS f32x4*)(ssl + row * 8), b = *(const PG8_LAS f32x4*)(ssl + row * 8 + 4);
    return __builtin_amdgcn_rsqf((((a[0] + a[1]) + (a[2] + a[3])) + ((b[0] + b[1]) + (b[2] + b[3]))) * (1.0f / D) + EPS);
}
#ifndef HID_NT
#define HID_NT 0
#endif
struct EpiRelu2 {
    static constexpr bool PERM = false, AFTER_DRAIN = false;
    bf16_t* O; int ldc; const float* ss; const float* bias;
    int Mblk;
    __device__ __forceinline__ void stage(const Unit& u, PG8_LAS unsigned char* lds, int ui) const { const int cond = u.pm < 16 ? 0 : 1 + ((u.pm - 16) >> 3); stage_ss_bias(ss, bias + (size_t)cond * ldc + u.pn * BM, u, lds, ui); }
    __device__ __forceinline__ void operator()(f32x4 (&acc)[2][2][4][2], const Unit& u, int ui, int, int, int, PG8_LAS unsigned char* lds) const {
        EPI_LANE_COORDS;
        PG8_LAS unsigned char* xs = lds + EPIX_OFF + (ui & 1) * EPIX_SLOT;
        const PG8_LAS float* ssl = (const PG8_LAS float*)xs; const PG8_LAS float* bp = (const PG8_LAS float*)(xs + 8192) + wc * 32 + 4 * fq;
        f32x4 bv[2][2];
#pragma unroll
        for (int bj = 0; bj < 2; ++bj) { bv[bj][0] = *(const PG8_LAS f32x4*)(bp + bj * HALF); bv[bj][1] = *(const PG8_LAS f32x4*)(bp + bj * HALF + 16); }
        const int row0 = u.pm * BM + wr * 64 + fr;
        const int c0 = u.pn * BM + wc * 32 + 8 * fq;
        const size_t rpitch = Mblk ? 64 : (size_t)ldc, hoff = Mblk ? (size_t)2 * Mblk * 64 : (size_t)HALF;
        bf16_t* base = Mblk ? O + ((size_t)(c0 >> 6) * Mblk + row0) * 64 + (c0 & 63) : O + (size_t)row0 * ldc + c0;
#pragma unroll
        for (int ai = 0; ai < 2; ++ai)
#pragma unroll
            for (int m = 0; m < 4; ++m) { bf16_t* rowp = base + (size_t)(ai * HALF + m * 16) * rpitch;
                const float r = row_rinv(ssl, wr * 64 + fr + ai * HALF + m * 16);
#pragma unroll
                for (int bj = 0; bj < 2; ++bj) { f32x4 v0 = acc[ai][bj][m][0] * r + bv[bj][0], v1 = acc[ai][bj][m][1] * r + bv[bj][1];
#pragma unroll
                    for (int e = 0; e < 4; ++e) { const float a = v0[e] > 0.f ? v0[e] : 0.f, b = v1[e] > 0.f ? v1[e] : 0.f; v0[e] = a * a; v1[e] = b * b; }
                    if (HID_NT) __builtin_nontemporal_store(pack8(v0, v1), (u32x4*)(rowp + bj * hoff)); else *(u32x4*)(rowp + bj * hoff) = pack8(v0, v1); } }
    }
};
struct EpiBf16Out {
    static constexpr bool PERM = false, AFTER_DRAIN = false;
    bf16_t* O; int ldc; int col_off;
    __device__ __forceinline__ void stage(const Unit&, PG8_LAS unsigned char*, int) const {}
    __device__ __forceinline__ void operator()(f32x4 (&acc)[2][2][4][2], const Unit& u, int, int, int, int, PG8_LAS unsigned char*) const {
        EPI_LANE_COORDS;
        bf16_t* base = O + (size_t)(u.pm * BM + wr * 64 + fr) * ldc + col_off + u.pn * BM + wc * 32 + 8 * fq;
#pragma unroll
        for (int ai = 0; ai < 2; ++ai)
#pragma unroll
            for (int m = 0; m < 4; ++m) { bf16_t* rowp = base + (size_t)(ai * HALF + m * 16) * ldc;
#pragma unroll
                for (int bj = 0; bj < 2; ++bj) *(u32x4*)(rowp + bj * HALF) = pack8(acc[ai][bj][m][0], acc[ai][bj][m][1]); }
    }
};
struct ResNext { bf16_t* XA; const float* gn; const float* scn; float* ssn; };
#ifndef XA_BLOCKED
#define XA_BLOCKED 0
#endif
#ifndef PB_PF
#define PB_PF 1
#endif
#ifndef XB_PF
#define XB_PF 2
#endif
struct EpiRes {
    static constexpr bool PERM = false, AFTER_DRAIN = false;
    float* X; const float* gate; ResNext nx;
    const float* Xr_ctx; const float* Xr_lat;
    int mode = 3;
    __device__ __forceinline__ void stage(const Unit&, PG8_LAS unsigned char*, int) const {}
    template <bool SPLIT>
    __device__ __forceinline__ void run(f32x4 (&acc)[2][2][4][2], const Unit& u, int wr, int wc, int fr, int fq, const float* pb, PG8_LAS unsigned char* lds, int t_) const {
        PG8_LAS float* PT = (PG8_LAS float*)(lds + STAGE_BYTES);
        const int cond = u.pm < 16 ? 0 : 1 + ((u.pm - 16) >> 3); const int col0 = u.pn * BM + wc * 32 + 8 * fq;
        const float* gp = gate + (size_t)cond * NMOD + col0;
        f32x4 gv[2][2], av[2][2];
        const bool has_next = nx.XA != nullptr;
#pragma unroll
        for (int bj = 0; bj < 2; ++bj) { gv[bj][0] = *(const f32x4*)(gp + bj * HALF); gv[bj][1] = *(const f32x4*)(gp + bj * HALF + 4); av[bj][0] = (f32x4){0.f, 0.f, 0.f, 0.f}; av[bj][1] = av[bj][0]; }
        if (has_next) { const float* g2 = nx.gn + col0; const float* s2 = nx.scn + (size_t)cond * NMOD + col0;
#pragma unroll
            for (int bj = 0; bj < 2; ++bj) { av[bj][0] = *(const f32x4*)(g2 + bj * HALF) * (*(const f32x4*)(s2 + bj * HALF) + 1.0f); av[bj][1] = *(const f32x4*)(g2 + bj * HALF + 4) * (*(const f32x4*)(s2 + bj * HALF + 4) + 1.0f); } }
        const int row0 = u.pm * BM + wr * 64 + fr;
        const bool rd_f32 = mode & 1, wr_f32 = mode & 2; const size_t eo = (size_t)row0 * D + col0;
        float* base = wr_f32 ? X + eo : (float*)((bf16_t*)X + eo); const float* rbase = (u.pm < 16 ? Xr_ctx : Xr_lat); rbase = rd_f32 ? rbase + eo : (const float*)((const bf16_t*)rbase + eo);
#if XB_PF
        u32x4 xq[8][2];
#define XQ_LOAD(rg) do { const bf16_t* rr_ = (const bf16_t*)rbase + (size_t)(((rg) >> 2) * HALF + ((rg) & 3) * 16) * D; xq[rg][0] = *(const u32x4*)rr_; xq[rg][1] = *(const u32x4*)(rr_ + HALF); } while (0)
        f32x4 pq[8][2][2];
#define PQ_LOAD(rg) do { if (SPLIT && PB_PF) { _Pragma("unroll") for (int bj_ = 0; bj_ < 2; ++bj_) { pq[rg][bj_][0] = *(const f32x4*)(pb + (size_t)(((((rg) >> 2) * 2 + bj_) * 4 + ((rg) & 3)) * 2 + 0) * 2048); pq[rg][bj_][1] = *(const f32x4*)(pb + (size_t)(((((rg) >> 2) * 2 + bj_) * 4 + ((rg) & 3)) * 2 + 1) * 2048); } } } while (0)
        if (!rd_f32) {
#pragma unroll
            for (int rg = 0; rg < XB_PF; ++rg) XQ_LOAD(rg); }
#pragma unroll
        for (int rg = 0; rg < XB_PF; ++rg) PQ_LOAD(rg);
#endif
#pragma unroll
        for (int ai = 0; ai < 2; ++ai)
#pragma unroll
            for (int m = 0; m < 4; ++m) { const int ro = ai * HALF + m * 16; float* rowp = wr_f32 ? base + (size_t)ro * D : (float*)((bf16_t*)base + (size_t)ro * D); const float* rrow = rd_f32 ? rbase + (size_t)ro * D : (const float*)((const bf16_t*)rbase + (size_t)ro * D); float sq = 0.f;
#pragma unroll
                for (int bj = 0; bj < 2; ++bj) { f32x4 x0, x1;
                    if (rd_f32) { x0 = *(const f32x4*)(rrow + bj * HALF); x1 = *(const f32x4*)(rrow + bj * HALF + 4); }
                    else {
#if XB_PF
                        const u32x4 v = xq[ai * 4 + m][bj];
#else
                        const u32x4 v = *(const u32x4*)((const bf16_t*)rrow + bj * HALF);
#endif
                        x0 = (f32x4){__builtin_bit_cast(float, v[0] << 16), __builtin_bit_cast(float, v[0] & 0xffff0000u), __builtin_bit_cast(float, v[1] << 16), __builtin_bit_cast(float, v[1] & 0xffff0000u)};
                        x1 = (f32x4){__builtin_bit_cast(float, v[2] << 16), __builtin_bit_cast(float, v[2] & 0xffff0000u), __builtin_bit_cast(float, v[3] << 16), __builtin_bit_cast(float, v[3] & 0xffff0000u)}; }
                    f32x4 a0 = acc[ai][bj][m][0], a1 = acc[ai][bj][m][1];
#if XB_PF && PB_PF
                    if (SPLIT) { a0 = a0 + pq[ai * 4 + m][bj][0]; a1 = a1 + pq[ai * 4 + m][bj][1]; }
#else
                    if (SPLIT) { a0 = a0 + *(const f32x4*)(pb + (size_t)(((ai * 2 + bj) * 4 + m) * 2 + 0) * 2048); a1 = a1 + *(const f32x4*)(pb + (size_t)(((ai * 2 + bj) * 4 + m) * 2 + 1) * 2048); }
#endif
                    x0 = x0 + gv[bj][0] * a0; x1 = x1 + gv[bj][1] * a1;
                    if (wr_f32) { *(f32x4*)(rowp + bj * HALF) = x0; *(f32x4*)(rowp + bj * HALF + 4) = x1; } else *(u32x4*)((bf16_t*)rowp + bj * HALF) = pack8(x0, x1);
                    if (has_next) { const int xc_ = col0 + bj * HALF;
                        *(u32x4*)(XA_BLOCKED ? nx.XA + ((size_t)(xc_ >> 6) * M_ALL + (row0 + ro)) * 64 + (xc_ & 63) : nx.XA + (size_t)(row0 + ro) * D + xc_) = pack8(x0 * av[bj][0], x1 * av[bj][1]);
                        sq += (x0[0] * x0[0] + x0[1] * x0[1]) + (x0[2] * x0[2] + x0[3] * x0[3]) + (x1[0] * x1[0] + x1[1] * x1[1]) + (x1[2] * x1[2] + x1[3] * x1[3]); } }
                if (has_next) { sq += __shfl_xor(sq, 16); sq += __shfl_xor(sq, 32); if (fq == 0) PT[(ro + wr * 64 + fr) * 4 + wc] = sq; }
#if XB_PF
                if (!rd_f32 && ai * 4 + m + XB_PF < 8) XQ_LOAD(ai * 4 + m + XB_PF);
                if (ai * 4 + m + XB_PF < 8) PQ_LOAD(ai * 4 + m + XB_PF);
#endif
                asm volatile("" ::: "memory"); }
#if XB_PF
#undef XQ_LOAD
#undef PQ_LOAD
#endif
        if (has_next) {
            asm volatile("s_waitcnt lgkmcnt(0)" ::: "memory"); __builtin_amdgcn_s_barrier(); asm volatile("" ::: "memory");
            if (t_ < 256) { const f32x4 p = *(const PG8_LAS f32x4*)(PT + t_ * 4); nx.ssn[(size_t)(u.pm * BM + t_) * 8 + u.pn] = (p[0] + p[1]) + (p[2] + p[3]); }
        }
    }
    __device__ __forceinline__ void operator()(f32x4 (&acc)[2][2][4][2], const Unit& u, int, int, int, int, PG8_LAS unsigned char* lds) const {
        EPI_LANE_COORDS;
        run<false>(acc, u, wr, wc, fr, fq, nullptr, lds, t_);
    }
};
#ifndef ROPE_PRE
#define ROPE_PRE 1
#endif
struct EpiIn {
    static constexpr bool PERM = false, AFTER_DRAIN = false;
    __device__ __forceinline__ void stage(const Unit& u, PG8_LAS unsigned char* lds, int ui) const { const int cond = u.pm < 16 ? 0 : 1 + ((u.pm - 16) >> 3); stage_ss_bias(ss, bias + (size_t)cond * N_IN + u.pn * BM, u, lds, ui); }
    int l;
    unsigned char* ws; float* out_; const float* ss; const float* bias;
    __device__ __forceinline__ void operator()(f32x4 (&acc)[2][2][4][2], const Unit& u, int ui, int, int, int, PG8_LAS unsigned char* lds) const {
        EPI_LANE_COORDS;
        unsigned char* w = ws; float* out = out_; asm volatile("" : "+s"(w), "+s"(out)); w = as_global(w); out = as_global(out);
        bf16_t* const QA = (bf16_t*)(w + WS_QA); bf16_t* const KAL = (bf16_t*)(w + WS_KAL); bf16_t* const VAL = (bf16_t*)(w + WS_VAL); bf16_t* const KAC = (bf16_t*)(w + WS_KAC); bf16_t* const VAC = (bf16_t*)(w + WS_VAC);
        bf16_t* const QB = (bf16_t*)(w + WS_QB); bf16_t* const KBL = (bf16_t*)(w + WS_KBL); bf16_t* const VBL = (bf16_t*)(w + WS_VBL); bf16_t* const KBC = (bf16_t*)(w + WS_KBC); bf16_t* const VBC = (bf16_t*)(w + WS_VBC);
        bf16_t* const YTL = (bf16_t*)(w + WS_YTL); bf16_t* const YTC = (bf16_t*)(w + WS_YTC); const float* const rope = (const float*)(w + WS_ROPE); const float* const gains = (const float*)(w + WS_GAIN) + l * 384;
        const int pn = u.pn, pm = u.pm; const bool lat = pm >= 16; const int b = lat ? (pm - 16) >> 3 : pm; const int tbase = lat ? ((pm - 16) & 7) * 256 : 0;
        const int rl0 = wr * 64 + fr;
        {
            PG8_LAS unsigned char* xs = lds + EPIX_OFF + (ui & 1) * EPIX_SLOT;
            const PG8_LAS float* ssl = (const PG8_LAS float*)xs; const PG8_LAS float* bp = (const PG8_LAS float*)(xs + 8192) + wc * 32 + 4 * fq;
            f32x4 bv[2][2];
#pragma unroll
            for (int bj = 0; bj < 2; ++bj) { bv[bj][0] = *(const PG8_LAS f32x4*)(bp + bj * HALF); bv[bj][1] = *(const PG8_LAS f32x4*)(bp + bj * HALF + 16); }
#pragma unroll
            for (int ai = 0; ai < 2; ++ai)
#pragma unroll
                for (int m = 0; m < 4; ++m) { const float r = row_rinv(ssl, ai * HALF + m * 16 + rl0);
#pragma unroll
                    for (int bj = 0; bj < 2; ++bj) { acc[ai][bj][m][0] = acc[ai][bj][m][0] * r + bv[bj][0]; acc[ai][bj][m][1] = acc[ai][bj][m][1] * r + bv[bj][1]; } }
        }
        const size_t lrow = (size_t)(l * NB_LAT + b) * S_LAT;
        PG8_LAS float* P = (PG8_LAS float*)(lds + STAGE_BYTES);
        const bool normed = (pn <= 4) || (pn >= 6 && pn <= 9);
        if (normed) {
            const bool is128 = pn <= 4;
            int lbase, pstep, fbase, sbase;
            const float *cosT, *sinT; int tstride; const float* g;
            if (is128) { const int u16 = 4 * wc + fq; lbase = (u16 < 8 ? 0 : 64) + 4 * (u16 & 7); pstep = 32; fbase = (u16 < 8 ? 0 : 32) + 4 * (u16 & 7); sbase = 8 * u16;
                cosT = rope; sinT = rope + 2048 * 64; tstride = 64; g = gains + ((pn < 4) ? 0 : 128); }
            else { const int u8 = 4 * (wc & 1) + fq; lbase = (u8 < 4 ? 0 : 32) + 4 * (u8 & 3); pstep = 16; fbase = (u8 < 4 ? 0 : 16) + 4 * (u8 & 3); sbase = 64 * (wc >> 1) + 8 * u8;
                cosT = rope + 2 * 2048 * 64; sinT = cosT + 2048 * 32; tstride = 32; g = gains + ((pn < 8) ? 256 : 320); }
#if ROPE_PRE
            f32x4 csr[8], snr[8];
#define ROPE_LOAD(rg) do { const int tk_ = tbase + ((rg) >> 2) * HALF + ((rg) & 3) * 16 + rl0; csr[rg] = (f32x4){1.f, 1.f, 1.f, 1.f}; snr[rg] = (f32x4){0.f, 0.f, 0.f, 0.f}; \
                if (lat) { csr[rg] = *(const f32x4*)(cosT + (size_t)tk_ * tstride + fbase); snr[rg] = *(const f32x4*)(sinT + (size_t)tk_ * tstride + fbase); } } while (0)
            ROPE_LOAD(0); ROPE_LOAD(1);
#endif
            const f32x4 g0 = *(const f32x4*)(g + lbase), g1 = *(const f32x4*)(g + lbase + pstep);
#pragma unroll
            for (int ai = 0; ai < 2; ++ai)
#pragma unroll
                for (int m = 0; m < 4; ++m)
#pragma unroll
                    for (int bj = 0; bj < 2; ++bj) { const f32x4 a0 = acc[ai][bj][m][0], a1 = acc[ai][bj][m][1];
                        float s = (a0[0] * a0[0] + a0[1] * a0[1]) + (a0[2] * a0[2] + a0[3] * a0[3]) + (a1[0] * a1[0] + a1[1] * a1[1]) + (a1[2] * a1[2] + a1[3] * a1[3]);
                        s += __shfl_xor(s, 16); s += __shfl_xor(s, 32);
                        if (fq == 0) P[(bj * 256 + ai * HALF + m * 16 + rl0) * 4 + wc] = s; }
            asm volatile("s_waitcnt lgkmcnt(0)" ::: "memory"); __builtin_amdgcn_s_barrier(); asm volatile("" ::: "memory");
            const float invdim = is128 ? (1.0f / 128.0f) : (1.0f / 64.0f);
            const bool isq = (pn < 4) || (pn == 6) || (pn == 7);
            const float qscale = isq ? (is128 ? 0.088388347648318440f * 1.4426950408889634f : 0.125f * 1.4426950408889634f) : 1.0f;
#pragma unroll
            for (int ai = 0; ai < 2; ++ai)
#pragma unroll
                for (int m = 0; m < 4; ++m) { const int rl = ai * HALF + m * 16 + rl0; const int tk = tbase + rl; const size_t row = (size_t)pm * BM + rl;
#if ROPE_PRE
                    const f32x4 cs4 = csr[ai * 4 + m], sn4 = snr[ai * 4 + m];
#else
                    f32x4 cs4 = (f32x4){1.f, 1.f, 1.f, 1.f}, sn4 = (f32x4){0.f, 0.f, 0.f, 0.f};
                    if (lat) { cs4 = *(const f32x4*)(cosT + (size_t)tk * tstride + fbase); sn4 = *(const f32x4*)(sinT + (size_t)tk * tstride + fbase); }
#endif
#pragma unroll
                    for (int bj = 0; bj < 2; ++bj) { const f32x4 pp = *(const PG8_LAS f32x4*)(P + (bj * 256 + rl) * 4);
                        const float tot = is128 ? ((pp[0] + pp[1]) + (pp[2] + pp[3])) : (wc < 2 ? pp[0] + pp[1] : pp[2] + pp[3]);
                        const float rinv = __builtin_amdgcn_rsqf(tot * invdim + EPS) * qscale;
                        f32x4 x1 = acc[ai][bj][m][0] * rinv * g0, x2 = acc[ai][bj][m][1] * rinv * g1;
                        bf16_t* dst;
                        if (is128) { if (pn < 4) dst = QA + row * 1024 + (2 * pn + bj) * 128 + sbase;
                            else if (lat) dst = KAL + (lrow + tk) * 256 + bj * 128 + sbase;
                            else { dst = KAC + row * 256 + bj * 128 + sbase; float* st = out + OUT_SAK + ((size_t)(b * DEPTH + l) * T_CTX + tk) * 256 + bj * 128 + lbase; *(f32x4*)st = x1; *(f32x4*)(st + pstep) = x2; } }
                        else { const int h = 2 * ((pn - 6) & 1) + bj;
                            if (pn < 8) dst = QB + row * 512 + h * 128 + sbase;
                            else if (lat) dst = KBL + (lrow + tk) * 512 + h * 128 + sbase;
                            else { dst = KBC + row * 512 + h * 128 + sbase; float* st = out + OUT_SDK + ((size_t)(b * DEPTH + l) * T_CTX + tk) * 512 + h * 128 + 64 * (wc >> 1) + lbase; *(f32x4*)st = x1; *(f32x4*)(st + pstep) = x2; } }
                        if (lat) { const f32x4 y1 = x1 * cs4 - x2 * sn4, y2 = x2 * cs4 + x1 * sn4; x1 = y1; x2 = y2; }
                        *(u32x4*)dst = pack8(x1, x2); }
#if ROPE_PRE
                    if (ai * 4 + m + 2 < 8) ROPE_LOAD(ai * 4 + m + 2);
#endif
                    asm volatile("" ::: "memory");
                }
#if ROPE_PRE
#undef ROPE_LOAD
#endif
        } else if (pn == 5 || pn == 10 || pn == 11) {
            const bool isa = pn == 5; const int pitch = isa ? 256 : 512; const int hb = isa ? 0 : 2 * (pn - 10);
            const int sb = wc * 32 + 8 * fq;
#pragma unroll
            for (int ai = 0; ai < 2; ++ai)
#pragma unroll
                for (int m = 0; m < 4; ++m) { const int rl = ai * HALF + m * 16 + rl0; const int tk = tbase + rl; const size_t row = (size_t)pm * BM + rl;
#pragma unroll
                    for (int bj = 0; bj < 2; ++bj) { const int col = (hb + bj) * 128 + sb; const f32x4 x1 = acc[ai][bj][m][0], x2 = acc[ai][bj][m][1];
                        bf16_t* dst;
                        if (lat) dst = (isa ? VAL : VBL) + (lrow + tk) * pitch + col;
                        else { dst = (isa ? VAC : VBC) + row * pitch + col; float* st = out + (isa ? OUT_SAV : OUT_SDV) + ((size_t)(b * DEPTH + l) * T_CTX + tk) * pitch + col; *(f32x4*)st = x1; *(f32x4*)(st + 4) = x2; }
                        *(u32x4*)dst = pack8(x1, x2); } }
        } else {
            bf16_t* yb = YTL + ((size_t)pm * BM + rl0) * 1024 + (pn - 12) * BM + wc * 32 + 8 * fq;
#pragma unroll
            for (int ai = 0; ai < 2; ++ai)
#pragma unroll
                for (int m = 0; m < 4; ++m)
#pragma unroll
                    for (int bj = 0; bj < 2; ++bj) *(u32x4*)(yb + (size_t)(ai * HALF + m * 16) * 1024 + bj * HALF) = pack8(acc[ai][bj][m][0], acc[ai][bj][m][1]);
        }
    }
};
#ifndef SPLIT_XCD
#define SPLIT_XCD 1
#endif
struct SplitOrder {
    StaticOrder base; int c, on;
    __device__ __forceinline__ static bool producer(int c_) { return SPLIT_XCD ? (c_ & 4) != 0 : (c_ >> 7) != 0; }
    __device__ __forceinline__ static int pair(int c_) { return SPLIT_XCD ? ((c_ >> 3) << 2) | (c_ & 3) : (c_ & 127); }
    __device__ __forceinline__ void init(int M, int N, int G, int c_) { base.init(M, N, 256, pair(c_)); c = c_; on = (G == 256); }
    __device__ __forceinline__ bool next(int i, Unit& u) const { if (!on || i > 0) return false; const bool ok = base.next(2, u); u.kh = producer(c) ? 1 : 0; u.aux = pair(c); return ok; }
    __device__ __forceinline__ const char* aptr(const Unit& u, const Gemm& g) const { return base.aptr(u, g); }
    __device__ __forceinline__ const char* bptr(const Unit& u, const Gemm& g) const { return base.bptr(u, g); }
    __device__ __forceinline__ void a_ready(const Unit&) const {}
    __device__ __forceinline__ void done(const Unit&) const {}
};
struct EpiResSplit {
    static constexpr bool PERM = false, AFTER_DRAIN = false;
    __device__ __forceinline__ void stage(const Unit&, PG8_LAS unsigned char*, int) const {}
    EpiRes R; float* part; unsigned* flags; unsigned* tmo;
    __device__ __forceinline__ void operator()(f32x4 (&acc)[2][2][4][2], const Unit& u, int, int, int, int, PG8_LAS unsigned char* lds) const {
        EPI_LANE_COORDS;
        float* pb = part + (size_t)u.aux * 65536 + (size_t)t_ * 4;
        unsigned* flag = flags + (size_t)u.aux * 64;
        if (u.kh == 1) {
#pragma unroll
            for (int ai = 0; ai < 2; ++ai)
#pragma unroll
                for (int bj = 0; bj < 2; ++bj)
#pragma unroll
                    for (int m = 0; m < 4; ++m)
#pragma unroll
                        for (int n = 0; n < 2; ++n) *(f32x4*)(pb + (size_t)(((ai * 2 + bj) * 4 + m) * 2 + n) * 2048) = acc[ai][bj][m][n];
            asm volatile("s_waitcnt vmcnt(0)" ::: "memory");
            __builtin_amdgcn_s_barrier(); asm volatile("" ::: "memory");
            if (t_ == 0) { __builtin_amdgcn_fence(__ATOMIC_RELEASE, "agent"); asm volatile("s_waitcnt vmcnt(0)" ::: "memory");
                __hip_atomic_store(flag, 1u, __ATOMIC_RELAXED, __HIP_MEMORY_SCOPE_AGENT); }
        } else {
            if (wid_ == 0) {
                unsigned sp = 0;
                while ((unsigned)__builtin_amdgcn_readfirstlane(__hip_atomic_load(flag, __ATOMIC_RELAXED, __HIP_MEMORY_SCOPE_AGENT)) == 0u) {
                    __builtin_amdgcn_s_sleep(2);
                    if ((++sp & 1023u) == 0u) { if (__builtin_amdgcn_readfirstlane(__hip_atomic_load(tmo, __ATOMIC_RELAXED, __HIP_MEMORY_SCOPE_AGENT)) != 0u) break;
                        if (sp > (1u << 22)) { if (t_ == 0) __hip_atomic_store(tmo, 1u, __ATOMIC_RELAXED, __HIP_MEMORY_SCOPE_AGENT); break; } } }
                __builtin_amdgcn_fence(__ATOMIC_ACQUIRE, "agent");
                asm volatile("s_waitcnt vmcnt(0)" ::: "memory");
            }
            __builtin_amdgcn_s_barrier(); asm volatile("" ::: "memory");
            R.run<true>(acc, u, wr, wc, fr, fq, pb, lds, t_);
        }
    }
};
struct DftOrder {
    int lat, first, count, G, c;
    __device__ __forceinline__ bool next(int i, Unit& u) const {
        const int nu = lat ? 128 : 32; const int k = c - first; if (k < 0 || k >= count) return false; const int id = k + i * count; if (id >= nu) return false;
        u.kh = 0; u.aux = 0;
        if (lat) { const int b = id >> 4, pmm = (id >> 1) & 7; u.pm = 16 + b * 8 + pmm; u.pn = id & 1; } else { u.pm = id >> 1; u.pn = id & 1; }
        return true;
    }
    __device__ __forceinline__ const char* aptr(const Unit& u, const Gemm& g) const { return lat ? (const char*)g.A + (size_t)((u.pm - 16) & 7) * ((size_t)BM * g.ld * 2) : (const char*)g.A; }
    __device__ __forceinline__ const char* bptr(const Unit& u, const Gemm& g) const { const int b = lat ? (u.pm - 16) >> 3 : u.pm; return (const char*)g.Bt + ((size_t)b * 512 + (size_t)u.pn * BM) * ((size_t)g.ld * 2); }
    __device__ __forceinline__ void a_ready(const Unit&) const {}
    __device__ __forceinline__ void done(const Unit&) const {}
};
template <class Epi, class Sched, bool ALIGN_EPI = false, bool SP2 = false>
__device__ __forceinline__ void gemm_phase(PG8_LAS unsigned char* lds, const Gemm g, const Sched& S, const Epi& E) {
    int tid = threadIdx.x; asm volatile("" : "+v"(tid));
    const int wid = __builtin_amdgcn_readfirstlane(tid >> 6), lane = tid & 63, wr = wid >> 2, wc = wid & 3, fr = lane & 15, fq = lane >> 4;
    const int K = g.ldb ? g.ldb : g.ld, KA = g.lda ? g.lda : g.ld, nt = g.K / BK;
    unsigned voffA[2], voffB[2];
#pragma unroll
    for (int i = 0; i < 2; ++i) { int R, C; stage_rc(tid * 16 + i * 8192, R, C); const int Rb = Epi::PERM ? ((R & ~31) + perm32(R & 31)) : R;
        voffA[i] = (unsigned)(R * KA + C) * 2u; voffB[i] = (unsigned)(Rb * K + C) * 2u; }
    const size_t kstepB = g.kstepB ? g.kstepB : (size_t)(BK * 2), kstepA = g.kstepA ? g.kstepA : (size_t)(BK * 2);
    const size_t hstepB = (size_t)HALF * K * 2, hstepA = (size_t)HALF * KA * 2;
    const size_t tstep = 2 * hstepB; (void)tstep;
    const unsigned ldsw = (unsigned)wid * 1024u;
    const int aoff = lds_byte(wr * 64 + fr, fq * 8), boff = lds_byte(wc * 32 + fr, fq * 8);
#define PG8_SA(b, h) (((b) * 2 + (h)) * HTB)
#define PG8_SB(b, h) ((4 + (b) * 2 + (h)) * HTB)
#define PG8_STAGE(bufoff, gbase, voff) do { _Pragma("unroll") for (int _i = 0; _i < 2; ++_i) \
        __builtin_amdgcn_global_load_lds((const unsigned*)((const char*)(gbase) + (voff)[_i]), (PG8_LAS unsigned*)(lds + (bufoff) + ldsw + _i * 8192), 16, 0, 0); } while (0)
#define PG8_LDA(dst, b, h) do { _Pragma("unroll") for (int m = 0; m < 4; ++m) _Pragma("unroll") for (int k = 0; k < 2; ++k) dst[m][k] = *(const PG8_LAS bf16x8*)(lds + PG8_SA(b, h) + aoff + m * 2048 + k * 1024); } while (0)
#define PG8_LDB(dst, b, h) do { _Pragma("unroll") for (int n = 0; n < 2; ++n) _Pragma("unroll") for (int k = 0; k < 2; ++k) dst[n][k] = *(const PG8_LAS bf16x8*)(lds + PG8_SB(b, h) + boff + n * 2048 + k * 1024); } while (0)
#define PG8_MMA(ai, bj, At, Bt) do { __builtin_amdgcn_s_setprio(1); _Pragma("unroll") for (int m = 0; m < 4; ++m) _Pragma("unroll") for (int n = 0; n < 2; ++n) _Pragma("unroll") for (int k = 0; k < 2; ++k) \
        acc[ai][bj][m][n] = __builtin_amdgcn_mfma_f32_16x16x32_bf16(Bt[n][k], At[m][k], acc[ai][bj][m][n], 0, 0, 0); __builtin_amdgcn_s_setprio(0); } while (0)
#define PG8_WAIT_V(n) asm volatile("s_waitcnt vmcnt(" #n ")" ::: "memory")
#define PG8_WAIT_L(n) asm volatile("s_waitcnt lgkmcnt(" #n ")" ::: "memory")
#define PG8_BAR __builtin_amdgcn_s_barrier()
#define PG8_SCHED __builtin_amdgcn_sched_barrier(0)
    Unit cur, nxt; int ui = 0;
    if (!S.next(0, cur)) return;
    f32x4 acc[2][2][4][2];
#pragma unroll
    for (int a = 0; a < 2; ++a)
#pragma unroll
        for (int b = 0; b < 2; ++b)
#pragma unroll
            for (int m = 0; m < 4; ++m)
#pragma unroll
                for (int n = 0; n < 2; ++n) acc[a][b][m][n] = (f32x4){0.f, 0.f, 0.f, 0.f};
    bf16x8 At[4][2], B0[2][2], B1[2][2];
    const char* cA = S.aptr(cur, g); const char* cB = S.bptr(cur, g);
    S.a_ready(cur);
    E.stage(cur, lds, 0);
    if constexpr (SP2) {
        PG8_STAGE(PG8_SB(0, 0), cB, voffB); PG8_STAGE(PG8_SB(0, 1), cB + hstepB, voffB); PG8_STAGE(PG8_SA(0, 0), cA, voffA); PG8_STAGE(PG8_SA(0, 1), cA + hstepA, voffA);
        if (wr == 1) PG8_BAR;
        PG8_WAIT_V(2); PG8_BAR;
        PG8_STAGE(PG8_SB(1, 0), cB + kstepB, voffB); PG8_STAGE(PG8_SA(1, 0), cA + kstepA, voffA); PG8_STAGE(PG8_SB(1, 1), cB + hstepB + kstepB, voffB);
        PG8_WAIT_V(6); PG8_BAR;
    } else {
        PG8_STAGE(PG8_SB(0, 0), cB, voffB); PG8_STAGE(PG8_SA(0, 0), cA, voffA); PG8_STAGE(PG8_SB(0, 1), cB + hstepB, voffB); PG8_STAGE(PG8_SA(0, 1), cA + hstepA, voffA);
        if (wr == 1) PG8_BAR;
        PG8_WAIT_V(4); PG8_BAR;
        PG8_STAGE(PG8_SB(1, 0), cB + kstepB, voffB); PG8_STAGE(PG8_SA(1, 0), cA + kstepA, voffA); PG8_STAGE(PG8_SB(1, 1), cB + hstepB + kstepB, voffB);
        PG8_WAIT_V(6); PG8_BAR;
    }
    for (;;) {
        const bool has_next = S.next(ui + 1, nxt);
        const char* nA = has_next ? S.aptr(nxt, g) : cA; const char* nB = has_next ? S.bptr(nxt, g) : cB;
        for (int t = 0; t < nt; t += 2) {
            const bool last = (t == nt - 2);
            const char* a1 = cA + (size_t)(t + 1) * kstepA;
            const char* a2 = last ? nA : cA + (size_t)(t + 2) * kstepA; const char* b2 = last ? nB : cB + (size_t)(t + 2) * kstepB;
            const char* a3 = a2 + kstepA; const char* b3 = b2 + kstepB;
            if (last && has_next) S.a_ready(nxt);
            if constexpr (SP2) {
            PG8_LDB(B0, 0, 0); PG8_LDB(B1, 0, 1); PG8_SCHED; PG8_LDA(At, 0, 0); PG8_STAGE(PG8_SA(1, 1), a1 + hstepA, voffA);
            PG8_WAIT_V(8); PG8_WAIT_L(0); PG8_BAR; PG8_MMA(0, 0, At, B0); PG8_MMA(0, 1, At, B1); PG8_BAR; PG8_SCHED;
            PG8_LDA(At, 0, 1); PG8_STAGE(PG8_SB(0, 0), b2, voffB); PG8_STAGE(PG8_SB(0, 1), b2 + hstepB, voffB); PG8_STAGE(PG8_SA(0, 0), a2, voffA);
            PG8_WAIT_V(8); PG8_WAIT_L(0); PG8_BAR; PG8_MMA(1, 0, At, B0); PG8_MMA(1, 1, At, B1); PG8_BAR; PG8_SCHED;
            PG8_LDB(B0, 1, 0); PG8_LDB(B1, 1, 1); PG8_SCHED; PG8_LDA(At, 1, 0); PG8_STAGE(PG8_SA(0, 1), a2 + hstepA, voffA);
            PG8_WAIT_V(8); PG8_WAIT_L(0); PG8_BAR; PG8_MMA(0, 0, At, B0); PG8_MMA(0, 1, At, B1); PG8_BAR; PG8_SCHED;
            PG8_LDA(At, 1, 1); PG8_STAGE(PG8_SB(1, 0), b3, voffB); PG8_STAGE(PG8_SB(1, 1), b3 + hstepB, voffB); PG8_STAGE(PG8_SA(1, 0), a3, voffA);
            PG8_WAIT_V(8); PG8_WAIT_L(0); PG8_BAR; PG8_MMA(1, 0, At, B0); PG8_MMA(1, 1, At, B1); PG8_BAR; PG8_SCHED;
            } else {
            PG8_LDB(B0, 0, 0); PG8_SCHED; PG8_LDA(At, 0, 0); PG8_STAGE(PG8_SA(1, 1), a1 + hstepA, voffA);
            PG8_WAIT_L(8); PG8_BAR; PG8_WAIT_L(0); PG8_MMA(0, 0, At, B0); PG8_BAR; PG8_SCHED;
            PG8_LDB(B1, 0, 1); PG8_STAGE(PG8_SB(0, 0), b2, voffB);
            PG8_BAR; PG8_WAIT_L(0); PG8_MMA(0, 1, At, B1); PG8_BAR;
            PG8_LDA(At, 0, 1); PG8_STAGE(PG8_SA(0, 0), a2, voffA);
            PG8_BAR; PG8_WAIT_L(0); PG8_MMA(1, 0, At, B0); PG8_BAR; PG8_SCHED;
            PG8_STAGE(PG8_SB(0, 1), b2 + hstepB, voffB);
            PG8_WAIT_V(6); PG8_BAR; PG8_MMA(1, 1, At, B1); PG8_BAR;
            PG8_LDB(B0, 1, 0); PG8_SCHED; PG8_LDA(At, 1, 0); PG8_STAGE(PG8_SA(0, 1), a2 + hstepA, voffA);
            PG8_WAIT_L(8); PG8_BAR; PG8_WAIT_L(0); PG8_MMA(0, 0, At, B0); PG8_BAR; PG8_SCHED;
            PG8_LDB(B1, 1, 1); PG8_STAGE(PG8_SB(1, 0), b3, voffB);
            PG8_BAR; PG8_WAIT_L(0); PG8_MMA(0, 1, At, B1); PG8_BAR;
            PG8_LDA(At, 1, 1); PG8_STAGE(PG8_SA(1, 0), a3, voffA);
            PG8_BAR; PG8_WAIT_L(0); PG8_MMA(1, 0, At, B0); PG8_BAR; PG8_SCHED;
            PG8_STAGE(PG8_SB(1, 1), b3 + hstepB, voffB);
            PG8_WAIT_V(6); PG8_BAR; PG8_MMA(1, 1, At, B1); PG8_BAR;
            }
        }
        if constexpr (ALIGN_EPI) { if (wr == 0) PG8_BAR; }
        if constexpr (!Epi::AFTER_DRAIN) { E(acc, cur, ui, 0, 0, 0, lds); S.done(cur); }
        if (!has_next) break;
#pragma unroll
        for (int a = 0; a < 2; ++a)
#pragma unroll
            for (int b = 0; b < 2; ++b)
#pragma unroll
                for (int m = 0; m < 4; ++m)
#pragma unroll
                    for (int n = 0; n < 2; ++n) acc[a][b][m][n] = (f32x4){0.f, 0.f, 0.f, 0.f};
        cur = nxt; cA = nA; cB = nB; ++ui;
        E.stage(cur, lds, ui);
        if constexpr (ALIGN_EPI) { if (wr == 1) PG8_BAR; }
    }
    PG8_WAIT_V(0);
    if constexpr (!ALIGN_EPI) { if (wr == 0) PG8_BAR; }
    PG8_BAR;
    if constexpr (Epi::AFTER_DRAIN) { E.fused(acc, cur, wr, wc, fr, fq, lds, wid, lane); S.done(cur); }
#undef PG8_SA
#undef PG8_SB
#undef PG8_STAGE
#undef PG8_LDA
#undef PG8_LDB
#undef PG8_MMA
#undef PG8_WAIT_V
#undef PG8_WAIT_L
#undef PG8_BAR
#undef PG8_SCHED
}
}
namespace att {
constexpr int DV = 128, NW = 8, QBLK = 32, KVBLK = 64;
constexpr float THR = 8.f;
constexpr size_t SHM_V = KVBLK * DV * 2, SHM_K = KVBLK * DV * 2, SHM_ATTN = 2 * SHM_V + 2 * SHM_K + NW * 64 * 4;
constexpr size_t SHM_ATTN3 = 3 * SHM_V + 3 * SHM_K + NW * 64 * 4;
using s16x4 = __attribute__((ext_vector_type(4))) short;
using f32x16 = __attribute__((ext_vector_type(16))) float;
using f32x2v = __attribute__((ext_vector_type(2))) float;
#ifndef PK_SUM
#define PK_SUM 0
#endif
#define KSWZ(row, colB) ((row) * 256 + ((colB) ^ (((row) & 7) << 4)))
#define SBAR() __builtin_amdgcn_sched_barrier(0)
__device__ __forceinline__ int crow(int r, int hi) { return (r & 3) + 8 * (r >> 2) + 4 * hi; }
__device__ __forceinline__ unsigned cvtpk(float lo, float hi) { unsigned r; asm volatile("v_cvt_pk_bf16_f32 %0, %1, %2" : "=v"(r) : "v"(lo), "v"(hi)); return r; }

template <int DQK>
__device__ __forceinline__ void partialSM(f32x16& p0, f32x16& p1, float& m_reg, float& mn, float& alpha) {
  (void)m_reg; (void)p1; mn = 0.f; alpha = 1.f;
#pragma unroll
  for (int r = 0; r < 16; ++r) p0[r] = __builtin_amdgcn_exp2f(p0[r]);
}
__device__ __forceinline__ void finishSM(f32x16& p0, f32x16& p1, float alpha, float& l_reg, bf16x8& pa0, bf16x8& pa1, bf16x8& pa2, bf16x8& pa3) {
#pragma unroll
  for (int r = 0; r < 16; ++r) p1[r] = __builtin_amdgcn_exp2f(p1[r]);
#if PK_SUM
  f32x2v ps2 = (f32x2v){0.f, 0.f};
#pragma unroll
  for (int r = 0; r < 16; r += 2) ps2 = ps2 + (f32x2v){p0[r], p0[r + 1]};
#pragma unroll
  for (int r = 0; r < 16; r += 2) ps2 = ps2 + (f32x2v){p1[r], p1[r + 1]};
  float ps = ps2[0] + ps2[1];
#else
  float ps = 0;
#pragma unroll
  for (int r = 0; r < 16; ++r) ps += p0[r];
#pragma unroll
  for (int r = 0; r < 16; ++r) ps += p1[r];
#endif
  { auto rr = __builtin_amdgcn_permlane32_swap(__float_as_uint(ps), __float_as_uint(ps), false, false);
    ps = __uint_as_float(rr[0]) + __uint_as_float(rr[1]); }
  l_reg = l_reg * alpha + ps;
#define PK4(P, BASE, OUT) do { unsigned a0 = cvtpk(P[BASE + 0], P[BASE + 1]), a1 = cvtpk(P[BASE + 2], P[BASE + 3]);   \
    unsigned b0 = cvtpk(P[BASE + 4], P[BASE + 5]), b1 = cvtpk(P[BASE + 6], P[BASE + 7]);                              \
    auto r0 = __builtin_amdgcn_permlane32_swap(a0, b0, false, false); auto r1 = __builtin_amdgcn_permlane32_swap(a1, b1, false, false); \
    u32x4 w = {r0[0], r1[0], r0[1], r1[1]}; OUT = *reinterpret_cast<bf16x8*>(&w); } while (0)
  PK4(p0, 0, pa0); PK4(p0, 8, pa1); PK4(p1, 0, pa2); PK4(p1, 8, pa3);
#undef PK4
}
#ifndef QK_PIPE
#define QK_PIPE 0
#endif
template <int OFF> __device__ __forceinline__ bf16x8 lds_rd128(int addr) { bf16x8 r; asm volatile("ds_read_b128 %0, %1 offset:%2" : "=&v"(r) : "v"(addr), "i"(OFF) : "memory"); return r; }
#if QK_PIPE
template <int DQK>
__device__ __forceinline__ void qkt(f32x16& p0, f32x16& p1, const char* Ks, const bf16x8* qr, int r32, int hi, int koffB) {
  p0 = f32x16{}; p1 = f32x16{};
  constexpr int N = DQK / 16;
  const int A0 = (int)(uintptr_t)Ks + koffB + r32 * 256 + ((hi * 16) ^ ((r32 & 7) << 4));
  bf16x8 k0[2], k1[2];
  k0[0] = lds_rd128<0>(A0); k1[0] = lds_rd128<8192>(A0);
  k0[1] = lds_rd128<0>(A0 ^ 32); k1[1] = lds_rd128<8192>(A0 ^ 32);
#pragma unroll
  for (int d0 = 0; d0 < N; ++d0) { const int b = d0 & 1;
    if (d0 + 1 < N) asm volatile("s_waitcnt lgkmcnt(2)" : "+v"(k0[b]), "+v"(k1[b]) :: "memory"); else asm volatile("s_waitcnt lgkmcnt(0)" : "+v"(k0[b]), "+v"(k1[b]) :: "memory");
    p0 = __builtin_amdgcn_mfma_f32_32x32x16_bf16(k0[b], qr[d0], p0, 0, 0, 0);
    p1 = __builtin_amdgcn_mfma_f32_32x32x16_bf16(k1[b], qr[d0], p1, 0, 0, 0);
    if (d0 + 2 < N) { const int a = A0 ^ ((d0 + 2) << 5); k0[b] = lds_rd128<0>(a); k1[b] = lds_rd128<8192>(a); } }
}
#else
template <int DQK>
__device__ __forceinline__ void qkt(f32x16& p0, f32x16& p1, const char* Ks, const bf16x8* qr, int r32, int hi, int koffB) {
  p0 = f32x16{}; p1 = f32x16{};
  Ks += koffB;
#pragma unroll
  for (int d0 = 0; d0 < DQK / 16; ++d0) { int cb = (d0 * 16 + hi * 8) * 2;
    bf16x8 b0 = *reinterpret_cast<const bf16x8*>(Ks + KSWZ(r32, cb));
    bf16x8 b1 = *reinterpret_cast<const bf16x8*>(Ks + KSWZ(32 + r32, cb));
    p0 = __builtin_amdgcn_mfma_f32_32x32x16_bf16(b0, qr[d0], p0, 0, 0, 0);
    p1 = __builtin_amdgcn_mfma_f32_32x32x16_bf16(b1, qr[d0], p1, 0, 0, 0); }
}
#endif
__device__ __forceinline__ int v_st(int k, int c) { const int kk = (k & ~0xC) | ((k & 4) << 1) | ((k & 8) >> 1); return ((kk >> 3) * 4 + (c >> 5)) * 512 + ((kk & 7) * 32 + (c & 31)) * 2; }
__device__ __forceinline__ int v_rd_base(int lane) { return ((lane & 3) << 3) | (((lane >> 2) & 3) << 6) | (((lane >> 4) & 1) << 5) | (((lane >> 5) & 1) << 8); }
constexpr int v_rd_off(int d0, int ks, int half) { return d0 * 512 + ks * 4096 + half * 2048; }
template <int OFF> __device__ __forceinline__ s16x4 tr_read(int vb) {
  s16x4 r; asm volatile("ds_read_b64_tr_b16 %0, %1 offset:%2" : "=&v"(r) : "v"(vb), "i"(OFF) : "memory"); return r;
}
template <int D0> __device__ __forceinline__ void pv_one(f32x16& od, int vb, bf16x8 pa0, bf16x8 pa1, bf16x8 pa2, bf16x8 pa3) {
  const s16x4 l0 = tr_read<v_rd_off(D0, 0, 0)>(vb), h0 = tr_read<v_rd_off(D0, 0, 1)>(vb), l1 = tr_read<v_rd_off(D0, 1, 0)>(vb), h1 = tr_read<v_rd_off(D0, 1, 1)>(vb);
  const s16x4 l2 = tr_read<v_rd_off(D0, 2, 0)>(vb), h2 = tr_read<v_rd_off(D0, 2, 1)>(vb), l3 = tr_read<v_rd_off(D0, 3, 0)>(vb), h3 = tr_read<v_rd_off(D0, 3, 1)>(vb);
  asm volatile("s_waitcnt lgkmcnt(0)" ::: "memory"); SBAR();
#define PK(L, H) (bf16x8){L[0], L[1], L[2], L[3], H[0], H[1], H[2], H[3]}
  od = __builtin_amdgcn_mfma_f32_32x32x16_bf16(pa0, PK(l0, h0), od, 0, 0, 0);
  od = __builtin_amdgcn_mfma_f32_32x32x16_bf16(pa1, PK(l1, h1), od, 0, 0, 0);
  od = __builtin_amdgcn_mfma_f32_32x32x16_bf16(pa2, PK(l2, h2), od, 0, 0, 0);
  od = __builtin_amdgcn_mfma_f32_32x32x16_bf16(pa3, PK(l3, h3), od, 0, 0, 0);
#undef PK
}
#ifndef ATT_PRO2
#define ATT_PRO2 0
#endif
#ifndef HALF_K_STAGE
#define HALF_K_STAGE 1
#endif
#ifndef ATT_PRIO
#define ATT_PRIO 0
#endif
#ifndef PV_EXPN
#define PV_EXPN 0
#endif
#ifndef PV_PIPE
#define PV_PIPE 1
#endif
#if PV_PIPE
template <bool EXPN>
__device__ __forceinline__ void pv_d0x(f32x16* o, int vb, bf16x8 pa0, bf16x8 pa1, bf16x8 pa2, bf16x8 pa3, f32x16& pn) {
#define EX4(G) do { if (EXPN) { _Pragma("unroll") for (int r = 4 * (G); r < 4 * (G) + 4; ++r) pn[r] = __builtin_amdgcn_exp2f(pn[r]); } } while (0)
#define RD8(D0, R) do { R[0] = tr_read<v_rd_off(D0, 0, 0)>(vb); R[1] = tr_read<v_rd_off(D0, 0, 1)>(vb); R[2] = tr_read<v_rd_off(D0, 1, 0)>(vb); R[3] = tr_read<v_rd_off(D0, 1, 1)>(vb); \
    R[4] = tr_read<v_rd_off(D0, 2, 0)>(vb); R[5] = tr_read<v_rd_off(D0, 2, 1)>(vb); R[6] = tr_read<v_rd_off(D0, 3, 0)>(vb); R[7] = tr_read<v_rd_off(D0, 3, 1)>(vb); } while (0)
#define PK(L, H) (bf16x8){L[0], L[1], L[2], L[3], H[0], H[1], H[2], H[3]}
#define MM4(O, R) do { if (ATT_PRIO) __builtin_amdgcn_s_setprio(1); O = __builtin_amdgcn_mfma_f32_32x32x16_bf16(pa0, PK(R[0], R[1]), O, 0, 0, 0); O = __builtin_amdgcn_mfma_f32_32x32x16_bf16(pa1, PK(R[2], R[3]), O, 0, 0, 0); \
    O = __builtin_amdgcn_mfma_f32_32x32x16_bf16(pa2, PK(R[4], R[5]), O, 0, 0, 0); O = __builtin_amdgcn_mfma_f32_32x32x16_bf16(pa3, PK(R[6], R[7]), O, 0, 0, 0); if (ATT_PRIO) __builtin_amdgcn_s_setprio(0); } while (0)
  s16x4 ra[8], rb[8], rc[8], rd[8];
  RD8(0, ra); RD8(1, rb);
  asm volatile("s_waitcnt lgkmcnt(8)" ::: "memory"); SBAR(); MM4(o[0], ra); RD8(2, rc); EX4(0);
  asm volatile("s_waitcnt lgkmcnt(8)" ::: "memory"); SBAR(); MM4(o[1], rb); RD8(3, rd); EX4(1);
  asm volatile("s_waitcnt lgkmcnt(8)" ::: "memory"); SBAR(); MM4(o[2], rc); EX4(2);
  asm volatile("s_waitcnt lgkmcnt(0)" ::: "memory"); SBAR(); MM4(o[3], rd); EX4(3);
#undef RD8
#undef PK
#undef MM4
#undef EX4
}
__device__ __forceinline__ void pv_d0(f32x16* o, int vb, bf16x8 pa0, bf16x8 pa1, bf16x8 pa2, bf16x8 pa3) { f32x16 dummy; pv_d0x<false>(o, vb, pa0, pa1, pa2, pa3, dummy); }
#else
__device__ __forceinline__ void pv_d0(f32x16* o, int vb, bf16x8 pa0, bf16x8 pa1, bf16x8 pa2, bf16x8 pa3) {
  pv_one<0>(o[0], vb, pa0, pa1, pa2, pa3); pv_one<1>(o[1], vb, pa0, pa1, pa2, pa3); pv_one<2>(o[2], vb, pa0, pa1, pa2, pa3); pv_one<3>(o[3], vb, pa0, pa1, pa2, pa3);
}
#endif
template <int DQK, int LDQ, int LDK>
__device__ __forceinline__ void body(const bf16_t* __restrict__ Qb, const bf16_t* __restrict__ Kh, const bf16_t* __restrict__ Vh, int seq, int koffB, char* lds, f32x16 (&o)[4], float (&rli)[16]) {
  int tid = threadIdx.x; asm volatile("" : "+v"(tid));
  const int wid = tid >> 6, lane = tid & 63, r32 = lane & 31, hi = lane >> 5;
  char* V_lds = lds; char* K_lds = lds + 2 * SHM_V;
  float* ws = (float*)(lds + 2 * SHM_V + 2 * SHM_K) + wid * 64; float* li_l = ws;
  float m_reg = -1e30f, l_reg = 0;
#pragma unroll
  for (int d = 0; d < 4; ++d) o[d] = f32x16{};
  bf16x8 qr[DQK / 16];
  const bf16_t* Qw = Qb + (long)(wid * QBLK + r32) * LDQ + hi * 8;
#pragma unroll
  for (int d0 = 0; d0 < DQK / 16; ++d0) qr[d0] = *reinterpret_cast<const bf16x8*>(Qw + d0 * 16);
  const int sr = tid >> 4, sc = (tid & 15) * 8, vst0 = v_st(sr, sc), vst1 = v_st(32 + sr, sc);
  constexpr bool HALFK = (DQK == 64) && HALF_K_STAGE; const int kr_ = tid >> 3, kcB_ = koffB + (tid & 7) * 16, kcE_ = kcB_ >> 1; (void)kr_; (void)kcB_; (void)kcE_;
  const int vb0 = (int)(uintptr_t)V_lds + v_rd_base(lane);
  bf16x8 sv0a, sv1a, sk0a, sk1a, sv0b, sv1b, sk0b, sk1b;
#define KLOADS(k0, K0, K1) do { if constexpr (HALFK) { K0 = *(const bf16x8*)&Kh[(long)((k0) + kr_) * LDK + kcE_]; } \
    else { K0 = *(const bf16x8*)&Kh[(long)((k0) + sr) * LDK + sc]; K1 = *(const bf16x8*)&Kh[(long)((k0) + 32 + sr) * LDK + sc]; } } while (0)
#define SLOAD_A(k0) do { sv0a = *(const bf16x8*)&Vh[(long)((k0) + sr) * LDK + sc]; sv1a = *(const bf16x8*)&Vh[(long)((k0) + 32 + sr) * LDK + sc]; KLOADS(k0, sk0a, sk1a); } while (0)
#define SLOAD_B(k0) do { sv0b = *(const bf16x8*)&Vh[(long)((k0) + sr) * LDK + sc]; sv1b = *(const bf16x8*)&Vh[(long)((k0) + 32 + sr) * LDK + sc]; KLOADS(k0, sk0b, sk1b); } while (0)
#define SWRITE(b, V0, V1, K0, K1) do { *(bf16x8*)(V_lds + (b) * SHM_V + vst0) = V0; *(bf16x8*)(V_lds + (b) * SHM_V + vst1) = V1; const int kc = sc * 2; \
    if constexpr (HALFK) { *(bf16x8*)(K_lds + (b) * SHM_K + KSWZ(kr_, kcB_)) = K0; } \
    else { *(bf16x8*)(K_lds + (b) * SHM_K + KSWZ(sr, kc)) = K0; *(bf16x8*)(K_lds + (b) * SHM_K + KSWZ(32 + sr, kc)) = K1; } } while (0)
#define SWAIT() do { if constexpr (HALFK) asm volatile("s_waitcnt vmcnt(3)" ::: "memory"); else asm volatile("s_waitcnt vmcnt(4)" ::: "memory"); } while (0)
#define RESC(a) do { (void)(a); } while (0)
#if PV_PIPE && PV_EXPN
#define PVSM(VB, P0, P1, MN, AL) do { pv_d0x<true>(o, VB, pa0, pa1, pa2, pa3, P0); MN = 0.f; AL = 1.f; } while (0)
#else
#define PVSM(VB, P0, P1, MN, AL) do { pv_d0(o, VB, pa0, pa1, pa2, pa3); partialSM<DQK>(P0, P1, m_reg, MN, AL); } while (0)
#endif
  f32x16 pA0, pA1, pB0, pB1; float mnA, mnB, alA, alB; bf16x8 pa0, pa1, pa2, pa3; const int NT = seq / KVBLK;
#if ATT_PRO2
  SLOAD_A(0); SLOAD_B(KVBLK); SWAIT(); SWRITE(0, sv0a, sv1a, sk0a, sk1a); __syncthreads();
  if (2 < NT) SLOAD_A(2 * KVBLK);
  qkt<DQK>(pA0, pA1, K_lds, qr, r32, hi, koffB); partialSM<DQK>(pA0, pA1, m_reg, mnA, alA);
  SWAIT(); SWRITE(1, sv0b, sv1b, sk0b, sk1b); __syncthreads();
#else
  SLOAD_A(0); asm volatile("s_waitcnt vmcnt(0)" ::: "memory"); SWRITE(0, sv0a, sv1a, sk0a, sk1a); __syncthreads();
  qkt<DQK>(pA0, pA1, K_lds, qr, r32, hi, koffB); partialSM<DQK>(pA0, pA1, m_reg, mnA, alA);
  SLOAD_B(KVBLK); if (2 < NT) SLOAD_A(2 * KVBLK);
  SWAIT(); SWRITE(1, sv0b, sv1b, sk0b, sk1b); __syncthreads();
#endif
  for (int j = 1; j + 1 < NT; j += 2) {
    SBAR(); qkt<DQK>(pB0, pB1, K_lds + SHM_K, qr, r32, hi, koffB);
    finishSM(pA0, pA1, alA, l_reg, pa0, pa1, pa2, pa3); SBAR();
    SLOAD_B((j + 2) * KVBLK); SBAR();
    PVSM(vb0, pB0, pB1, mnB, alB);
    __syncthreads(); SWAIT(); SWRITE(0, sv0a, sv1a, sk0a, sk1a);
    RESC(alB); __syncthreads();
    SBAR(); qkt<DQK>(pA0, pA1, K_lds, qr, r32, hi, koffB);
    finishSM(pB0, pB1, alB, l_reg, pa0, pa1, pa2, pa3); SBAR();
    if (j + 3 < NT) SLOAD_A((j + 3) * KVBLK); SBAR();
    PVSM(vb0 + (int)SHM_V, pA0, pA1, mnA, alA);
    __syncthreads(); SWAIT(); SWRITE(1, sv0b, sv1b, sk0b, sk1b);
    RESC(alA); __syncthreads();
  }
  SBAR(); qkt<DQK>(pB0, pB1, K_lds + SHM_K, qr, r32, hi, koffB);
  finishSM(pA0, pA1, alA, l_reg, pa0, pa1, pa2, pa3); SBAR();
  PVSM(vb0, pB0, pB1, mnB, alB);
  __syncthreads(); RESC(alB);
  finishSM(pB0, pB1, alB, l_reg, pa0, pa1, pa2, pa3); SBAR();
  pv_d0(o, vb0 + (int)SHM_V, pa0, pa1, pa2, pa3);
  if (hi == 0) li_l[r32] = l_reg; asm volatile("s_waitcnt lgkmcnt(0)" ::: "memory");
#pragma unroll
  for (int r = 0; r < 16; ++r) rli[r] = __builtin_amdgcn_rcpf(li_l[crow(r, hi)]);
  __syncthreads();
#undef PVSM
#undef KLOADS
#undef SLOAD_A
#undef SLOAD_B
#undef SWRITE
#undef SWAIT
#undef RESC
}
template <int DQK, int LDQ, int LDK>
__device__ __forceinline__ void body3(const bf16_t* __restrict__ Qb, const bf16_t* __restrict__ Kh, const bf16_t* __restrict__ Vh, int seq, int koffB, char* lds, f32x16 (&o)[4], float (&rli)[16]) {
  int tid = threadIdx.x; asm volatile("" : "+v"(tid));
  const int wid = tid >> 6, lane = tid & 63, r32 = lane & 31, hi = lane >> 5;
  char* V_lds = lds; char* K_lds = lds + 3 * SHM_V;
  float* ws = (float*)(lds + 3 * SHM_V + 3 * SHM_K) + wid * 64; float* li_l = ws;
  float m_reg = -1e30f, l_reg = 0;
#pragma unroll
  for (int d = 0; d < 4; ++d) o[d] = f32x16{};
  bf16x8 qr[DQK / 16];
  const bf16_t* Qw = Qb + (long)(wid * QBLK + r32) * LDQ + hi * 8;
#pragma unroll
  for (int d0 = 0; d0 < DQK / 16; ++d0) qr[d0] = *reinterpret_cast<const bf16x8*>(Qw + d0 * 16);
  const int sr = tid >> 4, sc = (tid & 15) * 8, vst0 = v_st(sr, sc), vst1 = v_st(32 + sr, sc);
  const int vb0 = (int)(uintptr_t)V_lds + v_rd_base(lane);
  bf16x8 sv0a, sv1a, sk0a, sk1a, sv0b, sv1b, sk0b, sk1b;
#define SLOAD_A(k0) do { sv0a = *(const bf16x8*)&Vh[(long)((k0) + sr) * LDK + sc]; sv1a = *(const bf16x8*)&Vh[(long)((k0) + 32 + sr) * LDK + sc]; \
    sk0a = *(const bf16x8*)&Kh[(long)((k0) + sr) * LDK + sc]; sk1a = *(const bf16x8*)&Kh[(long)((k0) + 32 + sr) * LDK + sc]; } while (0)
#define SLOAD_B(k0) do { sv0b = *(const bf16x8*)&Vh[(long)((k0) + sr) * LDK + sc]; sv1b = *(const bf16x8*)&Vh[(long)((k0) + 32 + sr) * LDK + sc]; \
    sk0b = *(const bf16x8*)&Kh[(long)((k0) + sr) * LDK + sc]; sk1b = *(const bf16x8*)&Kh[(long)((k0) + 32 + sr) * LDK + sc]; } while (0)
#define SWRITE(bo, V0, V1, K0, K1) do { *(bf16x8*)(V_lds + (bo) + vst0) = V0; *(bf16x8*)(V_lds + (bo) + vst1) = V1; const int kc = sc * 2; \
    *(bf16x8*)(K_lds + (bo) + KSWZ(sr, kc)) = K0; *(bf16x8*)(K_lds + (bo) + KSWZ(32 + sr, kc)) = K1; } while (0)
#define SWAIT() asm volatile("s_waitcnt vmcnt(4)" ::: "memory")
#define RESC(a) do { (void)(a); } while (0)
#if PV_PIPE && PV_EXPN
#define PVSM(VB, P0, P1, MN, AL) do { pv_d0x<true>(o, VB, pa0, pa1, pa2, pa3, P0); MN = 0.f; AL = 1.f; } while (0)
#else
#define PVSM(VB, P0, P1, MN, AL) do { pv_d0(o, VB, pa0, pa1, pa2, pa3); partialSM<DQK>(P0, P1, m_reg, MN, AL); } while (0)
#endif
  f32x16 pA0, pA1, pB0, pB1; float mnA, mnB, alA, alB; bf16x8 pa0, pa1, pa2, pa3; const int NT = seq / KVBLK;
  SLOAD_A(0); asm volatile("s_waitcnt vmcnt(0)" ::: "memory"); SWRITE(0, sv0a, sv1a, sk0a, sk1a); __syncthreads();
  qkt<DQK>(pA0, pA1, K_lds, qr, r32, hi, koffB); partialSM<DQK>(pA0, pA1, m_reg, mnA, alA);
  SLOAD_B(KVBLK); if (2 < NT) SLOAD_A(2 * KVBLK);
  SWAIT(); SWRITE((int)SHM_V, sv0b, sv1b, sk0b, sk1b); __syncthreads();
  int oP = 0, oC = (int)SHM_V, oN = 2 * (int)SHM_V;
  for (int t = 1; t + 1 < NT; t += 2) {
    SBAR(); qkt<DQK>(pB0, pB1, K_lds + oC, qr, r32, hi, koffB);
    finishSM(pA0, pA1, alA, l_reg, pa0, pa1, pa2, pa3); SBAR();
    SLOAD_B((t + 2) * KVBLK); SBAR();
    PVSM(vb0 + oP, pB0, pB1, mnB, alB);
    SWAIT(); SWRITE(oN, sv0a, sv1a, sk0a, sk1a);
    __syncthreads();
    SBAR(); qkt<DQK>(pA0, pA1, K_lds + oN, qr, r32, hi, koffB);
    finishSM(pB0, pB1, alB, l_reg, pa0, pa1, pa2, pa3); SBAR();
    if (t + 3 < NT) SLOAD_A((t + 3) * KVBLK); SBAR();
    PVSM(vb0 + oC, pA0, pA1, mnA, alA);
    SWAIT(); SWRITE(oP, sv0b, sv1b, sk0b, sk1b);
    __syncthreads();
    { const int r_ = oP; oP = oN; oN = oC; oC = r_; }
  }
  SBAR(); qkt<DQK>(pB0, pB1, K_lds + oC, qr, r32, hi, koffB);
  finishSM(pA0, pA1, alA, l_reg, pa0, pa1, pa2, pa3); SBAR();
  PVSM(vb0 + oP, pB0, pB1, mnB, alB);
  finishSM(pB0, pB1, alB, l_reg, pa0, pa1, pa2, pa3); SBAR();
  pv_d0(o, vb0 + oC, pa0, pa1, pa2, pa3);
  if (hi == 0) li_l[r32] = l_reg; asm volatile("s_waitcnt lgkmcnt(0)" ::: "memory");
#pragma unroll
  for (int r = 0; r < 16; ++r) rli[r] = __builtin_amdgcn_rcpf(li_l[crow(r, hi)]);
  __syncthreads();
#undef PVSM
#undef SLOAD_A
#undef SLOAD_B
#undef SWRITE
#undef SWAIT
#undef RESC
}
#undef KSWZ
#undef SBAR
}
#define GAS __attribute__((address_space(1)))
#define LAS __attribute__((address_space(3)))
typedef GAS unsigned gu32;
#define RLX_AGENT __ATOMIC_RELAXED, __HIP_MEMORY_SCOPE_AGENT
#define XB_TMO      128
#define XB_XCNT(j)  (256  + 64 * (j))
#define XB_XSUB(j)  (1280 + 64 * (j))
#define XB_XGEN(j)  (2304 + 64 * (j))
#define XB_TOP      3328
#define XB_TOPGEN   3392
#define XCD_BAR_WORDS 3456
#define XB_SPIN_CAP (1u << 18)

__device__ __forceinline__ unsigned xb_ld(unsigned* p)              { return __hip_atomic_load(p, __ATOMIC_RELAXED, __HIP_MEMORY_SCOPE_AGENT); }
__device__ __forceinline__ unsigned xb_add(unsigned* p, unsigned v) { return __hip_atomic_fetch_add(p, v, __ATOMIC_RELAXED, __HIP_MEMORY_SCOPE_AGENT); }
__device__ __forceinline__ unsigned xb_xcc_id() { return (unsigned)__builtin_amdgcn_s_getreg((3 << 11) | 20) & 0xFu; }
#define XB_SPIN(cond, bar) do { unsigned _sp = 0; while (cond) { __builtin_amdgcn_s_sleep(1); \
    if ((++_sp & 255u) == 0u) { if (xb_ld(&(bar)[XB_TMO])) break; if (_sp > XB_SPIN_CAP) { atomicAdd(&(bar)[XB_TMO], 1u); break; } } } } while (0)

struct XcdBarrier {
    unsigned* bar; unsigned x;
    volatile LAS unsigned* st;
};

__device__ __forceinline__ XcdBarrier xcd_barrier_post(unsigned* bar, volatile LAS unsigned* st) {
    XcdBarrier b; b.bar = bar; b.x = xb_xcc_id(); b.st = st;
    if (threadIdx.x == 0) (void)xb_add(&bar[XB_XCNT(b.x)], 1u);
    return b;
}
__device__ __forceinline__ void xcd_barrier_complete(unsigned* bar, unsigned x, unsigned& nloc, unsigned& nx) {
    const unsigned G = gridDim.x * gridDim.y * gridDim.z;
    unsigned sum, cnt, mine, sp = 0u;
    for (;;) {
        sum = 0u; cnt = 0u; mine = 0u;
#pragma unroll
        for (unsigned j = 0; j < 16; ++j) { const unsigned c = xb_ld(&bar[XB_XCNT(j)]); sum += c; cnt += (c > 0u) ? 1u : 0u; mine = (j == x) ? c : mine; }
        if (sum == G) break;
        __builtin_amdgcn_s_sleep(1);
        if ((++sp & 255u) == 0u) { if (xb_ld(&bar[XB_TMO])) break; if (sp > XB_SPIN_CAP) { atomicAdd(&bar[XB_TMO], 1u); break; } }
    }
    nloc = mine > 0u ? mine : 1u; nx = cnt > 0u ? cnt : 1u;
}

__device__ __forceinline__ void xcd_barrier(const XcdBarrier& b) {
    asm volatile("s_waitcnt vmcnt(0)" ::: "memory");
    __syncthreads();
    if (threadIdx.x == 0) {
        unsigned* bar = b.bar;
        __builtin_amdgcn_s_waitcnt(0);
        unsigned nloc = b.st[0], nx = b.st[1];
        if (nloc == 0u) { xcd_barrier_complete(bar, b.x, nloc, nx); b.st[0] = nloc; b.st[1] = nx; }
        const unsigned old = xb_add(&bar[XB_XSUB(b.x)], 1u);
        const unsigned gen = old / nloc;
        if (old + 1u == (gen + 1u) * nloc) {
            __builtin_amdgcn_fence(__ATOMIC_RELEASE, "agent");
            asm volatile("s_waitcnt vmcnt(0)" ::: "memory");
            const unsigned og = xb_add(&bar[XB_TOP], 1u);
            const unsigned tg = og / nx;
            if (og + 1u == (tg + 1u) * nx) xb_add(&bar[XB_TOPGEN], 1u);
            else XB_SPIN(xb_ld(&bar[XB_TOPGEN]) == tg, bar);
            __builtin_amdgcn_fence(__ATOMIC_ACQUIRE, "agent");
            xb_add(&bar[XB_XGEN(b.x)], 1u);
            asm volatile("s_waitcnt vmcnt(0)" ::: "memory");
        } else {
            XB_SPIN(xb_ld(&bar[XB_XGEN(b.x)]) == gen, bar);
            __builtin_amdgcn_fence(__ATOMIC_ACQUIRE, "agent");
            asm volatile("s_waitcnt vmcnt(0)" ::: "memory");
        }
    }
    __syncthreads();
}

#ifndef DUP_MASK
#define DUP_MASK 0
#endif
#ifndef PROLOGUE_IN_KERNEL
#define PROLOGUE_IN_KERNEL 1
#endif
#ifndef MIX_PARTS
#define MIX_PARTS 7
#endif
#ifndef PH_MASK
#define PH_MASK 0x7f
#endif
constexpr int NWAVES = 8;
constexpr int RING_BYTES = 131072;
constexpr int PTAB_OFF = RING_BYTES;
constexpr int MISC_OFF = PTAB_OFF + 8192;
constexpr int LDS_BYTES = 159744;
static_assert(pg8::STAGE_BYTES == RING_BYTES && MISC_OFF + 128 <= pg8::EPIX_OFF && pg8::EPIX_END <= LDS_BYTES && (int)att::SHM_ATTN <= RING_BYTES, "LDS map");
constexpr int CW_YCNT = 1024;
constexpr int CW_TMO = 64;
constexpr int CW_FLAG = 16384;
constexpr int CW_BAR = 4096;
constexpr int N_PHASES = 3 + 5 * DEPTH;

struct MegaArgs { const float* in[26]; float* out; unsigned char* ws; int ph_lo, ph_hi, pad0, pad1; };

__device__ __forceinline__ void stage_o_bf16(const att::f32x16 (&o)[4], const float (&rli)[16], bf16_t* wst, int r32, int hi) {
#pragma unroll
    for (int r = 0; r < 16; ++r) { const int orow = att::crow(r, hi);
#pragma unroll
        for (int d0 = 0; d0 < 4; ++d0) wst[orow * 128 + d0 * 32 + r32] = (bf16_t)f2bf(o[d0][r] * rli[r]); }
}
#ifndef ATT_A3
#define ATT_A3 0
#endif
static_assert((int)att::SHM_ATTN3 <= RING_BYTES, "LDS map");
__device__ __forceinline__ void attn_a_unit(const Ptrs& P, size_t row0, const bf16_t* Kb, const bf16_t* Vb, int seq, int h, char* lds) {
    att::f32x16 o[4]; float rli[16];
#if ATT_A3
    att::body3<128, 1024, 256>(P.QA + row0 * 1024 + h * 128, Kb + (h >> 2) * 128, Vb + (h >> 2) * 128, seq, 0, lds, o, rli);
#else
    att::body<128, 1024, 256>(P.QA + row0 * 1024 + h * 128, Kb + (h >> 2) * 128, Vb + (h >> 2) * 128, seq, 0, lds, o, rli);
#endif
    int tid = threadIdx.x; asm volatile("" : "+v"(tid));
    const int wid = tid >> 6, lane = tid & 63, r32 = lane & 31, hi = lane >> 5;
    bf16_t* wst = (bf16_t*)(lds + wid * 8192);
    stage_o_bf16(o, rli, wst, r32, hi);
    bf16_t* ob = P.MIX + (row0 + wid * 32) * D + h * 128;
#pragma unroll
    for (int i = 0; i < 8; ++i) { const int id = lane + 64 * i, row = id >> 4, ch = id & 15; *(u32x4*)(ob + (size_t)row * D + ch * 8) = *(const u32x4*)(wst + row * 128 + ch * 8); }
    __syncthreads();
}
__device__ __forceinline__ void attn_b_unit(const Ptrs& P, size_t row0, const bf16_t* Kb, const bf16_t* Vb, int seq, int h, int l, char* lds) {
#pragma unroll 1
    for (int c = 0; c < 2; ++c) {
        att::f32x16 o[4]; float rli[16];
        att::body<64, 512, 512>(P.QB + row0 * 512 + h * 128 + c * 64, Kb + h * 128, Vb + h * 128, seq, c * 128, lds, o, rli);
        int tid = threadIdx.x; asm volatile("" : "+v"(tid));
        const int wid = tid >> 6, lane = tid & 63, r32 = lane & 31, hi = lane >> 5;
        stage_o_bf16(o, rli, (bf16_t*)(lds + (c == 0 ? (int)att::SHM_ATTN : 0) + wid * 8192), r32, hi);
    }
    {   int tid = threadIdx.x; asm volatile("" : "+v"(tid));
        const int wid = tid >> 6, lane = tid & 63, sub = lane >> 4, ch = lane & 15;
        const bf16_t* w1 = (const bf16_t*)(lds + att::SHM_ATTN + wid * 8192); const bf16_t* w2 = (const bf16_t*)(lds + wid * 8192);
        const float lam = P.LAM[l]; const float post = 1.0f - lambda_init_of(l);
        const f32x4 g0 = *(const f32x4*)(P.subln + l * 128 + ch * 8), g1 = *(const f32x4*)(P.subln + l * 128 + ch * 8 + 4);
        bf16_t* ob = P.MIX + (row0 + wid * 32) * D + 1024 + h * 128 + ch * 8;
#pragma unroll
        for (int i = 0; i < 8; ++i) { const int row = i * 4 + sub;
            const u32x4 a = *(const u32x4*)(w1 + row * 128 + ch * 8), b = *(const u32x4*)(w2 + row * 128 + ch * 8);
            f32x4 v0, v1;
            v0[0] = __builtin_bit_cast(float, a.x << 16) - lam * __builtin_bit_cast(float, b.x << 16); v0[1] = __builtin_bit_cast(float, a.x & 0xffff0000u) - lam * __builtin_bit_cast(float, b.x & 0xffff0000u);
            v0[2] = __builtin_bit_cast(float, a.y << 16) - lam * __builtin_bit_cast(float, b.y << 16); v0[3] = __builtin_bit_cast(float, a.y & 0xffff0000u) - lam * __builtin_bit_cast(float, b.y & 0xffff0000u);
            v1[0] = __builtin_bit_cast(float, a.z << 16) - lam * __builtin_bit_cast(float, b.z << 16); v1[1] = __builtin_bit_cast(float, a.z & 0xffff0000u) - lam * __builtin_bit_cast(float, b.z & 0xffff0000u);
            v1[2] = __builtin_bit_cast(float, a.w << 16) - lam * __builtin_bit_cast(float, b.w << 16); v1[3] = __builtin_bit_cast(float, a.w & 0xffff0000u) - lam * __builtin_bit_cast(float, b.w & 0xffff0000u);
            float s = (v0[0] * v0[0] + v0[1] * v0[1]) + (v0[2] * v0[2] + v0[3] * v0[3]) + (v1[0] * v1[0] + v1[1] * v1[1]) + (v1[2] * v1[2] + v1[3] * v1[3]);
            s += __shfl_xor(s, 1); s += __shfl_xor(s, 2); s += __shfl_xor(s, 4); s += __shfl_xor(s, 8);
            const float rinv = __builtin_amdgcn_rsqf(s * (1.0f / 128.0f) + EPS) * post;
            v0 = v0 * rinv * g0; v1 = v1 * rinv * g1;
            *(u32x4*)(ob + (size_t)row * D) = (u32x4){pk2(v0[0], v0[1]), pk2(v0[2], v0[3]), pk2(v1[0], v1[1]), pk2(v1[2], v1[3])}; }
    }
    __syncthreads();
}

__device__ __forceinline__ void x0_row(const float* __restrict__ xrow, const float* __restrict__ g, const float* __restrict__ scale, bf16_t* __restrict__ xa0, int row, float* __restrict__ ssrow, int lane) {
    f32x4 v[8]; float ss = 0.f;
#pragma unroll
    for (int j = 0; j < 8; ++j) { v[j] = *(const f32x4*)(xrow + lane * 4 + 256 * j); ss += (v[j][0] * v[j][0] + v[j][1] * v[j][1]) + (v[j][2] * v[j][2] + v[j][3] * v[j][3]); }
    ss = wave_sum(ss); if (lane < 8) ssrow[lane] = (lane == 0) ? ss : 0.f;
#pragma unroll
    for (int j = 0; j < 8; ++j) { const int c = lane * 4 + 256 * j; const f32x4 o = v[j] * (*(const f32x4*)(g + c)) * (*(const f32x4*)(scale + c) + 1.0f);
        *(u32x2*)(XA_BLOCKED ? xa0 + ((size_t)(c >> 6) * M_ALL + row) * 64 + (c & 63) : xa0 + (size_t)row * D + c) = (u32x2){pk2(o[0], o[1]), pk2(o[2], o[3])}; }
}
struct BiasRaw { u32x4 q[4]; };
__device__ __forceinline__ BiasRaw bias_row_load(const bf16_t* __restrict__ btrow, int lane) { BiasRaw r;
#pragma unroll
    for (int j = 0; j < 4; ++j) r.q[j] = *(const u32x4*)(btrow + lane * 8 + 512 * j);
    return r; }
__device__ __forceinline__ void bias_row_fin(const BiasRaw& raw, const float* sh, float* __restrict__ bias_r, int bias_stride, int lane) {
    f32x4 wl[4], wh[4];
#pragma unroll
    for (int j = 0; j < 4; ++j) { const u32x4 q = raw.q[j];
        wl[j] = (f32x4){__builtin_bit_cast(float, q.x << 16), __builtin_bit_cast(float, q.x & 0xffff0000u), __builtin_bit_cast(float, q.y << 16), __builtin_bit_cast(float, q.y & 0xffff0000u)};
        wh[j] = (f32x4){__builtin_bit_cast(float, q.z << 16), __builtin_bit_cast(float, q.z & 0xffff0000u), __builtin_bit_cast(float, q.w << 16), __builtin_bit_cast(float, q.w & 0xffff0000u)}; }
#pragma unroll 1
    for (int c = 0; c < NCOND; ++c) { f32x4 s4 = (f32x4){0.f, 0.f, 0.f, 0.f};
#pragma unroll
        for (int j = 0; j < 4; ++j) { const f32x4 a = *(const f32x4*)(sh + c * D + lane * 8 + 512 * j), b = *(const f32x4*)(sh + c * D + lane * 8 + 512 * j + 4); s4 = s4 + wl[j] * a + wh[j] * b; }
        float s = wave_sum((s4[0] + s4[1]) + (s4[2] + s4[3])); if (lane == 0) bias_r[(size_t)c * bias_stride] = s; }
}
__device__ __forceinline__ void bias_row(const bf16_t* __restrict__ btrow, const float* sh, float* __restrict__ bias_r, int bias_stride, int lane) { bias_row_fin(bias_row_load(btrow, lane), sh, bias_r, bias_stride, lane); }

__global__ void __launch_bounds__(NWAVES * 64, 2) mega(MegaArgs args) {
    extern __shared__ __attribute__((aligned(16))) unsigned char lds[];
    LAS unsigned char* L = (LAS unsigned char*)lds;
    volatile LAS unsigned* MISC = (volatile LAS unsigned*)(L + MISC_OFF);
    const int G = gridDim.x, bx = blockIdx.x;
    gu32* ctl = (gu32*)(args.ws + WS_CTL);
    for (int u = threadIdx.x; u < 32; u += NWAVES * 64) ((LAS unsigned*)(L + MISC_OFF))[u] = 0u;
    __syncthreads();
    XcdBarrier bar = xcd_barrier_post((unsigned*)(ctl + CW_BAR), MISC + 8);
    const int lo = args.ph_lo, hi = args.ph_hi;
#define IN(k) (lo <= (k) && (k) < hi)
#define PHASE_P int tid = threadIdx.x; asm volatile("" : "+v"(tid)); const int lane = tid & 63, wave = __builtin_amdgcn_readfirstlane(tid >> 6); (void)lane; (void)wave; unsigned char* wsp_ = args.ws; asm volatile("" : "+s"(wsp_)); wsp_ = as_global(wsp_); const Ptrs P = make_ptrs_hd(args.in, args.out, wsp_); const float* mod_l = P.MOD + (size_t)l * NCOND * NMOD; (void)mod_l; float* const SS = (float*)(wsp_ + WS_SS); (void)SS
#ifndef BAR_DUP
#define BAR_DUP 0
#endif
#ifndef ACTX_ON_DFT
#define ACTX_ON_DFT 1
#endif
#ifndef SLACK_PROBE_TICKS
#define SLACK_PROBE_TICKS 0
#endif
#ifndef FOLD_HALF
#define FOLD_HALF 0
#endif
#ifndef TAIL_FIRST
#define TAIL_FIRST 1
#endif
#ifndef XBF16
#define XBF16 1
#endif
#ifndef MO_REV
#define MO_REV 0
#endif
#ifndef MO_BLOCKED
#define MO_BLOCKED 1
#endif
#ifndef HID_BLOCKED
#define HID_BLOCKED 1
#endif
#ifndef DUP_GRES
#define DUP_GRES 0
#endif
#ifndef DUP_GIN
#define DUP_GIN 0
#endif
#ifndef DUP_GMI
#define DUP_GMI 0
#endif
#ifndef DEFER_WCONV
#define DEFER_WCONV 1
#endif
#ifndef WGM_IN
#define WGM_IN 8
#endif
#ifndef WGM_MI
#define WGM_MI 8
#endif
#ifndef DFT_FIRST
#define DFT_FIRST 0
#endif
#ifndef OUT_SPLIT
#define OUT_SPLIT 0
#endif
#ifndef GEMM_SP2
#define GEMM_SP2 true
#endif
#ifndef MLPIN_ALIGN
#define MLPIN_ALIGN true
#endif
#ifndef IDLE_PROBE_TICKS
#define IDLE_PROBE_TICKS 0
#endif
#define SEAM(k) do { if (IN(k) && IN((k) + 1)) { xcd_barrier(bar); if (BAR_DUP) xcd_barrier(bar); if (SLACK_PROBE_TICKS && (k) >= 3 && ((k) - 3) % 5 == 0 && (blockIdx.x & 4)) { const unsigned long long t1_ = __builtin_amdgcn_s_memrealtime(); while (__builtin_amdgcn_s_memrealtime() - t1_ < (unsigned long long)SLACK_PROBE_TICKS) __builtin_amdgcn_s_sleep(32); } if (IDLE_PROBE_TICKS) { const unsigned long long t0_ = __builtin_amdgcn_s_memrealtime(); while (__builtin_amdgcn_s_memrealtime() - t0_ < (unsigned long long)IDLE_PROBE_TICKS) __builtin_amdgcn_s_sleep(32); } } } while (0)
#ifndef DUP_ADA
#define DUP_ADA 0
#endif
#ifndef DUP_P0
#define DUP_P0 0
#endif
#ifndef DUP_P12
#define DUP_P12 0
#endif
    _Pragma("unroll 1") for (int rep_ = 0; rep_ <= DUP_P0; ++rep_) if (IN(0)) {
        const int l = 0; PHASE_P;
        const int t = tid & 255, hf = __builtin_amdgcn_readfirstlane(tid >> 8), hw = bx * 2 + hf, NHW = 2 * G;
        float* sm = (float*)(lds + hf * 67584);
        _Pragma("unroll 1") for (int ar_ = 0; ar_ <= DUP_ADA; ++ar_)
        for (int v0 = 0; v0 < 512; v0 += NHW) { const int vb = v0 + hw; prep_ada96_vb(P.c, P.c_ctx, P.w_ada, P.b_ada, P.MOD, vb, t, sm, vb < 512); }
#define TR_LOOP(W, K, LDW, WST, BT, BST, MODE, NX, NY, NBLK) for (int v0 = 0; v0 < (NX) * (NY) * DEPTH; v0 += NHW) { const int vb = v0 + hw; \
            prep_transpose256_vb(W, K, LDW, WST, BT, BST, MODE, vb % (NX), (vb / (NX)) % (NY), vb / ((NX) * (NY)), t, (float(*)[257])sm, vb < (NX) * (NY) * DEPTH, NBLK); }
        TR_LOOP(P.w_in, D, N_INRAW, (size_t)D * N_INRAW, P.BT_IN, (size_t)N_IN * D, 1, D / 64, 3072 / 256, 0)
#define TR_LOOP1(W, K, LDW, WST, BT, BST, NX, NY, LAYER, HW, NH, NBLK) for (int v0 = 0; v0 < (NX) * (NY); v0 += (NH)) { const int vb = v0 + (HW); \
            prep_transpose256_vb(W, K, LDW, WST, BT, BST, 0, vb % (NX), vb / (NX), LAYER, t, (float(*)[257])sm, vb < (NX) * (NY), NBLK); }
        if (G == 256 && DEFER_WCONV) { TR_LOOP1(P.w_out, D, D, (size_t)D * D, P.BT_OUT, (size_t)D * D, D / 64, D / 256, 0, hw, NHW, 0) }
        else { TR_LOOP(P.w_out, D, D, (size_t)D * D, P.BT_OUT, (size_t)D * D, 0, D / 64, D / 256, 0) }
        TR_LOOP(P.w_mi, D, DFF, (size_t)D * DFF, P.BT_MI, (size_t)DFF * D, 0, D / 64, DFF / 256, 0)
        if (G == 256 && DEFER_WCONV) { TR_LOOP1(P.w_mo, DFF, D, (size_t)DFF * D, P.BT_MO, (size_t)D * DFF, DFF / 64, D / 256, 0, hw, NHW, MO_BLOCKED ? D : 0) }
        else { TR_LOOP(P.w_mo, DFF, D, (size_t)DFF * D, P.BT_MO, (size_t)D * DFF, 0, DFF / 64, D / 256, MO_BLOCKED ? D : 0) }
        {   float* ct = sm; float* st = sm + 128;
            if (t < 128) { float s, c; sincospif((float)t / 64.0f, &s, &c); ct[t] = c; st[t] = s; }
            __syncthreads();
            for (size_t idx = (size_t)hw * 256 + t; idx < (size_t)DEPTH * 4 * 2 * 128 * 128; idx += (size_t)NHW * 256) prep_G_idx(P.w_fourier, P.G, idx, ct, st);
            __syncthreads(); }
        prep_tables_gs(P.ROPE, P.DFT_L, P.DFT_C, P.LAM, P.lq1, P.lk1, P.lq2, P.lk2, (float*)(P.ws + WS_GAIN), P.qn_a, P.kn_a, P.qn_b, P.kn_b, (size_t)bx * 512 + tid, (size_t)G * 512);
        prep_cache_gs(P.cak, P.cav, P.cdk, P.cdv, P.KAL, P.VAL, P.KBL, P.VBL, (size_t)bx * 512 + tid, (size_t)G * 512, -1);
    }
    SEAM(0);
    _Pragma("unroll 1") for (int rep_ = 0; rep_ <= DUP_P12; ++rep_) if (IN(1)) {
        const int l = 0; PHASE_P;
        const int gw = bx * NWAVES + wave, NGW = G * NWAVES;
        for (int row = gw; row < M_ALL; row += NGW) {
            const float* xrow = row < M_CTX ? P.x_prompt + (size_t)row * D : P.x_sample + (size_t)(row - M_CTX) * D;
            x0_row(xrow, P.g_mix, mod_l + (size_t)cond_of_row(row) * NMOD + D, P.H, row, SS + (size_t)row * 8, lane);
        }
        const int t = tid & 255, hf = __builtin_amdgcn_readfirstlane(tid >> 8), hw = bx * 2 + hf, NHW = 2 * G;
        float* sm = (float*)(lds + hf * 40960);
        for (int v0 = 0; v0 < 32 * 4 * DEPTH; v0 += NHW) { const int vb = v0 + hw; prep_fold_vb(P.w_in, P.G, P.BT_IN, vb & 31, (vb >> 5) & 3, vb >> 7, t, (float(*)[132])sm, vb < 32 * 4 * DEPTH); }
    }
    SEAM(1);
    _Pragma("unroll 1") for (int rep_ = 0; rep_ <= DUP_P12; ++rep_) if (IN(2)) {
        const int l = 0; PHASE_P;
        float* sh = (float*)lds;
        for (int item = bx; item < 8 * 32; item += G) {
            const int combo = item & 7, sub = item >> 3, ll = combo >> 1, which = combo & 1;
            const float* shsrc = P.MOD + (size_t)ll * NCOND * NMOD + (size_t)(which ? 3 : 0) * D;
            for (int i = tid; i < NCOND * D / 4; i += NWAVES * 64) { const int c = i / (D / 4), k4 = i % (D / 4); *(f32x4*)(sh + c * D + k4 * 4) = *(const f32x4*)(shsrc + (size_t)c * NMOD + k4 * 4); }
            __syncthreads();
            const int nrows = which ? DFF : N_IN, rps = nrows / 32;
            const bf16_t* bt = which ? P.BT_MI + (size_t)ll * DFF * D : P.BT_IN + (size_t)ll * N_IN * D;
            float* bo = which ? (float*)(P.ws + WS_BIAS_MI) + (size_t)ll * NCOND * DFF : (float*)(P.ws + WS_BIAS_IN) + (size_t)ll * NCOND * N_IN;
            {
                int r = sub * rps + wave; const int rend = (sub + 1) * rps;
                BiasRaw cur = bias_row_load(bt + (size_t)(r < rend ? r : rend - 1) * D, lane);
                for (; r < rend; r += NWAVES) { const int rn = r + NWAVES < rend ? r + NWAVES : r; const BiasRaw nxt = bias_row_load(bt + (size_t)rn * D, lane);
                    bias_row_fin(cur, sh, bo + r, nrows, lane); cur = nxt; } }
            __syncthreads();
        }
    }
    SEAM(2);
#pragma unroll 1
    for (int l = 0; l < DEPTH; ++l) {
        const int pb = 3 + 5 * l;
        _Pragma("unroll 1") for (int rep_ = 0; rep_ <= DUP_GIN; ++rep_) if (IN(pb + 0)) { PHASE_P;
            pg8::Gemm g{P.H, P.BT_IN + (size_t)l * N_IN * D, M_ALL, N_IN, D, D, XA_BLOCKED ? 64 : 0, XA_BLOCKED ? (size_t)M_ALL * 128 : 0}; pg8::StaticOrder S; S.init(M_ALL, N_IN, G, bx); S.wgm = WGM_IN;
            pg8::EpiIn E{l, P.ws, P.out, SS + (size_t)(2 * l) * M_ALL * 8, (const float*)(P.ws + WS_BIAS_IN) + (size_t)l * NCOND * N_IN};
            pg8::gemm_phase<pg8::EpiIn, pg8::StaticOrder, true, GEMM_SP2>(L, g, S, E);
        }
        SEAM(pb + 0);
#ifndef DUP_MIX
#define DUP_MIX 0
#endif
        _Pragma("unroll 1") for (int rep_ = 0; rep_ <= DUP_MIX; ++rep_) if (IN(pb + 1)) { PHASE_P;
            char* al = (char*)lds;
            const int vx = (G % 8 == 0) ? (bx % 8) * (G / 8) + bx / 8 : bx;
            {
                const bf16_t* YR = P.YTL; bf16_t* tl = (bf16_t*)lds;
                const bool fhalf = FOLD_HALF && G == 256;
                for (int item = fhalf ? (vx >= 128 ? vx - 128 : 1 << 20) : bx; item < 1024 + 256; item += fhalf ? 128 : G) {
                    const bool latent = item < 1024; const int it = latent ? item : item - 1024;
                    const int T = latent ? T_LAT : T_CTX, njb = T / 128;
                    const int jb = it % njb, nb = (it / njb) & 7, b = it / (njb * 8);
                    const size_t tok0 = latent ? (size_t)M_CTX + (size_t)b * T_LAT : (size_t)b * T_CTX; const int j0 = jb * 64, n0 = nb * 64;
                    {   const int row = tid >> 3, ch = tid & 7; const int j = j0 + row; const int jm = j ? T - j : T / 2;
                        const bf16_t* src = YR + (tok0 + j) * 1024 + n0 + ch * 8; const bf16_t* srm = YR + (tok0 + jm) * 1024 + n0 + ch * 8;
                        *(u32x4*)(tl + 0 * 4608 + row * 72 + ch * 8) = *(const u32x4*)src; *(u32x4*)(tl + 1 * 4608 + row * 72 + ch * 8) = *(const u32x4*)srm;
                        *(u32x4*)(tl + 2 * 4608 + row * 72 + ch * 8) = *(const u32x4*)(src + 512); *(u32x4*)(tl + 3 * 4608 + row * 72 + ch * 8) = *(const u32x4*)(srm + 512); }
                    __syncthreads();
                    {   const int rl = tid & 63, jc = tid >> 6; const int col = (rl & 32) | (map8(rl & 31) & 31);
                        float cv[8], sv[8];
#pragma unroll
                        for (int q = 0; q < 8; ++q) { const int jj = jc * 8 + q; const bool first = (j0 + jj) == 0;
                            const float c0 = bf2f(tl[0 * 4608 + jj * 72 + col]), c1 = bf2f(tl[1 * 4608 + jj * 72 + col]), s0 = bf2f(tl[2 * 4608 + jj * 72 + col]), s1 = bf2f(tl[3 * 4608 + jj * 72 + col]);
                            cv[q] = first ? c0 : c0 + c1; sv[q] = first ? c1 : s0 - s1; }
                        bf16_t* dst = (latent ? (bf16_t*)(P.ws + WS_YPL) + ((size_t)b * 512 + n0 + rl) * 2048 : (bf16_t*)(P.ws + WS_YPC) + ((size_t)b * 512 + n0 + rl) * 256) + j0 + jc * 8;
                        *(u32x4*)dst = (u32x4){pk2(cv[0], cv[1]), pk2(cv[2], cv[3]), pk2(cv[4], cv[5]), pk2(cv[6], cv[7])};
                        *(u32x4*)(dst + T / 2) = (u32x4){pk2(sv[0], sv[1]), pk2(sv[2], sv[3]), pk2(sv[4], sv[5]), pk2(sv[6], sv[7])}; }
                    __syncthreads();
                }
                asm volatile("s_waitcnt vmcnt(0)" ::: "memory"); __syncthreads();
                if (tid == 0) { __builtin_amdgcn_fence(__ATOMIC_RELEASE, "agent"); asm volatile("s_waitcnt vmcnt(0)" ::: "memory"); __hip_atomic_fetch_add(ctl + CW_YCNT + l * 64, 1u, RLX_AGENT); }
            }
#if DFT_FIRST
            {
                if (wave == 0) { unsigned sp = 0; gu32* cw = ctl + CW_YCNT + l * 64;
                    while ((unsigned)__builtin_amdgcn_readfirstlane(__hip_atomic_load(cw, RLX_AGENT)) < (unsigned)G * (unsigned)(rep_ + 1)) { __builtin_amdgcn_s_sleep(2);
                        if ((++sp & 1023u) == 0u && sp > (1u << 22)) { if (tid == 0) __hip_atomic_store(ctl + CW_TMO, 1u, RLX_AGENT); break; } }
                    __builtin_amdgcn_fence(__ATOMIC_ACQUIRE, "agent"); asm volatile("s_waitcnt vmcnt(0)" ::: "memory"); }
                __syncthreads(); }
            {   pg8::Gemm g{P.DFT_L, (const bf16_t*)(P.ws + WS_YPL), T_LAT, 512, 2048, 2048}; pg8::DftOrder S{1, 0, (G == 256 ? 128 : G), G, vx}; pg8::EpiBf16Out E{P.MIX, D, 1536};
                pg8::gemm_phase<pg8::EpiBf16Out, pg8::DftOrder, true, GEMM_SP2>(L, g, S, E); }
            {   pg8::Gemm g{P.DFT_C, (const bf16_t*)(P.ws + WS_YPC), T_CTX, 512, 256, 256}; pg8::DftOrder S{0, (G == 256 ? 192 : 0), (G == 256 ? 32 : G), G, vx}; pg8::EpiBf16Out E{P.MIX, D, 1536};
                pg8::gemm_phase<pg8::EpiBf16Out, pg8::DftOrder, true, GEMM_SP2>(L, g, S, E); }
            for (int id = vx; id < 256; id += G) { const int b = id >> 5, h = (id >> 3) & 3, qb = id & 7; const size_t kvrow = (size_t)(l * NB_LAT + b) * S_LAT;
                attn_b_unit(P, (size_t)M_CTX + (size_t)b * T_LAT + qb * 256, P.KBL + kvrow * 512, P.VBL + kvrow * 512, S_LAT, h, l, al); }
            for (int id = (G == 256 ? vx - 128 : vx); id < 64; id += G) { if (id < 0) break; const int b = id >> 2, h = id & 3;
                attn_b_unit(P, (size_t)b * T_CTX, P.KBC + (size_t)b * T_CTX * 512, P.VBC + (size_t)b * T_CTX * 512, T_CTX, h, l, al); }
#else
            for (int id = vx; id < 256; id += G) { const int b = id >> 5, h = (id >> 3) & 3, qb = id & 7; const size_t kvrow = (size_t)(l * NB_LAT + b) * S_LAT;
                attn_b_unit(P, (size_t)M_CTX + (size_t)b * T_LAT + qb * 256, P.KBL + kvrow * 512, P.VBL + kvrow * 512, S_LAT, h, l, al); }
            for (int id = (G == 256 ? vx - 128 : vx); id < 64; id += G) { if (id < 0) break; const int b = id >> 2, h = id & 3;
                attn_b_unit(P, (size_t)b * T_CTX, P.KBC + (size_t)b * T_CTX * 512, P.VBC + (size_t)b * T_CTX * 512, T_CTX, h, l, al); }
            {
                if (wave == 0) { unsigned sp = 0; gu32* cw = ctl + CW_YCNT + l * 64;
                    while ((unsigned)__builtin_amdgcn_readfirstlane(__hip_atomic_load(cw, RLX_AGENT)) < (unsigned)G * (unsigned)(rep_ + 1)) { __builtin_amdgcn_s_sleep(2);
                        if ((++sp & 1023u) == 0u && sp > (1u << 22)) { if (tid == 0) __hip_atomic_store(ctl + CW_TMO, 1u, RLX_AGENT); break; } }
                    __builtin_amdgcn_fence(__ATOMIC_ACQUIRE, "agent"); asm volatile("s_waitcnt vmcnt(0)" ::: "memory"); }
                __syncthreads(); }
            {   pg8::Gemm g{P.DFT_L, (const bf16_t*)(P.ws + WS_YPL), T_LAT, 512, 2048, 2048}; pg8::DftOrder S{1, 0, (G == 256 ? 128 : G), G, vx}; pg8::EpiBf16Out E{P.MIX, D, 1536};
                pg8::gemm_phase<pg8::EpiBf16Out, pg8::DftOrder, true, GEMM_SP2>(L, g, S, E); }
            {   pg8::Gemm g{P.DFT_C, (const bf16_t*)(P.ws + WS_YPC), T_CTX, 512, 256, 256}; pg8::DftOrder S{0, (G == 256 ? 192 : 0), (G == 256 ? 32 : G), G, vx}; pg8::EpiBf16Out E{P.MIX, D, 1536};
                pg8::gemm_phase<pg8::EpiBf16Out, pg8::DftOrder, true, GEMM_SP2>(L, g, S, E); }
#endif
            {
                for (int id = (G == 256 ? 2 * vx : vx), k = 0; id < 512; id += (G == 256 ? 1 : G), ++k) { if (G == 256 && k == 2) break;
                    const int b = id >> 6, h = (id >> 3) & 7, qb = id & 7; const size_t kvrow = (size_t)(l * NB_LAT + b) * S_LAT;
                    attn_a_unit(P, (size_t)M_CTX + (size_t)b * T_LAT + qb * 256, P.KAL + kvrow * 256, P.VAL + kvrow * 256, S_LAT, h, al); } }
            for (int id = (G == 256 ? (ACTX_ON_DFT ? (vx < 128 ? vx : 1 << 20) : vx - 128) : vx); id < 128; id += G) { if (id < 0) break; const int b = id >> 3, h = id & 7;
                attn_a_unit(P, (size_t)b * T_CTX, P.KAC + (size_t)b * T_CTX * 256, P.VAC + (size_t)b * T_CTX * 256, T_CTX, h, al); }
        }
        SEAM(pb + 1);
        if (IN(pb + 2)) { PHASE_P;
            const pg8::ResNext nx{P.H, P.g_mlp + (size_t)l * D, mod_l + 4 * D, SS + (size_t)(2 * l + 1) * M_ALL * 8};
            pg8::Gemm g{P.MIX, P.BT_OUT + (size_t)l * D * D, M_ALL, D, D, D}; pg8::StaticOrder S; S.init(M_ALL, D, G, bx); if (G == 256 && OUT_SPLIT) S.rounds = 2;
            float* const xb = XBF16 ? (float*)(P.ws + WS_XB) : P.out;
            pg8::EpiRes E{xb, mod_l + 2 * D, nx, l == 0 ? P.x_prompt : xb, l == 0 ? P.x_sample - (size_t)M_CTX * D : xb, ((!XBF16 || l == 0) ? 1 : 0) | (XBF16 ? 0 : 2)};
            pg8::gemm_phase<pg8::EpiRes, pg8::StaticOrder, true, GEMM_SP2>(L, g, S, E);
            {   pg8::Gemm g2{P.MIX, P.BT_OUT + (size_t)l * D * D, M_ALL, D, D / 2, D}; pg8::SplitOrder S2; S2.init(M_ALL, D, G, bx); if (!OUT_SPLIT) S2.on = 0;
                pg8::EpiResSplit E2{E, P.OTMP, (unsigned*)(ctl + CW_FLAG) + (size_t)(l * 2 + 0) * 128 * 64, (unsigned*)(ctl + CW_TMO)};
                pg8::gemm_phase<pg8::EpiResSplit, pg8::SplitOrder, true, GEMM_SP2>(L, g2, S2, E2); }
            if (G == 256 && DEFER_WCONV && !OUT_SPLIT && l + 1 < DEPTH && bx >= 128) {
                const int t = tid & 255, hf = __builtin_amdgcn_readfirstlane(tid >> 8), hw2 = (bx - 128) * 2 + hf; float* sm = (float*)(lds + hf * 67584);
                TR_LOOP1(P.w_out, D, D, (size_t)D * D, P.BT_OUT, (size_t)D * D, D / 64, D / 256, l + 1, hw2, 256, 0)
                TR_LOOP1(P.w_mo, DFF, D, (size_t)DFF * D, P.BT_MO, (size_t)D * DFF, DFF / 64, D / 256, l + 1, hw2, 256, MO_BLOCKED ? D : 0)
            }
        }
        SEAM(pb + 2);
        _Pragma("unroll 1") for (int rep_ = 0; rep_ <= DUP_GMI; ++rep_) if (IN(pb + 3)) { PHASE_P;
            pg8::Gemm g{P.H, P.BT_MI + (size_t)l * DFF * D, M_ALL, DFF, D, D, XA_BLOCKED ? 64 : 0, XA_BLOCKED ? (size_t)M_ALL * 128 : 0}; pg8::StaticOrder S; S.init(M_ALL, DFF, G, bx); S.wgm = WGM_MI;
            pg8::EpiRelu2 E{P.HID, DFF, SS + (size_t)(2 * l + 1) * M_ALL * 8, (const float*)(P.ws + WS_BIAS_MI) + (size_t)l * NCOND * DFF, HID_BLOCKED ? M_ALL : 0};
            pg8::gemm_phase<pg8::EpiRelu2, pg8::StaticOrder, MLPIN_ALIGN, GEMM_SP2>(L, g, S, E);
        }
        SEAM(pb + 3);
        if (IN(pb + 4)) { PHASE_P;
            const bool more = l + 1 < DEPTH;
            const pg8::ResNext nx{more ? P.H : nullptr, P.g_mix + (size_t)(more ? l + 1 : l) * D, P.MOD + (size_t)(more ? l + 1 : l) * NCOND * NMOD + D, SS + (size_t)(more ? 2 * l + 2 : 0) * M_ALL * 8};
            pg8::Gemm g{P.HID, P.BT_MO + (size_t)l * D * DFF, M_ALL, D, DFF, DFF, HID_BLOCKED ? 64 : 0, HID_BLOCKED ? (size_t)M_ALL * 128 : 0, MO_BLOCKED ? 64 : 0, MO_BLOCKED ? (size_t)D * 128 : 0}; pg8::StaticOrder S; S.init(M_ALL, D, G, bx); if (G == 256) S.rounds = 2; S.rev = MO_REV;
            float* const xb = XBF16 ? (float*)(P.ws + WS_XB) : P.out; const bool wf = !XBF16 || l == DEPTH - 1;
            pg8::EpiRes E{wf ? P.out : xb, mod_l + 5 * D, nx, xb, xb, (XBF16 ? 0 : 1) | (wf ? 2 : 0)};
            const bool prod_first = TAIL_FIRST && G == 256 && pg8::SplitOrder::producer(bx);
            _Pragma("unroll 1") for (int st = 0; st < 3; ++st) {
                if (st == 1) pg8::gemm_phase<pg8::EpiRes, pg8::StaticOrder, true, GEMM_SP2>(L, g, S, E);
                else if ((st == 0) == prod_first) { pg8::Gemm g2{P.HID, P.BT_MO + (size_t)l * D * DFF, M_ALL, D, DFF / 2, DFF, HID_BLOCKED ? 64 : 0, HID_BLOCKED ? (size_t)M_ALL * 128 : 0, MO_BLOCKED ? 64 : 0, MO_BLOCKED ? (size_t)D * 128 : 0}; pg8::SplitOrder S2; S2.init(M_ALL, D, G, bx); S2.base.rev = MO_REV;
                    pg8::EpiResSplit E2{E, P.OTMP, (unsigned*)(ctl + CW_FLAG) + (size_t)(l * 2 + 1) * 128 * 64, (unsigned*)(ctl + CW_TMO)};
                    pg8::gemm_phase<pg8::EpiResSplit, pg8::SplitOrder, true, GEMM_SP2>(L, g2, S2, E2); }
            }
        }
        SEAM(pb + 4);
    }
#undef TR_LOOP
#undef TR_LOOP1
#undef IN
#undef PHASE_P
#undef SEAM
}
extern "C" void kernel_launch(void* const* d_in, const int* in_sizes, int n_in, void* d_out, int out_size, void* d_ws, size_t ws_size, hipStream_t stream) {
    if (n_in != 26 || (size_t)out_size != OUT_END || ws_size < WS_END) { fprintf(stderr, "kernel_launch: unexpected shapes (n_in %d out %d ws %zu)\n", n_in, out_size, ws_size); return; }
    static int grid = 0;
    if (grid == 0) {
        int dev = 0, cus = 0;
        if (hipGetDevice(&dev) != hipSuccess || hipDeviceGetAttribute(&cus, hipDeviceAttributeMultiprocessorCount, dev) != hipSuccess) { grid = -1; return; }
        if (hipFuncSetAttribute((const void*)mega, hipFuncAttributeMaxDynamicSharedMemorySize, LDS_BYTES) != hipSuccess) { grid = -1; return; }
        int per_cu = 0; (void)hipOccupancyMaxActiveBlocksPerMultiprocessor(&per_cu, (const void*)mega, NWAVES * 64, LDS_BYTES); (void)hipGetLastError();
        grid = cus;
#ifdef FORCE_GRID
        grid = FORCE_GRID;
#endif
    }
    if (grid < 0) return;
    (void)hipMemsetAsync((char*)d_ws + WS_CTL, 0, 1 * MiB, stream);
    MegaArgs a{}; for (int i = 0; i < 26; ++i) a.in[i] = (const float*)d_in[i]; a.out = (float*)d_out; a.ws = (unsigned char*)d_ws;
    a.ph_lo = 0; a.ph_hi = N_PHASES;
    hipLaunchKernelGGL(mega, dim3(grid), dim3(NWAVES * 64), LDS_BYTES, stream, a);
}
```

```cpp
#include <hip/hip_runtime.h>
#include <stdint.h>
#include <stdio.h>

typedef unsigned short bf16_t;
typedef short bf16x8 __attribute__((ext_vector_type(8)));
typedef float f32x4 __attribute__((ext_vector_type(4)));
typedef float f32x2 __attribute__((ext_vector_type(2)));
typedef unsigned u32x4 __attribute__((ext_vector_type(4)));
typedef unsigned u32x2 __attribute__((ext_vector_type(2)));

constexpr int D = 2048, NB_CTX = 16, T_CTX = 256, NB_LAT = 8, T_LAT = 2048, DEPTH = 4, PAST = 512;
constexpr int M_CTX = NB_CTX * T_CTX;
constexpr int M_LAT = NB_LAT * T_LAT;
constexpr int M_ALL = M_CTX + M_LAT;
constexpr int S_LAT = T_LAT + PAST;
constexpr int N_IN = 4096;
constexpr int N_INRAW = 3584;
constexpr int DFF = 8192;
constexpr int NMOD = 6 * D;
constexpr int NCOND = 9;
constexpr float EPS = 1e-6f;
constexpr size_t OUT_X = 0;
constexpr size_t OUT_SAK = (size_t)M_ALL * D;
constexpr size_t OUT_SAV = OUT_SAK + (size_t)NB_CTX * DEPTH * T_CTX * 256;
constexpr size_t OUT_SDK = OUT_SAV + (size_t)NB_CTX * DEPTH * T_CTX * 256;
constexpr size_t OUT_SDV = OUT_SDK + (size_t)NB_CTX * DEPTH * T_CTX * 512;
constexpr size_t OUT_END = OUT_SDV + (size_t)NB_CTX * DEPTH * T_CTX * 512;

constexpr size_t MiB = (size_t)1 << 20;
constexpr size_t WS_CTL = 0;
constexpr size_t WS_BT_IN = 1 * MiB;
constexpr size_t WS_BT_OUT = 65 * MiB;
constexpr size_t WS_BT_MI = 97 * MiB;
constexpr size_t WS_BT_MO = 225 * MiB;
constexpr size_t WS_DFT_L = 353 * MiB;
constexpr size_t WS_DFT_C = 369 * MiB;
constexpr size_t WS_MOD = 370 * MiB;
constexpr size_t WS_ROPE = 372 * MiB;
constexpr size_t WS_G = 374 * MiB;
constexpr size_t WS_LAM = 376 * MiB;
constexpr size_t WS_GAIN = WS_LAM + 4096;
constexpr size_t WS_H = 377 * MiB;
constexpr size_t WS_QA = 457 * MiB;
constexpr size_t WS_KAL = 497 * MiB;
constexpr size_t WS_VAL = 537 * MiB;
constexpr size_t WS_KAC = 577 * MiB;
constexpr size_t WS_VAC = 579 * MiB;
constexpr size_t WS_QB = 581 * MiB;
constexpr size_t WS_KBL = 601 * MiB;
constexpr size_t WS_VBL = 681 * MiB;
constexpr size_t WS_KBC = 761 * MiB;
constexpr size_t WS_VBC = 765 * MiB;
constexpr size_t WS_YTL = 769 * MiB;
constexpr size_t WS_YTC = 801 * MiB;
constexpr size_t WS_MIX = 809 * MiB;
constexpr size_t WS_HID = 889 * MiB;
constexpr size_t WS_OTMP = 1209 * MiB;
constexpr size_t WS_SS = 1273 * MiB;
constexpr size_t WS_BIAS_IN = 1279 * MiB;
constexpr size_t WS_BIAS_MI = 1280 * MiB;
constexpr size_t WS_YPL = 1282 * MiB;
constexpr size_t WS_YPC = 1298 * MiB;
constexpr size_t WS_XB = 1302 * MiB;
constexpr size_t WS_END = 1382 * MiB;

#ifndef AS_GLOBAL
#define AS_GLOBAL 1
#endif
template <class T> __device__ __forceinline__ T* as_global(T* p) {
#if defined(__HIP_DEVICE_COMPILE__) && AS_GLOBAL
    __attribute__((address_space(1))) T* g = (__attribute__((address_space(1))) T*)p; asm volatile("" : "+s"(g));
    return (T*)g;
#else
    return p;
#endif
}
__host__ __device__ __forceinline__ int map8(int p) { return (p & 96) | (((p >> 2) & 3) << 3) | (((p >> 4) & 1) << 2) | (p & 3); }
__host__ __device__ __forceinline__ int map8inv(int s) { return (s & 96) | (((s >> 2) & 1) << 4) | (((s >> 3) & 3) << 2) | (s & 3); }
__host__ __device__ __forceinline__ int sigma128(int s) { const int u = s >> 3, n = (s >> 2) & 1, e = s & 3; return (u < 8 ? 0 : 64) + 32 * n + 4 * (u & 7) + e; }
__host__ __device__ __forceinline__ int sigma64(int s) { const int u = s >> 3, n = (s >> 2) & 1, e = s & 3; return (u < 4 ? 0 : 32) + 16 * n + 4 * (u & 3) + e; }
__host__ __device__ __forceinline__ int in_logical_col(int t, int sc) {
    const int half = sc & 128, s = sc & 127;
    int l;
    if (t <= 4) l = sigma128(s);
    else if (t == 5 || t >= 10) l = s;
    else l = (s & 64) + sigma64(s & 63);
    return t * 256 + half + l;
}
__device__ __forceinline__ unsigned f2bf(float f) { unsigned u = __builtin_bit_cast(unsigned, f); return (u + 0x7fffu + ((u >> 16) & 1u)) >> 16; }
__device__ __forceinline__ float bf2f(unsigned short h) { return __builtin_bit_cast(float, (unsigned)h << 16); }
__device__ __forceinline__ unsigned pk2(float lo, float hi) { return f2bf(lo) | (f2bf(hi) << 16); }
__device__ __forceinline__ int cond_of_row(int row) { return row < M_CTX ? 0 : 1 + ((row - M_CTX) >> 11); }
__host__ __device__ __forceinline__ float lambda_init_of(int l) { return 0.8f - 0.6f * expf(-0.3f * (float)l); }
__device__ __forceinline__ float wave_sum(float v) {
#pragma unroll
    for (int o = 1; o < 64; o <<= 1) v += __shfl_xor(v, o);
    return v;
}
struct Ptrs {
    const float *x_prompt, *x_sample, *cak, *cav, *cdk, *cdv, *c, *c_ctx, *w_ada, *b_ada, *g_mix, *g_mlp, *w_in, *qn_a, *kn_a, *qn_b, *kn_b, *lq1, *lk1, *lq2, *lk2, *subln, *w_fourier, *w_out, *w_mi, *w_mo;
    float* out; unsigned char* ws;
    bf16_t *BT_IN, *BT_OUT, *BT_MI, *BT_MO, *DFT_L, *DFT_C, *H, *QA, *KAL, *VAL, *KAC, *VAC, *QB, *KBL, *VBL, *KBC, *VBC, *YTL, *YTC, *MIX, *HID;
    float *MOD, *ROPE, *G, *LAM, *OTMP;
};
__host__ __device__ __forceinline__ Ptrs make_ptrs_hd(const float* const* in, float* out, unsigned char* w) {
    Ptrs p{}; w = as_global(w); out = as_global(out);
#define in_(i) as_global(in[i])
    p.x_prompt = in_(0); p.x_sample = in_(1); p.cak = in_(2); p.cav = in_(3); p.cdk = in_(4); p.cdv = in_(5); p.c = in_(6); p.c_ctx = in_(7); p.w_ada = in_(8); p.b_ada = in_(9);
    p.g_mix = in_(10); p.g_mlp = in_(11); p.w_in = in_(12); p.qn_a = in_(13); p.kn_a = in_(14); p.qn_b = in_(15); p.kn_b = in_(16); p.lq1 = in_(17); p.lk1 = in_(18); p.lq2 = in_(19); p.lk2 = in_(20);
    p.subln = in_(21); p.w_fourier = in_(22); p.w_out = in_(23); p.w_mi = in_(24); p.w_mo = in_(25);
    p.out = out; p.ws = w;
    p.BT_IN = (bf16_t*)(w + WS_BT_IN); p.BT_OUT = (bf16_t*)(w + WS_BT_OUT); p.BT_MI = (bf16_t*)(w + WS_BT_MI); p.BT_MO = (bf16_t*)(w + WS_BT_MO);
    p.DFT_L = (bf16_t*)(w + WS_DFT_L); p.DFT_C = (bf16_t*)(w + WS_DFT_C); p.MOD = (float*)(w + WS_MOD); p.ROPE = (float*)(w + WS_ROPE); p.G = (float*)(w + WS_G); p.LAM = (float*)(w + WS_LAM);
    p.H = (bf16_t*)(w + WS_H); p.QA = (bf16_t*)(w + WS_QA); p.KAL = (bf16_t*)(w + WS_KAL); p.VAL = (bf16_t*)(w + WS_VAL); p.KAC = (bf16_t*)(w + WS_KAC); p.VAC = (bf16_t*)(w + WS_VAC);
    p.QB = (bf16_t*)(w + WS_QB); p.KBL = (bf16_t*)(w + WS_KBL); p.VBL = (bf16_t*)(w + WS_VBL); p.KBC = (bf16_t*)(w + WS_KBC); p.VBC = (bf16_t*)(w + WS_VBC);
    p.YTL = (bf16_t*)(w + WS_YTL); p.YTC = (bf16_t*)(w + WS_YTC); p.MIX = (bf16_t*)(w + WS_MIX); p.HID = (bf16_t*)(w + WS_HID); p.OTMP = (float*)(w + WS_OTMP);
#undef in_
    return p;
}


__device__ __forceinline__ void prep_G_idx(const float* __restrict__ wf, float* __restrict__ G, size_t idx, const float* ct, const float* st) {
    const int d = idx & 127, c = (idx >> 7) & 127, cs = (idx >> 14) & 1, g = (idx >> 15) & 3, l = (int)(idx >> 17);
    const float* Wg = wf + ((size_t)(l * 4 + g) * 128) * 128;
    float acc = 0.f;
    for (int m = 0; m < 128; ++m) { const float tr = cs ? st[(m * c) & 127] : ct[(m * c) & 127]; acc += tr * Wg[(size_t)m * 128 + d]; }
    G[idx] = acc * 0.088388347648318440f;
}
__device__ __forceinline__ void prep_fold_vb(const float* __restrict__ w_in, const float* __restrict__ G, bf16_t* __restrict__ Bt_in, int vbx, int vby, int vbz, int t, float (*wt)[132], bool act) {
    const int j0 = vbx * 64, g = vby, l = vbz;
    const float* Wl = w_in + (size_t)l * D * N_INRAW;
    if (act) for (int i = t; i < 64 * 32; i += 256) { const int j = i >> 5, c4 = (i & 31) * 4; const f32x4 v = *(const f32x4*)(Wl + (size_t)(j0 + j) * N_INRAW + 3072 + 128 * g + c4);
        wt[j][c4] = v[0]; wt[j][c4 + 1] = v[1]; wt[j][c4 + 2] = v[2]; wt[j][c4 + 3] = v[3]; }
    __syncthreads();
    if (act) {
    const int cs = t >> 7, d = t & 127;
    const float* Gp = G + ((size_t)((l * 4 + g) * 2 + cs) * 128) * 128 + d;
    const int nl = cs * 512 + g * 128 + d;
    const int sc = nl & 255, pos = (nl & ~255) + (sc & 128) + map8inv(sc & 127);
    bf16_t* dst = Bt_in + (size_t)l * N_IN * D + (size_t)(3072 + pos) * D + j0;
    for (int jb = 0; jb < 64; jb += 8) {
        float a0 = 0, a1 = 0, a2 = 0, a3 = 0, a4 = 0, a5 = 0, a6 = 0, a7 = 0;
        for (int c = 0; c < 128; ++c) { const float gv = Gp[(size_t)c * 128];
            a0 += wt[jb + 0][c] * gv; a1 += wt[jb + 1][c] * gv; a2 += wt[jb + 2][c] * gv; a3 += wt[jb + 3][c] * gv;
            a4 += wt[jb + 4][c] * gv; a5 += wt[jb + 5][c] * gv; a6 += wt[jb + 6][c] * gv; a7 += wt[jb + 7][c] * gv; }
        *(u32x4*)(dst + jb) = (u32x4){pk2(a0, a1), pk2(a2, a3), pk2(a4, a5), pk2(a6, a7)};
    }
    }
    __syncthreads();
}
__device__ __forceinline__ void prep_tables_gs(float* __restrict__ rope, bf16_t* __restrict__ dftl, bf16_t* __restrict__ dftc, float* __restrict__ lam,
                                                     const float* lq1, const float* lk1, const float* lq2, const float* lk2,
                                                     float* __restrict__ gain, const float* qna, const float* kna, const float* qnb, const float* knb, size_t gid, size_t nth) {
    float* cosA = rope; float* sinA = rope + 2048 * 64; float* cosB = rope + 2 * 2048 * 64; float* sinB = cosB + 2048 * 32;
    for (size_t i = gid; i < (size_t)2048 * 64; i += nth) { const int tk = (int)(i >> 6), f = (int)(i & 63); const int fi = f & 31; const float pos = (f < 32) ? (float)(tk >> 6) : (float)(tk & 63);
        const float inv = powf(10000.0f, -(float)fi / 32.0f); const float ang = pos * inv; cosA[i] = cosf(ang); sinA[i] = sinf(ang); }
    for (size_t i = gid; i < (size_t)2048 * 32; i += nth) { const int tk = (int)(i >> 5), f = (int)(i & 31); const int fi = f & 15; const float pos = (f < 16) ? (float)(tk >> 6) : (float)(tk & 63);
        const float inv = powf(10000.0f, -(float)fi / 16.0f); const float ang = pos * inv; cosB[i] = cosf(ang); sinB[i] = sinf(ang); }
    for (size_t i = gid; i < (size_t)2048 * 2048; i += nth) { const int k = (int)(i >> 11), j = (int)(i & 2047); const int tt = j & 1023; const int ph = (k * tt) & 2047;
        float sn, cs; sincospif((float)ph / 1024.0f, &sn, &cs); const float v = (j < 1024 ? cs : (j == 1024 ? ((k & 1) ? -1.0f : 1.0f) : -sn)) * 0.022097086912079608f; dftl[i] = (bf16_t)f2bf(v); }
    for (size_t i = gid; i < (size_t)256 * 256; i += nth) { const int k = (int)(i >> 8), j = (int)(i & 255); const int tt = j & 127; const int ph = (k * tt) & 255;
        float sn, cs; sincospif((float)ph / 128.0f, &sn, &cs); const float v = (j < 128 ? cs : (j == 128 ? ((k & 1) ? -1.0f : 1.0f) : -sn)) * 0.0625f; dftc[i] = (bf16_t)f2bf(v); }
    if (gid < DEPTH * 384) { const int l = (int)gid / 384, i = (int)gid % 384; gain[gid] = i < 128 ? qna[l * 128 + i] : i < 256 ? kna[l * 128 + i - 128] : i < 320 ? qnb[l * 64 + i - 256] : knb[l * 64 + i - 320]; }
    if (gid < DEPTH) { const int l = (int)gid; float s1 = 0.f, s2 = 0.f; for (int i = 0; i < 64; ++i) { s1 += lq1[l * 64 + i] * lk1[l * 64 + i]; s2 += lq2[l * 64 + i] * lk2[l * 64 + i]; }
        lam[l] = expf(s1) - expf(s2) + lambda_init_of(l); }
}
__device__ __forceinline__ void prep_cache_gs(const float* __restrict__ cak, const float* __restrict__ cav, const float* __restrict__ cdk, const float* __restrict__ cdv,
                                                    bf16_t* __restrict__ KAL, bf16_t* __restrict__ VAL, bf16_t* __restrict__ KBL, bf16_t* __restrict__ VBL, size_t gid, size_t nth, int lsel) {
    const size_t nrow = (size_t)NB_LAT * (lsel < 0 ? DEPTH : 1) * PAST;
    for (size_t i = gid; i < nrow * 32; i += nth) { const int it = (int)(i & 31); size_t r = i >> 5; if (lsel >= 0) r = ((r >> 9) * DEPTH + (size_t)lsel) * PAST + (r & 511); const int p = (int)(r & 511), l = (int)((r >> 9) & 3), b = (int)(r >> 11);
        const int head = it >> 4, s0 = (it & 15) * 8;
        const float* srck = cak + r * 256 + head * 128; const float* srcv = cav + r * 256 + head * 128;
        const int la = sigma128(s0), lb = sigma128(s0 + 4);
        const f32x4 ka = *(const f32x4*)(srck + la), kb = *(const f32x4*)(srck + lb), va = *(const f32x4*)(srcv + s0), vb = *(const f32x4*)(srcv + s0 + 4);
        const size_t orow = ((size_t)(l * NB_LAT + b) * S_LAT + T_LAT + p) * 256 + head * 128 + s0;
        *(u32x4*)(KAL + orow) = (u32x4){pk2(ka[0], ka[1]), pk2(ka[2], ka[3]), pk2(kb[0], kb[1]), pk2(kb[2], kb[3])};
        *(u32x4*)(VAL + orow) = (u32x4){pk2(va[0], va[1]), pk2(va[2], va[3]), pk2(vb[0], vb[1]), pk2(vb[2], vb[3])}; }
    for (size_t i = gid; i < nrow * 64; i += nth) { const int it = (int)(i & 63); size_t r = i >> 6; if (lsel >= 0) r = ((r >> 9) * DEPTH + (size_t)lsel) * PAST + (r & 511); const int p = (int)(r & 511), l = (int)((r >> 9) & 3), b = (int)(r >> 11);
        const int grp = it >> 3, s0 = (it & 7) * 8;
        const float* srck = cdk + r * 512 + grp * 64; const float* srcv = cdv + r * 512 + it * 8;
        const int la = sigma64(s0), lb = sigma64(s0 + 4);
        const f32x4 ka = *(const f32x4*)(srck + la), kb = *(const f32x4*)(srck + lb), va = *(const f32x4*)(srcv), vb = *(const f32x4*)(srcv + 4);
        const size_t orow = ((size_t)(l * NB_LAT + b) * S_LAT + T_LAT + p) * 512 + it * 8;
        *(u32x4*)(KBL + orow) = (u32x4){pk2(ka[0], ka[1]), pk2(ka[2], ka[3]), pk2(kb[0], kb[1]), pk2(kb[2], kb[3])};
        *(u32x4*)(VBL + orow) = (u32x4){pk2(va[0], va[1]), pk2(va[2], va[3]), pk2(vb[0], vb[1]), pk2(vb[2], vb[3])}; }
}

__device__ __forceinline__ void prep_transpose256_vb(const float* __restrict__ W, int K, int ldw, size_t w_layer_stride, bf16_t* __restrict__ Bt, size_t bt_layer_stride, int mode, int vbx, int vby, int vbz, int t, float (*tile)[257], bool act, int nblk = 0) {
    const int k0 = vbx * 64, grp = vby, l = vbz;
    const float* Wl = W + (size_t)l * w_layer_stride; bf16_t* Bl = Bt + (size_t)l * bt_layer_stride;
    const int c0 = grp * 256;
    if (act) {
        f32x4 v[16];
#pragma unroll
        for (int i = 0; i < 16; ++i) { const int idx = t + 256 * i, row = idx >> 6, c = (idx & 63) * 4; v[i] = *(const f32x4*)(Wl + (size_t)(k0 + row) * ldw + c0 + c); }
#pragma unroll
        for (int i = 0; i < 16; ++i) { const int idx = t + 256 * i, row = idx >> 6, c = (idx & 63) * 4;
            tile[row][c] = v[i][0]; tile[row][c + 1] = v[i][1]; tile[row][c + 2] = v[i][2]; tile[row][c + 3] = v[i][3]; } }
    __syncthreads();
    if (act) {
        const int p = t, sc = (p & 128) | map8(p & 127);
        const int lc = (mode == 0) ? sc : in_logical_col(grp, sc) - grp * 256;
        bf16_t* dst = nblk ? Bl + ((size_t)vbx * nblk + c0 + p) * 64 : Bl + (size_t)(c0 + p) * K + k0;
#pragma unroll
        for (int q = 0; q < 8; ++q) { unsigned w[4];
#pragma unroll
            for (int j = 0; j < 4; ++j) w[j] = pk2(tile[8 * q + 2 * j][lc], tile[8 * q + 2 * j + 1][lc]);
            *(u32x4*)(dst + 8 * q) = (u32x4){w[0], w[1], w[2], w[3]}; }
    }
    __syncthreads();
}
__device__ __forceinline__ void prep_ada96_vb(const float* __restrict__ c, const float* __restrict__ c_ctx, const float* __restrict__ w_ada, const float* __restrict__ b_ada, float* __restrict__ mod, int vb, int t, float* sm, bool act) {
    float (*sv)[128] = (float(*)[128])sm; float (*red)[96] = (float(*)[96])(sm + NCOND * 128);
    const int l = vb >> 7, col = (vb & 127) * 96 + (t % 96), kh = t / 96; const bool work = act && t < 192;
    const float* W = w_ada + (size_t)l * D * NMOD + col;
    float acc[NCOND];
#pragma unroll
    for (int q = 0; q < NCOND; ++q) acc[q] = 0.f;
    for (int k0 = 0; k0 < D; k0 += 128) {
        __syncthreads();
        if (act) for (int i = t; i < NCOND * 128; i += 256) { const int q = i >> 7, kk = i & 127; const float v = (q == 0) ? c_ctx[k0 + kk] : c[(size_t)(q - 1) * D + k0 + kk]; sv[q][kk] = v / (1.f + expf(-v)); }
        __syncthreads();
        if (work) {
#pragma unroll 2
            for (int kk = kh * 64; kk < kh * 64 + 64; kk += 4) {
                const float w0 = W[(size_t)(k0 + kk) * NMOD], w1 = W[(size_t)(k0 + kk + 1) * NMOD], w2 = W[(size_t)(k0 + kk + 2) * NMOD], w3 = W[(size_t)(k0 + kk + 3) * NMOD];
#pragma unroll
                for (int q = 0; q < NCOND; ++q) { const f32x4 s = *(const f32x4*)&sv[q][kk]; acc[q] += (s[0] * w0 + s[1] * w1) + (s[2] * w2 + s[3] * w3); }
            }
        }
    }
    if (work && kh == 1) {
#pragma unroll
        for (int q = 0; q < NCOND; ++q) red[q][t - 96] = acc[q]; }
    __syncthreads();
    if (work && kh == 0) { const float bb = b_ada[(size_t)l * NMOD + col];
#pragma unroll
        for (int q = 0; q < NCOND; ++q) mod[((size_t)l * NCOND + q) * NMOD + col] = (acc[q] + red[q][t]) + bb; }
    __syncthreads();
}
#ifndef PG8_WGM
#define PG8_WGM 4
#endif
namespace pg8 {
#define PG8_LAS __attribute__((address_space(3)))
typedef unsigned short bf16_t;
typedef short bf16x8 __attribute__((ext_vector_type(8)));
typedef float f32x4 __attribute__((ext_vector_type(4)));
typedef unsigned u32x4 __attribute__((ext_vector_type(4)));
constexpr int BM = 256, BK = 64, HALF = 128, HTB = HALF * BK * 2  , STAGE_BYTES = 8 * HTB, NXCD = 8, WGM = PG8_WGM;

__host__ __device__ __forceinline__ int lds_byte(int r, int c) { const int st = (r >> 4) * 2 + (c >> 5), rr = r & 15, cc = c & 31, ob = rr * 64 + cc * 2; return st * 1024 + (ob ^ (((ob >> 9) & 1) << 5)); }
__host__ __device__ __forceinline__ void stage_rc(int b, int& R, int& C) { const int st = b / 1024, sb = b % 1024, swz = sb ^ (((sb >> 9) & 1) << 5); R = (st >> 1) * 16 + swz / 64; C = (st & 1) * 32 + (swz % 64) / 2; }
__host__ __device__ __forceinline__ int perm32(int rho) { const int n = rho >> 4, i = rho & 15; return 8 * (i >> 2) + 4 * n + (i & 3); }

struct Unit { int pm, pn, kh, aux; };
struct Gemm { const bf16_t* A; const bf16_t* Bt; int M, N, K, ld; int lda = 0; size_t kstepA = 0; int ldb = 0; size_t kstepB = 0; };

struct StaticOrder {
    int nM, nN, nwg, G, c; int rounds = 1 << 30; int wgm = WGM; int rev = 0;
    __device__ __forceinline__ const char* aptr(const Unit& u, const Gemm& g) const { return (const char*)g.A + (size_t)u.pm * ((size_t)BM * (g.lda ? g.lda : g.ld) * 2) + (size_t)u.kh * (size_t)(g.K / BK) * (g.kstepA ? g.kstepA : (size_t)BK * 2); }
    __device__ __forceinline__ const char* bptr(const Unit& u, const Gemm& g) const { return (const char*)g.Bt + (size_t)u.pn * ((size_t)BM * (g.ldb ? g.ldb : g.ld) * 2) + (size_t)u.kh * (size_t)(g.K / BK) * (g.kstepB ? g.kstepB : (size_t)BK * 2); }
    __host__ __device__ void init(int M, int N, int G_, int c_) { nM = M / BM; nN = N / BM; nwg = nM * nN; G = G_; c = c_; }
    __host__ __device__ bool next(int i, Unit& u) const {
        const long L = (long)i * G + c; if (L >= nwg || i >= rounds) return false; u.kh = 0; u.aux = 0;
        int wgid = (int)L; { const int q = nwg / NXCD, r = nwg % NXCD, xcd = wgid % NXCD, off = wgid / NXCD; wgid = (xcd < r ? xcd * (q + 1) : r * (q + 1) + (xcd - r) * q) + off; }
        const int nig = wgm * nN, gid = wgid / nig, fm = gid * wgm, gsz = (nM - fm) < wgm ? (nM - fm) : wgm;
        u.pm = fm + ((wgid % nig) % gsz); u.pn = (wgid % nig) / gsz; if (rev) u.pm = nM - 1 - u.pm;
        return true;
    }
    __device__ __forceinline__ void a_ready(const Unit&) const {}
    __device__ __forceinline__ void done(const Unit&) const {}
};


__device__ __forceinline__ unsigned cvt_pk_bf16(float lo, float hi) { unsigned r; asm volatile("v_cvt_pk_bf16_f32 %0, %1, %2" : "=v"(r) : "v"(lo), "v"(hi)); return r; }
__device__ __forceinline__ u32x4 pack8(const f32x4 a, const f32x4 b) { u32x4 w; w.x = cvt_pk_bf16(a[0], a[1]); w.y = cvt_pk_bf16(a[2], a[3]); w.z = cvt_pk_bf16(b[0], b[1]); w.w = cvt_pk_bf16(b[2], b[3]); return w; }
constexpr int EPIX_OFF = STAGE_BYTES + 8192 + 1024, EPIX_SLOT = 9216, EPIX_END = EPIX_OFF + 2 * EPIX_SLOT;
__device__ __forceinline__ void stage_ss_bias(const float* ss, const float* bias_row256, const Unit& u, PG8_LAS unsigned char* lds, int ui) {
    int t_ = threadIdx.x; asm volatile("" : "+v"(t_)); const int wid_ = __builtin_amdgcn_readfirstlane(t_ >> 6), lane_ = t_ & 63;
    PG8_LAS unsigned char* slot = lds + EPIX_OFF + (ui & 1) * EPIX_SLOT;
    __builtin_amdgcn_global_load_lds((const unsigned*)((const char*)(ss + (size_t)u.pm * BM * 8) + wid_ * 1024 + lane_ * 16), (PG8_LAS unsigned*)(slot + wid_ * 1024), 16, 0, 0);
    if (wid_ == 0) __builtin_amdgcn_global_load_lds((const unsigned*)((const char*)bias_row256 + lane_ * 16), (PG8_LAS unsigned*)(slot + 8192), 16, 0, 0);
}
#define EPI_LANE_COORDS int t_ = threadIdx.x; asm volatile("" : "+v"(t_)); const int wid_ = __builtin_amdgcn_readfirstlane(t_ >> 6), wr = wid_ >> 2, wc = wid_ & 3, fr = t_ & 15, fq = (t_ >> 4) & 3
__device__ __forceinline__ float row_rinv(const PG8_LAS float* ssl, int row) {
    const f32x4 a = *(const PG8_LAS f32x4*)(ssl + row * 8), b = *(const PG8_LAS f32x4*)(ssl + row * 8 + 4);
    return __builtin_amdgcn_rsqf((((a[0] + a[1]) + (a[2] + a[3])) + ((b[0] + b[1]) + (b[2] + b[3]))) * (1.0f / D) + EPS);
}
#ifndef HID_NT
#define HID_NT 0
#endif
struct EpiRelu2 {
    static constexpr bool PERM = false, AFTER_DRAIN = false;
    bf16_t* O; int ldc; const float* ss; const float* bias;
    int Mblk;
    __device__ __forceinline__ void stage(const Unit& u, PG8_LAS unsigned char* lds, int ui) const { const int cond = u.pm < 16 ? 0 : 1 + ((u.pm - 16) >> 3); stage_ss_bias(ss, bias + (size_t)cond * ldc + u.pn * BM, u, lds, ui); }
    __device__ __forceinline__ void operator()(f32x4 (&acc)[2][2][4][2], const Unit& u, int ui, int, int, int, PG8_LAS unsigned char* lds) const {
        EPI_LANE_COORDS;
        PG8_LAS unsigned char* xs = lds + EPIX_OFF + (ui & 1) * EPIX_SLOT;
        const PG8_LAS float* ssl = (const PG8_LAS float*)xs; const PG8_LAS float* bp = (const PG8_LAS float*)(xs + 8192) + wc * 32 + 4 * fq;
        f32x4 bv[2][2];
#pragma unroll
        for (int bj = 0; bj < 2; ++bj) { bv[bj][0] = *(const PG8_LAS f32x4*)(bp + bj * HALF); bv[bj][1] = *(const PG8_LAS f32x4*)(bp + bj * HALF + 16); }
        const int row0 = u.pm * BM + wr * 64 + fr;
        const int c0 = u.pn * BM + wc * 32 + 8 * fq;
        const size_t rpitch = Mblk ? 64 : (size_t)ldc, hoff = Mblk ? (size_t)2 * Mblk * 64 : (size_t)HALF;
        bf16_t* base = Mblk ? O + ((size_t)(c0 >> 6) * Mblk + row0) * 64 + (c0 & 63) : O + (size_t)row0 * ldc + c0;
#pragma unroll
        for (int ai = 0; ai < 2; ++ai)
#pragma unroll
            for (int m = 0; m < 4; ++m) { bf16_t* rowp = base + (size_t)(ai * HALF + m * 16) * rpitch;
                const float r = row_rinv(ssl, wr * 64 + fr + ai * HALF + m * 16);
#pragma unroll
                for (int bj = 0; bj < 2; ++bj) { f32x4 v0 = acc[ai][bj][m][0] * r + bv[bj][0], v1 = acc[ai][bj][m][1] * r + bv[bj][1];
#pragma unroll
                    for (int e = 0; e < 4; ++e) { const float a = v0[e] > 0.f ? v0[e] : 0.f, b = v1[e] > 0.f ? v1[e] : 0.f; v0[e] = a * a; v1[e] = b * b; }
                    if (HID_NT) __builtin_nontemporal_store(pack8(v0, v1), (u32x4*)(rowp + bj * hoff)); else *(u32x4*)(rowp + bj * hoff) = pack8(v0, v1); } }
    }
};
struct EpiBf16Out {
    static constexpr bool PERM = false, AFTER_DRAIN = false;
    bf16_t* O; int ldc; int col_off;
    __device__ __forceinline__ void stage(const Unit&, PG8_LAS unsigned char*, int) const {}
    __device__ __forceinline__ void operator()(f32x4 (&acc)[2][2][4][2], const Unit& u, int, int, int, int, PG8_LAS unsigned char*) const {
        EPI_LANE_COORDS;
        bf16_t* base = O + (size_t)(u.pm * BM + wr * 64 + fr) * ldc + col_off + u.pn * BM + wc * 32 + 8 * fq;
#pragma unroll
        for (int ai = 0; ai < 2; ++ai)
#pragma unroll
            for (int m = 0; m < 4; ++m) { bf16_t* rowp = base + (size_t)(ai * HALF + m * 16) * ldc;
#pragma unroll
                for (int bj = 0; bj < 2; ++bj) *(u32x4*)(rowp + bj * HALF) = pack8(acc[ai][bj][m][0], acc[ai][bj][m][1]); }
    }
};
struct ResNext { bf16_t* XA; const float* gn; const float* scn; float* ssn; };
#ifndef XA_BLOCKED
#define XA_BLOCKED 0
#endif
#ifndef PART_BF16
#define PART_BF16 1
#endif
#ifndef PB_PF
#define PB_PF 1
#endif
#ifndef XB_PF
#define XB_PF 2
#endif
struct EpiRes {
    static constexpr bool PERM = false, AFTER_DRAIN = false;
    float* X; const float* gate; ResNext nx;
    const float* Xr_ctx; const float* Xr_lat;
    int mode = 3;
    __device__ __forceinline__ void stage(const Unit&, PG8_LAS unsigned char*, int) const {}
    template <bool SPLIT>
    __device__ __forceinline__ void run(f32x4 (&acc)[2][2][4][2], const Unit& u, int wr, int wc, int fr, int fq, const float* pb, PG8_LAS unsigned char* lds, int t_) const {
        PG8_LAS float* PT = (PG8_LAS float*)(lds + STAGE_BYTES);
        const int cond = u.pm < 16 ? 0 : 1 + ((u.pm - 16) >> 3); const int col0 = u.pn * BM + wc * 32 + 8 * fq;
        const float* gp = gate + (size_t)cond * NMOD + col0;
        f32x4 gv[2][2], av[2][2];
        const bool has_next = nx.XA != nullptr;
#pragma unroll
        for (int bj = 0; bj < 2; ++bj) { gv[bj][0] = *(const f32x4*)(gp + bj * HALF); gv[bj][1] = *(const f32x4*)(gp + bj * HALF + 4); av[bj][0] = (f32x4){0.f, 0.f, 0.f, 0.f}; av[bj][1] = av[bj][0]; }
        if (has_next) { const float* g2 = nx.gn + col0; const float* s2 = nx.scn + (size_t)cond * NMOD + col0;
#pragma unroll
            for (int bj = 0; bj < 2; ++bj) { av[bj][0] = *(const f32x4*)(g2 + bj * HALF) * (*(const f32x4*)(s2 + bj * HALF) + 1.0f); av[bj][1] = *(const f32x4*)(g2 + bj * HALF + 4) * (*(const f32x4*)(s2 + bj * HALF + 4) + 1.0f); } }
        const int row0 = u.pm * BM + wr * 64 + fr;
        const bool rd_f32 = mode & 1, wr_f32 = mode & 2; const size_t eo = (size_t)row0 * D + col0;
        float* base = wr_f32 ? X + eo : (float*)((bf16_t*)X + eo); const float* rbase = (u.pm < 16 ? Xr_ctx : Xr_lat); rbase = rd_f32 ? rbase + eo : (const float*)((const bf16_t*)rbase + eo);
#if XB_PF
        u32x4 xq[8][2];
#define XQ_LOAD(rg) do { const bf16_t* rr_ = (const bf16_t*)rbase + (size_t)(((rg) >> 2) * HALF + ((rg) & 3) * 16) * D; xq[rg][0] = *(const u32x4*)rr_; xq[rg][1] = *(const u32x4*)(rr_ + HALF); } while (0)
        f32x4 pq[8][2][2];
#if PART_BF16
        u32x4 pqh[8][2];
#define PQ_LOAD(rg) do { if (SPLIT && PB_PF) { _Pragma("unroll") for (int bj_ = 0; bj_ < 2; ++bj_) pqh[rg][bj_] = *(const u32x4*)(pb + (size_t)((((rg) >> 2) * 2 + bj_) * 4 + ((rg) & 3)) * 2048); } } while (0)
#else
#define PQ_LOAD(rg) do { if (SPLIT && PB_PF) { _Pragma("unroll") for (int bj_ = 0; bj_ < 2; ++bj_) { pq[rg][bj_][0] = *(const f32x4*)(pb + (size_t)(((((rg) >> 2) * 2 + bj_) * 4 + ((rg) & 3)) * 2 + 0) * 2048); pq[rg][bj_][1] = *(const f32x4*)(pb + (size_t)(((((rg) >> 2) * 2 + bj_) * 4 + ((rg) & 3)) * 2 + 1) * 2048); } } } while (0)
#endif
        if (!rd_f32) {
#pragma unroll
            for (int rg = 0; rg < XB_PF; ++rg) XQ_LOAD(rg); }
#pragma unroll
        for (int rg = 0; rg < XB_PF; ++rg) PQ_LOAD(rg);
#endif
#pragma unroll
        for (int ai = 0; ai < 2; ++ai)
#pragma unroll
            for (int m = 0; m < 4; ++m) { const int ro = ai * HALF + m * 16; float* rowp = wr_f32 ? base + (size_t)ro * D : (float*)((bf16_t*)base + (size_t)ro * D); const float* rrow = rd_f32 ? rbase + (size_t)ro * D : (const float*)((const bf16_t*)rbase + (size_t)ro * D); float sq = 0.f;
#pragma unroll
                for (int bj = 0; bj < 2; ++bj) { f32x4 x0, x1;
                    if (rd_f32) { x0 = *(const f32x4*)(rrow + bj * HALF); x1 = *(const f32x4*)(rrow + bj * HALF + 4); }
                    else {
#if XB_PF
                        const u32x4 v = xq[ai * 4 + m][bj];
#else
                        const u32x4 v = *(const u32x4*)((const bf16_t*)rrow + bj * HALF);
#endif
                        x0 = (f32x4){__builtin_bit_cast(float, v[0] << 16), __builtin_bit_cast(float, v[0] & 0xffff0000u), __builtin_bit_cast(float, v[1] << 16), __builtin_bit_cast(float, v[1] & 0xffff0000u)};
                        x1 = (f32x4){__builtin_bit_cast(float, v[2] << 16), __builtin_bit_cast(float, v[2] & 0xffff0000u), __builtin_bit_cast(float, v[3] << 16), __builtin_bit_cast(float, v[3] & 0xffff0000u)}; }
                    f32x4 a0 = acc[ai][bj][m][0], a1 = acc[ai][bj][m][1];
#if XB_PF && PB_PF
#if PART_BF16
                    if (SPLIT) { const u32x4 pv = pqh[ai * 4 + m][bj];
                        a0 = a0 + (f32x4){__builtin_bit_cast(float, pv[0] << 16), __builtin_bit_cast(float, pv[0] & 0xffff0000u), __builtin_bit_cast(float, pv[1] << 16), __builtin_bit_cast(float, pv[1] & 0xffff0000u)};
                        a1 = a1 + (f32x4){__builtin_bit_cast(float, pv[2] << 16), __builtin_bit_cast(float, pv[2] & 0xffff0000u), __builtin_bit_cast(float, pv[3] << 16), __builtin_bit_cast(float, pv[3] & 0xffff0000u)}; }
#else
                    if (SPLIT) { a0 = a0 + pq[ai * 4 + m][bj][0]; a1 = a1 + pq[ai * 4 + m][bj][1]; }
#endif
#else
                    if (SPLIT) { a0 = a0 + *(const f32x4*)(pb + (size_t)(((ai * 2 + bj) * 4 + m) * 2 + 0) * 2048); a1 = a1 + *(const f32x4*)(pb + (size_t)(((ai * 2 + bj) * 4 + m) * 2 + 1) * 2048); }
#endif
                    x0 = x0 + gv[bj][0] * a0; x1 = x1 + gv[bj][1] * a1;
                    if (wr_f32) { *(f32x4*)(rowp + bj * HALF) = x0; *(f32x4*)(rowp + bj * HALF + 4) = x1; } else *(u32x4*)((bf16_t*)rowp + bj * HALF) = pack8(x0, x1);
                    if (has_next) { const int xc_ = col0 + bj * HALF;
                        *(u32x4*)(XA_BLOCKED ? nx.XA + ((size_t)(xc_ >> 6) * M_ALL + (row0 + ro)) * 64 + (xc_ & 63) : nx.XA + (size_t)(row0 + ro) * D + xc_) = pack8(x0 * av[bj][0], x1 * av[bj][1]);
                        sq += (x0[0] * x0[0] + x0[1] * x0[1]) + (x0[2] * x0[2] + x0[3] * x0[3]) + (x1[0] * x1[0] + x1[1] * x1[1]) + (x1[2] * x1[2] + x1[3] * x1[3]); } }
                if (has_next) { sq += __shfl_xor(sq, 16); sq += __shfl_xor(sq, 32); if (fq == 0) PT[(ro + wr * 64 + fr) * 4 + wc] = sq; }
#if XB_PF
                if (!rd_f32 && ai * 4 + m + XB_PF < 8) XQ_LOAD(ai * 4 + m + XB_PF);
                if (ai * 4 + m + XB_PF < 8) PQ_LOAD(ai * 4 + m + XB_PF);
#endif
                asm volatile("" ::: "memory"); }
#if XB_PF
#undef XQ_LOAD
#undef PQ_LOAD
#endif
        if (has_next) {
            asm volatile("s_waitcnt lgkmcnt(0)" ::: "memory"); __builtin_amdgcn_s_barrier(); asm volatile("" ::: "memory");
            if (t_ < 256) { const f32x4 p = *(const PG8_LAS f32x4*)(PT + t_ * 4); nx.ssn[(size_t)(u.pm * BM + t_) * 8 + u.pn] = (p[0] + p[1]) + (p[2] + p[3]); }
        }
    }
    __device__ __forceinline__ void operator()(f32x4 (&acc)[2][2][4][2], const Unit& u, int, int, int, int, PG8_LAS unsigned char* lds) const {
        EPI_LANE_COORDS;
        run<false>(acc, u, wr, wc, fr, fq, nullptr, lds, t_);
    }
};
#ifndef ROPE_PRE
#define ROPE_PRE 1
#endif
struct EpiIn {
    static constexpr bool PERM = false, AFTER_DRAIN = false;
    __device__ __forceinline__ void stage(const Unit& u, PG8_LAS unsigned char* lds, int ui) const { const int cond = u.pm < 16 ? 0 : 1 + ((u.pm - 16) >> 3); stage_ss_bias(ss, bias + (size_t)cond * N_IN + u.pn * BM, u, lds, ui); }
    int l;
    unsigned char* ws; float* out_; const float* ss; const float* bias;
    __device__ __forceinline__ void operator()(f32x4 (&acc)[2][2][4][2], const Unit& u, int ui, int, int, int, PG8_LAS unsigned char* lds) const {
        EPI_LANE_COORDS;
        unsigned char* w = ws; float* out = out_; asm volatile("" : "+s"(w), "+s"(out)); w = as_global(w); out = as_global(out);
        bf16_t* const QA = (bf16_t*)(w + WS_QA); bf16_t* const KAL = (bf16_t*)(w + WS_KAL); bf16_t* const VAL = (bf16_t*)(w + WS_VAL); bf16_t* const KAC = (bf16_t*)(w + WS_KAC); bf16_t* const VAC = (bf16_t*)(w + WS_VAC);
        bf16_t* const QB = (bf16_t*)(w + WS_QB); bf16_t* const KBL = (bf16_t*)(w + WS_KBL); bf16_t* const VBL = (bf16_t*)(w + WS_VBL); bf16_t* const KBC = (bf16_t*)(w + WS_KBC); bf16_t* const VBC = (bf16_t*)(w + WS_VBC);
        bf16_t* const YTL = (bf16_t*)(w + WS_YTL); bf16_t* const YTC = (bf16_t*)(w + WS_YTC); const float* const rope = (const float*)(w + WS_ROPE); const float* const gains = (const float*)(w + WS_GAIN) + l * 384;
        const int pn = u.pn, pm = u.pm; const bool lat = pm >= 16; const int b = lat ? (pm - 16) >> 3 : pm; const int tbase = lat ? ((pm - 16) & 7) * 256 : 0;
        const int rl0 = wr * 64 + fr;
        {
            PG8_LAS unsigned char* xs = lds + EPIX_OFF + (ui & 1) * EPIX_SLOT;
            const PG8_LAS float* ssl = (const PG8_LAS float*)xs; const PG8_LAS float* bp = (const PG8_LAS float*)(xs + 8192) + wc * 32 + 4 * fq;
            f32x4 bv[2][2];
#pragma unroll
            for (int bj = 0; bj < 2; ++bj) { bv[bj][0] = *(const PG8_LAS f32x4*)(bp + bj * HALF); bv[bj][1] = *(const PG8_LAS f32x4*)(bp + bj * HALF + 16); }
#pragma unroll
            for (int ai = 0; ai < 2; ++ai)
#pragma unroll
                for (int m = 0; m < 4; ++m) { const float r = row_rinv(ssl, ai * HALF + m * 16 + rl0);
#pragma unroll
                    for (int bj = 0; bj < 2; ++bj) { acc[ai][bj][m][0] = acc[ai][bj][m][0] * r + bv[bj][0]; acc[ai][bj][m][1] = acc[ai][bj][m][1] * r + bv[bj][1]; } }
        }
        const size_t lrow = (size_t)(l * NB_LAT + b) * S_LAT;
        PG8_LAS float* P = (PG8_LAS float*)(lds + STAGE_BYTES);
        const bool normed = (pn <= 4) || (pn >= 6 && pn <= 9);
        if (normed) {
            const bool is128 = pn <= 4;
            int lbase, pstep, fbase, sbase;
            const float *cosT, *sinT; int tstride; const float* g;
            if (is128) { const int u16 = 4 * wc + fq; lbase = (u16 < 8 ? 0 : 64) + 4 * (u16 & 7); pstep = 32; fbase = (u16 < 8 ? 0 : 32) + 4 * (u16 & 7); sbase = 8 * u16;
                cosT = rope; sinT = rope + 2048 * 64; tstride = 64; g = gains + ((pn < 4) ? 0 : 128); }
            else { const int u8 = 4 * (wc & 1) + fq; lbase = (u8 < 4 ? 0 : 32) + 4 * (u8 & 3); pstep = 16; fbase = (u8 < 4 ? 0 : 16) + 4 * (u8 & 3); sbase = 64 * (wc >> 1) + 8 * u8;
                cosT = rope + 2 * 2048 * 64; sinT = cosT + 2048 * 32; tstride = 32; g = gains + ((pn < 8) ? 256 : 320); }
#if ROPE_PRE
            f32x4 csr[8], snr[8];
#define ROPE_LOAD(rg) do { const int tk_ = tbase + ((rg) >> 2) * HALF + ((rg) & 3) * 16 + rl0; csr[rg] = (f32x4){1.f, 1.f, 1.f, 1.f}; snr[rg] = (f32x4){0.f, 0.f, 0.f, 0.f}; \
                if (lat) { csr[rg] = *(const f32x4*)(cosT + (size_t)tk_ * tstride + fbase); snr[rg] = *(const f32x4*)(sinT + (size_t)tk_ * tstride + fbase); } } while (0)
            ROPE_LOAD(0); ROPE_LOAD(1);
#endif
            const f32x4 g0 = *(const f32x4*)(g + lbase), g1 = *(const f32x4*)(g + lbase + pstep);
#pragma unroll
            for (int ai = 0; ai < 2; ++ai)
#pragma unroll
                for (int m = 0; m < 4; ++m)
#pragma unroll
                    for (int bj = 0; bj < 2; ++bj) { const f32x4 a0 = acc[ai][bj][m][0], a1 = acc[ai][bj][m][1];
                        float s = (a0[0] * a0[0] + a0[1] * a0[1]) + (a0[2] * a0[2] + a0[3] * a0[3]) + (a1[0] * a1[0] + a1[1] * a1[1]) + (a1[2] * a1[2] + a1[3] * a1[3]);
                        s += __shfl_xor(s, 16); s += __shfl_xor(s, 32);
                        if (fq == 0) P[(bj * 256 + ai * HALF + m * 16 + rl0) * 4 + wc] = s; }
            asm volatile("s_waitcnt lgkmcnt(0)" ::: "memory"); __builtin_amdgcn_s_barrier(); asm volatile("" ::: "memory");
            const float invdim = is128 ? (1.0f / 128.0f) : (1.0f / 64.0f);
            const bool isq = (pn < 4) || (pn == 6) || (pn == 7);
            const float qscale = isq ? (is128 ? 0.088388347648318440f * 1.4426950408889634f : 0.125f * 1.4426950408889634f) : 1.0f;
#pragma unroll
            for (int ai = 0; ai < 2; ++ai)
#pragma unroll
                for (int m = 0; m < 4; ++m) { const int rl = ai * HALF + m * 16 + rl0; const int tk = tbase + rl; const size_t row = (size_t)pm * BM + rl;
#if ROPE_PRE
                    const f32x4 cs4 = csr[ai * 4 + m], sn4 = snr[ai * 4 + m];
#else
                    f32x4 cs4 = (f32x4){1.f, 1.f, 1.f, 1.f}, sn4 = (f32x4){0.f, 0.f, 0.f, 0.f};
                    if (lat) { cs4 = *(const f32x4*)(cosT + (size_t)tk * tstride + fbase); sn4 = *(const f32x4*)(sinT + (size_t)tk * tstride + fbase); }
#endif
#pragma unroll
                    for (int bj = 0; bj < 2; ++bj) { const f32x4 pp = *(const PG8_LAS f32x4*)(P + (bj * 256 + rl) * 4);
                        const float tot = is128 ? ((pp[0] + pp[1]) + (pp[2] + pp[3])) : (wc < 2 ? pp[0] + pp[1] : pp[2] + pp[3]);
                        const float rinv = __builtin_amdgcn_rsqf(tot * invdim + EPS) * qscale;
                        f32x4 x1 = acc[ai][bj][m][0] * rinv * g0, x2 = acc[ai][bj][m][1] * rinv * g1;
                        bf16_t* dst;
                        if (is128) { if (pn < 4) dst = QA + row * 1024 + (2 * pn + bj) * 128 + sbase;
                            else if (lat) dst = KAL + (lrow + tk) * 256 + bj * 128 + sbase;
                            else { dst = KAC + row * 256 + bj * 128 + sbase; float* st = out + OUT_SAK + ((size_t)(b * DEPTH + l) * T_CTX + tk) * 256 + bj * 128 + lbase; *(f32x4*)st = x1; *(f32x4*)(st + pstep) = x2; } }
                        else { const int h = 2 * ((pn - 6) & 1) + bj;
                            if (pn < 8) dst = QB + row * 512 + h * 128 + sbase;
                            else if (lat) dst = KBL + (lrow + tk) * 512 + h * 128 + sbase;
                            else { dst = KBC + row * 512 + h * 128 + sbase; float* st = out + OUT_SDK + ((size_t)(b * DEPTH + l) * T_CTX + tk) * 512 + h * 128 + 64 * (wc >> 1) + lbase; *(f32x4*)st = x1; *(f32x4*)(st + pstep) = x2; } }
                        if (lat) { const f32x4 y1 = x1 * cs4 - x2 * sn4, y2 = x2 * cs4 + x1 * sn4; x1 = y1; x2 = y2; }
                        *(u32x4*)dst = pack8(x1, x2); }
#if ROPE_PRE
                    if (ai * 4 + m + 2 < 8) ROPE_LOAD(ai * 4 + m + 2);
#endif
                    asm volatile("" ::: "memory");
                }
#if ROPE_PRE
#undef ROPE_LOAD
#endif
        } else if (pn == 5 || pn == 10 || pn == 11) {
            const bool isa = pn == 5; const int pitch = isa ? 256 : 512; const int hb = isa ? 0 : 2 * (pn - 10);
            const int sb = wc * 32 + 8 * fq;
#pragma unroll
            for (int ai = 0; ai < 2; ++ai)
#pragma unroll
                for (int m = 0; m < 4; ++m) { const int rl = ai * HALF + m * 16 + rl0; const int tk = tbase + rl; const size_t row = (size_t)pm * BM + rl;
#pragma unroll
                    for (int bj = 0; bj < 2; ++bj) { const int col = (hb + bj) * 128 + sb; const f32x4 x1 = acc[ai][bj][m][0], x2 = acc[ai][bj][m][1];
                        bf16_t* dst;
                        if (lat) dst = (isa ? VAL : VBL) + (lrow + tk) * pitch + col;
                        else { dst = (isa ? VAC : VBC) + row * pitch + col; float* st = out + (isa ? OUT_SAV : OUT_SDV) + ((size_t)(b * DEPTH + l) * T_CTX + tk) * pitch + col; *(f32x4*)st = x1; *(f32x4*)(st + 4) = x2; }
                        *(u32x4*)dst = pack8(x1, x2); } }
        } else {
            bf16_t* yb = YTL + ((size_t)pm * BM + rl0) * 1024 + (pn - 12) * BM + wc * 32 + 8 * fq;
#pragma unroll
            for (int ai = 0; ai < 2; ++ai)
#pragma unroll
                for (int m = 0; m < 4; ++m)
#pragma unroll
                    for (int bj = 0; bj < 2; ++bj) *(u32x4*)(yb + (size_t)(ai * HALF + m * 16) * 1024 + bj * HALF) = pack8(acc[ai][bj][m][0], acc[ai][bj][m][1]);
        }
    }
};
#ifndef SPLIT_XCD
#define SPLIT_XCD 1
#endif
struct SplitOrder {
    StaticOrder base; int c, on;
    __device__ __forceinline__ static bool producer(int c_) { return SPLIT_XCD ? (c_ & 4) != 0 : (c_ >> 7) != 0; }
    __device__ __forceinline__ static int pair(int c_) { return SPLIT_XCD ? ((c_ >> 3) << 2) | (c_ & 3) : (c_ & 127); }
    __device__ __forceinline__ void init(int M, int N, int G, int c_) { base.init(M, N, 256, pair(c_)); c = c_; on = (G == 256); }
    __device__ __forceinline__ bool next(int i, Unit& u) const { if (!on || i > 0) return false; const bool ok = base.next(2, u); u.kh = producer(c) ? 1 : 0; u.aux = pair(c); return ok; }
    __device__ __forceinline__ const char* aptr(const Unit& u, const Gemm& g) const { return base.aptr(u, g); }
    __device__ __forceinline__ const char* bptr(const Unit& u, const Gemm& g) const { return base.bptr(u, g); }
    __device__ __forceinline__ void a_ready(const Unit&) const {}
    __device__ __forceinline__ void done(const Unit&) const {}
};
struct EpiResSplit {
    static constexpr bool PERM = false, AFTER_DRAIN = false;
    __device__ __forceinline__ void stage(const Unit&, PG8_LAS unsigned char*, int) const {}
    EpiRes R; float* part; unsigned* flags; unsigned* tmo;
    __device__ __forceinline__ void operator()(f32x4 (&acc)[2][2][4][2], const Unit& u, int, int, int, int, PG8_LAS unsigned char* lds) const {
        EPI_LANE_COORDS;
        float* pb = part + (size_t)u.aux * 65536 + (size_t)t_ * 4;
        unsigned* flag = flags + (size_t)u.aux * 64;
        if (u.kh == 1) {
#pragma unroll
            for (int ai = 0; ai < 2; ++ai)
#pragma unroll
                for (int bj = 0; bj < 2; ++bj)
#pragma unroll
                    for (int m = 0; m < 4; ++m)
#pragma unroll
                        for (int n = 0; n < 2; ++n) { if (PART_BF16) { if (n == 0) *(u32x4*)(pb + (size_t)((ai * 2 + bj) * 4 + m) * 2048) = pack8(acc[ai][bj][m][0], acc[ai][bj][m][1]); }
                            else *(f32x4*)(pb + (size_t)(((ai * 2 + bj) * 4 + m) * 2 + n) * 2048) = acc[ai][bj][m][n]; }
            asm volatile("s_waitcnt vmcnt(0)" ::: "memory");
            __builtin_amdgcn_s_barrier(); asm volatile("" ::: "memory");
            if (t_ == 0) { __builtin_amdgcn_fence(__ATOMIC_RELEASE, "agent"); asm volatile("s_waitcnt vmcnt(0)" ::: "memory");
                __hip_atomic_store(flag, 1u, __ATOMIC_RELAXED, __HIP_MEMORY_SCOPE_AGENT); }
        } else {
            if (wid_ == 0) {
                unsigned sp = 0;
                while ((unsigned)__builtin_amdgcn_readfirstlane(__hip_atomic_load(flag, __ATOMIC_RELAXED, __HIP_MEMORY_SCOPE_AGENT)) == 0u) {
                    __builtin_amdgcn_s_sleep(2);
                    if ((++sp & 1023u) == 0u) { if (__builtin_amdgcn_readfirstlane(__hip_atomic_load(tmo, __ATOMIC_RELAXED, __HIP_MEMORY_SCOPE_AGENT)) != 0u) break;
                        if (sp > (1u << 22)) { if (t_ == 0) __hip_atomic_store(tmo, 1u, __ATOMIC_RELAXED, __HIP_MEMORY_SCOPE_AGENT); break; } } }
                __builtin_amdgcn_fence(__ATOMIC_ACQUIRE, "agent");
                asm volatile("s_waitcnt vmcnt(0)" ::: "memory");
            }
            __builtin_amdgcn_s_barrier(); asm volatile("" ::: "memory");
            R.run<true>(acc, u, wr, wc, fr, fq, pb, lds, t_);
        }
    }
};
struct DftOrder {
    int lat, first, count, G, c;
    __device__ __forceinline__ bool next(int i, Unit& u) const {
        const int nu = lat ? 128 : 32; const int k = c - first; if (k < 0 || k >= count) return false; const int id = k + i * count; if (id >= nu) return false;
        u.kh = 0; u.aux = 0;
        if (lat) { const int b = id >> 4, pmm = (id >> 1) & 7; u.pm = 16 + b * 8 + pmm; u.pn = id & 1; } else { u.pm = id >> 1; u.pn = id & 1; }
        return true;
    }
    __device__ __forceinline__ const char* aptr(const Unit& u, const Gemm& g) const { return lat ? (const char*)g.A + (size_t)((u.pm - 16) & 7) * ((size_t)BM * g.ld * 2) : (const char*)g.A; }
    __device__ __forceinline__ const char* bptr(const Unit& u, const Gemm& g) const { const int b = lat ? (u.pm - 16) >> 3 : u.pm; return (const char*)g.Bt + ((size_t)b * 512 + (size_t)u.pn * BM) * ((size_t)g.ld * 2); }
    __device__ __forceinline__ void a_ready(const Unit&) const {}
    __device__ __forceinline__ void done(const Unit&) const {}
};
template <class Epi, class Sched, bool ALIGN_EPI = false, bool SP2 = false>
__device__ __forceinline__ void gemm_phase(PG8_LAS unsigned char* lds, const Gemm g, const Sched& S, const Epi& E) {
    int tid = threadIdx.x; asm volatile("" : "+v"(tid));
    const int wid = __builtin_amdgcn_readfirstlane(tid >> 6), lane = tid & 63, wr = wid >> 2, wc = wid & 3, fr = lane & 15, fq = lane >> 4;
    const int K = g.ldb ? g.ldb : g.ld, KA = g.lda ? g.lda : g.ld, nt = g.K / BK;
    unsigned voffA[2], voffB[2];
#pragma unroll
    for (int i = 0; i < 2; ++i) { int R, C; stage_rc(tid * 16 + i * 8192, R, C); const int Rb = Epi::PERM ? ((R & ~31) + perm32(R & 31)) : R;
        voffA[i] = (unsigned)(R * KA + C) * 2u; voffB[i] = (unsigned)(Rb * K + C) * 2u; }
    const size_t kstepB = g.kstepB ? g.kstepB : (size_t)(BK * 2), kstepA = g.kstepA ? g.kstepA : (size_t)(BK * 2);
    const size_t hstepB = (size_t)HALF * K * 2, hstepA = (size_t)HALF * KA * 2;
    const size_t tstep = 2 * hstepB; (void)tstep;
    const unsigned ldsw = (unsigned)wid * 1024u;
    const int aoff = lds_byte(wr * 64 + fr, fq * 8), boff = lds_byte(wc * 32 + fr, fq * 8);
#define PG8_SA(b, h) (((b) * 2 + (h)) * HTB)
#define PG8_SB(b, h) ((4 + (b) * 2 + (h)) * HTB)
#define PG8_STAGE(bufoff, gbase, voff) do { _Pragma("unroll") for (int _i = 0; _i < 2; ++_i) \
        __builtin_amdgcn_global_load_lds((const unsigned*)((const char*)(gbase) + (voff)[_i]), (PG8_LAS unsigned*)(lds + (bufoff) + ldsw + _i * 8192), 16, 0, 0); } while (0)
#define PG8_LDA(dst, b, h) do { _Pragma("unroll") for (int m = 0; m < 4; ++m) _Pragma("unroll") for (int k = 0; k < 2; ++k) dst[m][k] = *(const PG8_LAS bf16x8*)(lds + PG8_SA(b, h) + aoff + m * 2048 + k * 1024); } while (0)
#define PG8_LDB(dst, b, h) do { _Pragma("unroll") for (int n = 0; n < 2; ++n) _Pragma("unroll") for (int k = 0; k < 2; ++k) dst[n][k] = *(const PG8_LAS bf16x8*)(lds + PG8_SB(b, h) + boff + n * 2048 + k * 1024); } while (0)
#define PG8_MMA(ai, bj, At, Bt) do { __builtin_amdgcn_s_setprio(1); _Pragma("unroll") for (int m = 0; m < 4; ++m) _Pragma("unroll") for (int n = 0; n < 2; ++n) _Pragma("unroll") for (int k = 0; k < 2; ++k) \
        acc[ai][bj][m][n] = __builtin_amdgcn_mfma_f32_16x16x32_bf16(Bt[n][k], At[m][k], acc[ai][bj][m][n], 0, 0, 0); __builtin_amdgcn_s_setprio(0); } while (0)
#define PG8_WAIT_V(n) asm volatile("s_waitcnt vmcnt(" #n ")" ::: "memory")
#define PG8_WAIT_L(n) asm volatile("s_waitcnt lgkmcnt(" #n ")" ::: "memory")
#define PG8_BAR __builtin_amdgcn_s_barrier()
#define PG8_SCHED __builtin_amdgcn_sched_barrier(0)
    Unit cur, nxt; int ui = 0;
    if (!S.next(0, cur)) return;
    f32x4 acc[2][2][4][2];
#pragma unroll
    for (int a = 0; a < 2; ++a)
#pragma unroll
        for (int b = 0; b < 2; ++b)
#pragma unroll
            for (int m = 0; m < 4; ++m)
#pragma unroll
                for (int n = 0; n < 2; ++n) acc[a][b][m][n] = (f32x4){0.f, 0.f, 0.f, 0.f};
    bf16x8 At[4][2], B0[2][2], B1[2][2];
    const char* cA = S.aptr(cur, g); const char* cB = S.bptr(cur, g);
    S.a_ready(cur);
    E.stage(cur, lds, 0);
    if constexpr (SP2) {
        PG8_STAGE(PG8_SB(0, 0), cB, voffB); PG8_STAGE(PG8_SB(0, 1), cB + hstepB, voffB); PG8_STAGE(PG8_SA(0, 0), cA, voffA); PG8_STAGE(PG8_SA(0, 1), cA + hstepA, voffA);
        if (wr == 1) PG8_BAR;
        PG8_WAIT_V(2); PG8_BAR;
        PG8_STAGE(PG8_SB(1, 0), cB + kstepB, voffB); PG8_STAGE(PG8_SA(1, 0), cA + kstepA, voffA); PG8_STAGE(PG8_SB(1, 1), cB + hstepB + kstepB, voffB);
        PG8_WAIT_V(6); PG8_BAR;
    } else {
        PG8_STAGE(PG8_SB(0, 0), cB, voffB); PG8_STAGE(PG8_SA(0, 0), cA, voffA); PG8_STAGE(PG8_SB(0, 1), cB + hstepB, voffB); PG8_STAGE(PG8_SA(0, 1), cA + hstepA, voffA);
        if (wr == 1) PG8_BAR;
        PG8_WAIT_V(4); PG8_BAR;
        PG8_STAGE(PG8_SB(1, 0), cB + kstepB, voffB); PG8_STAGE(PG8_SA(1, 0), cA + kstepA, voffA); PG8_STAGE(PG8_SB(1, 1), cB + hstepB + kstepB, voffB);
        PG8_WAIT_V(6); PG8_BAR;
    }
    for (;;) {
        const bool has_next = S.next(ui + 1, nxt);
        const char* nA = has_next ? S.aptr(nxt, g) : cA; const char* nB = has_next ? S.bptr(nxt, g) : cB;
        for (int t = 0; t < nt; t += 2) {
            const bool last = (t == nt - 2);
            const char* a1 = cA + (size_t)(t + 1) * kstepA;
            const char* a2 = last ? nA : cA + (size_t)(t + 2) * kstepA; const char* b2 = last ? nB : cB + (size_t)(t + 2) * kstepB;
            const char* a3 = a2 + kstepA; const char* b3 = b2 + kstepB;
            if (last && has_next) S.a_ready(nxt);
            if constexpr (SP2) {
            PG8_LDB(B0, 0, 0); PG8_LDB(B1, 0, 1); PG8_SCHED; PG8_LDA(At, 0, 0); PG8_STAGE(PG8_SA(1, 1), a1 + hstepA, voffA);
            PG8_WAIT_V(8); PG8_WAIT_L(0); PG8_BAR; PG8_MMA(0, 0, At, B0); PG8_MMA(0, 1, At, B1); PG8_BAR; PG8_SCHED;
            PG8_LDA(At, 0, 1); PG8_STAGE(PG8_SB(0, 0), b2, voffB); PG8_STAGE(PG8_SB(0, 1), b2 + hstepB, voffB); PG8_STAGE(PG8_SA(0, 0), a2, voffA);
            PG8_WAIT_V(8); PG8_WAIT_L(0); PG8_BAR; PG8_MMA(1, 0, At, B0); PG8_MMA(1, 1, At, B1); PG8_BAR; PG8_SCHED;
            PG8_LDB(B0, 1, 0); PG8_LDB(B1, 1, 1); PG8_SCHED; PG8_LDA(At, 1, 0); PG8_STAGE(PG8_SA(0, 1), a2 + hstepA, voffA);
            PG8_WAIT_V(8); PG8_WAIT_L(0); PG8_BAR; PG8_MMA(0, 0, At, B0); PG8_MMA(0, 1, At, B1); PG8_BAR; PG8_SCHED;
            PG8_LDA(At, 1, 1); PG8_STAGE(PG8_SB(1, 0), b3, voffB); PG8_STAGE(PG8_SB(1, 1), b3 + hstepB, voffB); PG8_STAGE(PG8_SA(1, 0), a3, voffA);
            PG8_WAIT_V(8); PG8_WAIT_L(0); PG8_BAR; PG8_MMA(1, 0, At, B0); PG8_MMA(1, 1, At, B1); PG8_BAR; PG8_SCHED;
            } else {
            PG8_LDB(B0, 0, 0); PG8_SCHED; PG8_LDA(At, 0, 0); PG8_STAGE(PG8_SA(1, 1), a1 + hstepA, voffA);
            PG8_WAIT_L(8); PG8_BAR; PG8_WAIT_L(0); PG8_MMA(0, 0, At, B0); PG8_BAR; PG8_SCHED;
            PG8_LDB(B1, 0, 1); PG8_STAGE(PG8_SB(0, 0), b2, voffB);
            PG8_BAR; PG8_WAIT_L(0); PG8_MMA(0, 1, At, B1); PG8_BAR;
            PG8_LDA(At, 0, 1); PG8_STAGE(PG8_SA(0, 0), a2, voffA);
            PG8_BAR; PG8_WAIT_L(0); PG8_MMA(1, 0, At, B0); PG8_BAR; PG8_SCHED;
            PG8_STAGE(PG8_SB(0, 1), b2 + hstepB, voffB);
            PG8_WAIT_V(6); PG8_BAR; PG8_MMA(1, 1, At, B1); PG8_BAR;
            PG8_LDB(B0, 1, 0); PG8_SCHED; PG8_LDA(At, 1, 0); PG8_STAGE(PG8_SA(0, 1), a2 + hstepA, voffA);
            PG8_WAIT_L(8); PG8_BAR; PG8_WAIT_L(0); PG8_MMA(0, 0, At, B0); PG8_BAR; PG8_SCHED;
            PG8_LDB(B1, 1, 1); PG8_STAGE(PG8_SB(1, 0), b3, voffB);
            PG8_BAR; PG8_WAIT_L(0); PG8_MMA(0, 1, At, B1); PG8_BAR;
            PG8_LDA(At, 1, 1); PG8_STAGE(PG8_SA(1, 0), a3, voffA);
            PG8_BAR; PG8_WAIT_L(0); PG8_MMA(1, 0, At, B0); PG8_BAR; PG8_SCHED;
            PG8_STAGE(PG8_SB(1, 1), b3 + hstepB, voffB);
            PG8_WAIT_V(6); PG8_BAR; PG8_MMA(1, 1, At, B1); PG8_BAR;
            }
        }
        if constexpr (ALIGN_EPI) { if (wr == 0) PG8_BAR; }
        if constexpr (!Epi::AFTER_DRAIN) { E(acc, cur, ui, 0, 0, 0, lds); S.done(cur); }
        if (!has_next) break;
#pragma unroll
        for (int a = 0; a < 2; ++a)
#pragma unroll
            for (int b = 0; b < 2; ++b)
#pragma unroll
                for (int m = 0; m < 4; ++m)
#pragma unroll
                    for (int n = 0; n < 2; ++n) acc[a][b][m][n] = (f32x4){0.f, 0.f, 0.f, 0.f};
        cur = nxt; cA = nA; cB = nB; ++ui;
        E.stage(cur, lds, ui);
        if constexpr (ALIGN_EPI) { if (wr == 1) PG8_BAR; }
    }
    PG8_WAIT_V(0);
    if constexpr (!ALIGN_EPI) { if (wr == 0) PG8_BAR; }
    PG8_BAR;
    if constexpr (Epi::AFTER_DRAIN) { E.fused(acc, cur, wr, wc, fr, fq, lds, wid, lane); S.done(cur); }
#undef PG8_SA
#undef PG8_SB
#undef PG8_STAGE
#undef PG8_LDA
#undef PG8_LDB
#undef PG8_MMA
#undef PG8_WAIT_V
#undef PG8_WAIT_L
#undef PG8_BAR
#undef PG8_SCHED
}
}
namespace att {
constexpr int DV = 128, NW = 8, QBLK = 32, KVBLK = 64;
constexpr float THR = 8.f;
constexpr size_t SHM_V = KVBLK * DV * 2, SHM_K = KVBLK * DV * 2, SHM_ATTN = 2 * SHM_V + 2 * SHM_K + NW * 64 * 4;
constexpr size_t SHM_ATTN3 = 3 * SHM_V + 3 * SHM_K + NW * 64 * 4;
using s16x4 = __attribute__((ext_vector_type(4))) short;
using f32x16 = __attribute__((ext_vector_type(16))) float;
using f32x2v = __attribute__((ext_vector_type(2))) float;
#ifndef PK_SUM
#define PK_SUM 0
#endif
#define KSWZ(row, colB) ((row) * 256 + ((colB) ^ (((row) & 7) << 4)))
#define SBAR() __builtin_amdgcn_sched_barrier(0)
__device__ __forceinline__ int crow(int r, int hi) { return (r & 3) + 8 * (r >> 2) + 4 * hi; }
__device__ __forceinline__ unsigned cvtpk(float lo, float hi) { unsigned r; asm volatile("v_cvt_pk_bf16_f32 %0, %1, %2" : "=v"(r) : "v"(lo), "v"(hi)); return r; }

template <int DQK>
__device__ __forceinline__ void partialSM(f32x16& p0, f32x16& p1, float& m_reg, float& mn, float& alpha) {
  (void)m_reg; (void)p1; mn = 0.f; alpha = 1.f;
#pragma unroll
  for (int r = 0; r < 16; ++r) p0[r] = __builtin_amdgcn_exp2f(p0[r]);
}
__device__ __forceinline__ void finishSM(f32x16& p0, f32x16& p1, float alpha, float& l_reg, bf16x8& pa0, bf16x8& pa1, bf16x8& pa2, bf16x8& pa3) {
#pragma unroll
  for (int r = 0; r < 16; ++r) p1[r] = __builtin_amdgcn_exp2f(p1[r]);
#if PK_SUM
  f32x2v ps2 = (f32x2v){0.f, 0.f};
#pragma unroll
  for (int r = 0; r < 16; r += 2) ps2 = ps2 + (f32x2v){p0[r], p0[r + 1]};
#pragma unroll
  for (int r = 0; r < 16; r += 2) ps2 = ps2 + (f32x2v){p1[r], p1[r + 1]};
  float ps = ps2[0] + ps2[1];
#else
  float ps = 0;
#pragma unroll
  for (int r = 0; r < 16; ++r) ps += p0[r];
#pragma unroll
  for (int r = 0; r < 16; ++r) ps += p1[r];
#endif
  { auto rr = __builtin_amdgcn_permlane32_swap(__float_as_uint(ps), __float_as_uint(ps), false, false);
    ps = __uint_as_float(rr[0]) + __uint_as_float(rr[1]); }
  l_reg = l_reg * alpha + ps;
#define PK4(P, BASE, OUT) do { unsigned a0 = cvtpk(P[BASE + 0], P[BASE + 1]), a1 = cvtpk(P[BASE + 2], P[BASE + 3]);   \
    unsigned b0 = cvtpk(P[BASE + 4], P[BASE + 5]), b1 = cvtpk(P[BASE + 6], P[BASE + 7]);                              \
    auto r0 = __builtin_amdgcn_permlane32_swap(a0, b0, false, false); auto r1 = __builtin_amdgcn_permlane32_swap(a1, b1, false, false); \
    u32x4 w = {r0[0], r1[0], r0[1], r1[1]}; OUT = *reinterpret_cast<bf16x8*>(&w); } while (0)
  PK4(p0, 0, pa0); PK4(p0, 8, pa1); PK4(p1, 0, pa2); PK4(p1, 8, pa3);
#undef PK4
}
#ifndef QK_PIPE
#define QK_PIPE 0
#endif
template <int OFF> __device__ __forceinline__ bf16x8 lds_rd128(int addr) { bf16x8 r; asm volatile("ds_read_b128 %0, %1 offset:%2" : "=&v"(r) : "v"(addr), "i"(OFF) : "memory"); return r; }
#if QK_PIPE
template <int DQK>
__device__ __forceinline__ void qkt(f32x16& p0, f32x16& p1, const char* Ks, const bf16x8* qr, int r32, int hi, int koffB) {
  p0 = f32x16{}; p1 = f32x16{};
  constexpr int N = DQK / 16;
  const int A0 = (int)(uintptr_t)Ks + koffB + r32 * 256 + ((hi * 16) ^ ((r32 & 7) << 4));
  bf16x8 k0[2], k1[2];
  k0[0] = lds_rd128<0>(A0); k1[0] = lds_rd128<8192>(A0);
  k0[1] = lds_rd128<0>(A0 ^ 32); k1[1] = lds_rd128<8192>(A0 ^ 32);
#pragma unroll
  for (int d0 = 0; d0 < N; ++d0) { const int b = d0 & 1;
    if (d0 + 1 < N) asm volatile("s_waitcnt lgkmcnt(2)" : "+v"(k0[b]), "+v"(k1[b]) :: "memory"); else asm volatile("s_waitcnt lgkmcnt(0)" : "+v"(k0[b]), "+v"(k1[b]) :: "memory");
    p0 = __builtin_amdgcn_mfma_f32_32x32x16_bf16(k0[b], qr[d0], p0, 0, 0, 0);
    p1 = __builtin_amdgcn_mfma_f32_32x32x16_bf16(k1[b], qr[d0], p1, 0, 0, 0);
    if (d0 + 2 < N) { const int a = A0 ^ ((d0 + 2) << 5); k0[b] = lds_rd128<0>(a); k1[b] = lds_rd128<8192>(a); } }
}
#else
template <int DQK>
__device__ __forceinline__ void qkt(f32x16& p0, f32x16& p1, const char* Ks, const bf16x8* qr, int r32, int hi, int koffB) {
  p0 = f32x16{}; p1 = f32x16{};
  Ks += koffB;
#pragma unroll
  for (int d0 = 0; d0 < DQK / 16; ++d0) { int cb = (d0 * 16 + hi * 8) * 2;
    bf16x8 b0 = *reinterpret_cast<const bf16x8*>(Ks + KSWZ(r32, cb));
    bf16x8 b1 = *reinterpret_cast<const bf16x8*>(Ks + KSWZ(32 + r32, cb));
    p0 = __builtin_amdgcn_mfma_f32_32x32x16_bf16(b0, qr[d0], p0, 0, 0, 0);
    p1 = __builtin_amdgcn_mfma_f32_32x32x16_bf16(b1, qr[d0], p1, 0, 0, 0); }
}
#endif
__device__ __forceinline__ int v_st(int k, int c) { const int kk = (k & ~0xC) | ((k & 4) << 1) | ((k & 8) >> 1); return ((kk >> 3) * 4 + (c >> 5)) * 512 + ((kk & 7) * 32 + (c & 31)) * 2; }
__device__ __forceinline__ int v_rd_base(int lane) { return ((lane & 3) << 3) | (((lane >> 2) & 3) << 6) | (((lane >> 4) & 1) << 5) | (((lane >> 5) & 1) << 8); }
constexpr int v_rd_off(int d0, int ks, int half) { return d0 * 512 + ks * 4096 + half * 2048; }
template <int OFF> __device__ __forceinline__ s16x4 tr_read(int vb) {
  s16x4 r; asm volatile("ds_read_b64_tr_b16 %0, %1 offset:%2" : "=&v"(r) : "v"(vb), "i"(OFF) : "memory"); return r;
}
template <int D0> __device__ __forceinline__ void pv_one(f32x16& od, int vb, bf16x8 pa0, bf16x8 pa1, bf16x8 pa2, bf16x8 pa3) {
  const s16x4 l0 = tr_read<v_rd_off(D0, 0, 0)>(vb), h0 = tr_read<v_rd_off(D0, 0, 1)>(vb), l1 = tr_read<v_rd_off(D0, 1, 0)>(vb), h1 = tr_read<v_rd_off(D0, 1, 1)>(vb);
  const s16x4 l2 = tr_read<v_rd_off(D0, 2, 0)>(vb), h2 = tr_read<v_rd_off(D0, 2, 1)>(vb), l3 = tr_read<v_rd_off(D0, 3, 0)>(vb), h3 = tr_read<v_rd_off(D0, 3, 1)>(vb);
  asm volatile("s_waitcnt lgkmcnt(0)" ::: "memory"); SBAR();
#define PK(L, H) (bf16x8){L[0], L[1], L[2], L[3], H[0], H[1], H[2], H[3]}
  od = __builtin_amdgcn_mfma_f32_32x32x16_bf16(pa0, PK(l0, h0), od, 0, 0, 0);
  od = __builtin_amdgcn_mfma_f32_32x32x16_bf16(pa1, PK(l1, h1), od, 0, 0, 0);
  od = __builtin_amdgcn_mfma_f32_32x32x16_bf16(pa2, PK(l2, h2), od, 0, 0, 0);
  od = __builtin_amdgcn_mfma_f32_32x32x16_bf16(pa3, PK(l3, h3), od, 0, 0, 0);
#undef PK
}
#ifndef ATT_PRO2
#define ATT_PRO2 0
#endif
#ifndef HALF_K_STAGE
#define HALF_K_STAGE 1
#endif
#ifndef ATT_PRIO
#define ATT_PRIO 0
#endif
#ifndef PV_EXPN
#define PV_EXPN 0
#endif
#ifndef PV_PIPE
#define PV_PIPE 1
#endif
#if PV_PIPE
template <bool EXPN>
__device__ __forceinline__ void pv_d0x(f32x16* o, int vb, bf16x8 pa0, bf16x8 pa1, bf16x8 pa2, bf16x8 pa3, f32x16& pn) {
#define EX4(G) do { if (EXPN) { _Pragma("unroll") for (int r = 4 * (G); r < 4 * (G) + 4; ++r) pn[r] = __builtin_amdgcn_exp2f(pn[r]); } } while (0)
#define RD8(D0, R) do { R[0] = tr_read<v_rd_off(D0, 0, 0)>(vb); R[1] = tr_read<v_rd_off(D0, 0, 1)>(vb); R[2] = tr_read<v_rd_off(D0, 1, 0)>(vb); R[3] = tr_read<v_rd_off(D0, 1, 1)>(vb); \
    R[4] = tr_read<v_rd_off(D0, 2, 0)>(vb); R[5] = tr_read<v_rd_off(D0, 2, 1)>(vb); R[6] = tr_read<v_rd_off(D0, 3, 0)>(vb); R[7] = tr_read<v_rd_off(D0, 3, 1)>(vb); } while (0)
#define PK(L, H) (bf16x8){L[0], L[1], L[2], L[3], H[0], H[1], H[2], H[3]}
#define MM4(O, R) do { if (ATT_PRIO) __builtin_amdgcn_s_setprio(1); O = __builtin_amdgcn_mfma_f32_32x32x16_bf16(pa0, PK(R[0], R[1]), O, 0, 0, 0); O = __builtin_amdgcn_mfma_f32_32x32x16_bf16(pa1, PK(R[2], R[3]), O, 0, 0, 0); \
    O = __builtin_amdgcn_mfma_f32_32x32x16_bf16(pa2, PK(R[4], R[5]), O, 0, 0, 0); O = __builtin_amdgcn_mfma_f32_32x32x16_bf16(pa3, PK(R[6], R[7]), O, 0, 0, 0); if (ATT_PRIO) __builtin_amdgcn_s_setprio(0); } while (0)
  s16x4 ra[8], rb[8], rc[8], rd[8];
  RD8(0, ra); RD8(1, rb);
  asm volatile("s_waitcnt lgkmcnt(8)" ::: "memory"); SBAR(); MM4(o[0], ra); RD8(2, rc); EX4(0);
  asm volatile("s_waitcnt lgkmcnt(8)" ::: "memory"); SBAR(); MM4(o[1], rb); RD8(3, rd); EX4(1);
  asm volatile("s_waitcnt lgkmcnt(8)" ::: "memory"); SBAR(); MM4(o[2], rc); EX4(2);
  asm volatile("s_waitcnt lgkmcnt(0)" ::: "memory"); SBAR(); MM4(o[3], rd); EX4(3);
#undef RD8
#undef PK
#undef MM4
#undef EX4
}
__device__ __forceinline__ void pv_d0(f32x16* o, int vb, bf16x8 pa0, bf16x8 pa1, bf16x8 pa2, bf16x8 pa3) { f32x16 dummy; pv_d0x<false>(o, vb, pa0, pa1, pa2, pa3, dummy); }
#else
__device__ __forceinline__ void pv_d0(f32x16* o, int vb, bf16x8 pa0, bf16x8 pa1, bf16x8 pa2, bf16x8 pa3) {
  pv_one<0>(o[0], vb, pa0, pa1, pa2, pa3); pv_one<1>(o[1], vb, pa0, pa1, pa2, pa3); pv_one<2>(o[2], vb, pa0, pa1, pa2, pa3); pv_one<3>(o[3], vb, pa0, pa1, pa2, pa3);
}
#endif
template <int DQK, int LDQ, int LDK>
__device__ __forceinline__ void body(const bf16_t* __restrict__ Qb, const bf16_t* __restrict__ Kh, const bf16_t* __restrict__ Vh, int seq, int koffB, char* lds, f32x16 (&o)[4], float (&rli)[16]) {
  int tid = threadIdx.x; asm volatile("" : "+v"(tid));
  const int wid = tid >> 6, lane = tid & 63, r32 = lane & 31, hi = lane >> 5;
  char* V_lds = lds; char* K_lds = lds + 2 * SHM_V;
  float* ws = (float*)(lds + 2 * SHM_V + 2 * SHM_K) + wid * 64; float* li_l = ws;
  float m_reg = -1e30f, l_reg = 0;
#pragma unroll
  for (int d = 0; d < 4; ++d) o[d] = f32x16{};
  bf16x8 qr[DQK / 16];
  const bf16_t* Qw = Qb + (long)(wid * QBLK + r32) * LDQ + hi * 8;
#pragma unroll
  for (int d0 = 0; d0 < DQK / 16; ++d0) qr[d0] = *reinterpret_cast<const bf16x8*>(Qw + d0 * 16);
  const int sr = tid >> 4, sc = (tid & 15) * 8, vst0 = v_st(sr, sc), vst1 = v_st(32 + sr, sc);
  constexpr bool HALFK = (DQK == 64) && HALF_K_STAGE; const int kr_ = tid >> 3, kcB_ = koffB + (tid & 7) * 16, kcE_ = kcB_ >> 1; (void)kr_; (void)kcB_; (void)kcE_;
  const int vb0 = (int)(uintptr_t)V_lds + v_rd_base(lane);
  bf16x8 sv0a, sv1a, sk0a, sk1a, sv0b, sv1b, sk0b, sk1b;
#define KLOADS(k0, K0, K1) do { if constexpr (HALFK) { K0 = *(const bf16x8*)&Kh[(long)((k0) + kr_) * LDK + kcE_]; } \
    else { K0 = *(const bf16x8*)&Kh[(long)((k0) + sr) * LDK + sc]; K1 = *(const bf16x8*)&Kh[(long)((k0) + 32 + sr) * LDK + sc]; } } while (0)
#define SLOAD_A(k0) do { sv0a = *(const bf16x8*)&Vh[(long)((k0) + sr) * LDK + sc]; sv1a = *(const bf16x8*)&Vh[(long)((k0) + 32 + sr) * LDK + sc]; KLOADS(k0, sk0a, sk1a); } while (0)
#define SLOAD_B(k0) do { sv0b = *(const bf16x8*)&Vh[(long)((k0) + sr) * LDK + sc]; sv1b = *(const bf16x8*)&Vh[(long)((k0) + 32 + sr) * LDK + sc]; KLOADS(k0, sk0b, sk1b); } while (0)
#define SWRITE(b, V0, V1, K0, K1) do { *(bf16x8*)(V_lds + (b) * SHM_V + vst0) = V0; *(bf16x8*)(V_lds + (b) * SHM_V + vst1) = V1; const int kc = sc * 2; \
    if constexpr (HALFK) { *(bf16x8*)(K_lds + (b) * SHM_K + KSWZ(kr_, kcB_)) = K0; } \
    else { *(bf16x8*)(K_lds + (b) * SHM_K + KSWZ(sr, kc)) = K0; *(bf16x8*)(K_lds + (b) * SHM_K + KSWZ(32 + sr, kc)) = K1; } } while (0)
#define SWAIT() do { if constexpr (HALFK) asm volatile("s_waitcnt vmcnt(3)" ::: "memory"); else asm volatile("s_waitcnt vmcnt(4)" ::: "memory"); } while (0)
#define RESC(a) do { (void)(a); } while (0)
#if PV_PIPE && PV_EXPN
#define PVSM(VB, P0, P1, MN, AL) do { pv_d0x<true>(o, VB, pa0, pa1, pa2, pa3, P0); MN = 0.f; AL = 1.f; } while (0)
#else
#define PVSM(VB, P0, P1, MN, AL) do { pv_d0(o, VB, pa0, pa1, pa2, pa3); partialSM<DQK>(P0, P1, m_reg, MN, AL); } while (0)
#endif
  f32x16 pA0, pA1, pB0, pB1; float mnA, mnB, alA, alB; bf16x8 pa0, pa1, pa2, pa3; const int NT = seq / KVBLK;
#if ATT_PRO2
  SLOAD_A(0); SLOAD_B(KVBLK); SWAIT(); SWRITE(0, sv0a, sv1a, sk0a, sk1a); __syncthreads();
  if (2 < NT) SLOAD_A(2 * KVBLK);
  qkt<DQK>(pA0, pA1, K_lds, qr, r32, hi, koffB); partialSM<DQK>(pA0, pA1, m_reg, mnA, alA);
  SWAIT(); SWRITE(1, sv0b, sv1b, sk0b, sk1b); __syncthreads();
#else
  SLOAD_A(0); asm volatile("s_waitcnt vmcnt(0)" ::: "memory"); SWRITE(0, sv0a, sv1a, sk0a, sk1a); __syncthreads();
  qkt<DQK>(pA0, pA1, K_lds, qr, r32, hi, koffB); partialSM<DQK>(pA0, pA1, m_reg, mnA, alA);
  SLOAD_B(KVBLK); if (2 < NT) SLOAD_A(2 * KVBLK);
  SWAIT(); SWRITE(1, sv0b, sv1b, sk0b, sk1b); __syncthreads();
#endif
  for (int j = 1; j + 1 < NT; j += 2) {
    SBAR(); qkt<DQK>(pB0, pB1, K_lds + SHM_K, qr, r32, hi, koffB);
    finishSM(pA0, pA1, alA, l_reg, pa0, pa1, pa2, pa3); SBAR();
    SLOAD_B((j + 2) * KVBLK); SBAR();
    PVSM(vb0, pB0, pB1, mnB, alB);
    __syncthreads(); SWAIT(); SWRITE(0, sv0a, sv1a, sk0a, sk1a);
    RESC(alB); __syncthreads();
    SBAR(); qkt<DQK>(pA0, pA1, K_lds, qr, r32, hi, koffB);
    finishSM(pB0, pB1, alB, l_reg, pa0, pa1, pa2, pa3); SBAR();
    if (j + 3 < NT) SLOAD_A((j + 3) * KVBLK); SBAR();
    PVSM(vb0 + (int)SHM_V, pA0, pA1, mnA, alA);
    __syncthreads(); SWAIT(); SWRITE(1, sv0b, sv1b, sk0b, sk1b);
    RESC(alA); __syncthreads();
  }
  SBAR(); qkt<DQK>(pB0, pB1, K_lds + SHM_K, qr, r32, hi, koffB);
  finishSM(pA0, pA1, alA, l_reg, pa0, pa1, pa2, pa3); SBAR();
  PVSM(vb0, pB0, pB1, mnB, alB);
  __syncthreads(); RESC(alB);
  finishSM(pB0, pB1, alB, l_reg, pa0, pa1, pa2, pa3); SBAR();
  pv_d0(o, vb0 + (int)SHM_V, pa0, pa1, pa2, pa3);
  if (hi == 0) li_l[r32] = l_reg; asm volatile("s_waitcnt lgkmcnt(0)" ::: "memory");
#pragma unroll
  for (int r = 0; r < 16; ++r) rli[r] = __builtin_amdgcn_rcpf(li_l[crow(r, hi)]);
  __syncthreads();
#undef PVSM
#undef KLOADS
#undef SLOAD_A
#undef SLOAD_B
#undef SWRITE
#undef SWAIT
#undef RESC
}
template <int DQK, int LDQ, int LDK>
__device__ __forceinline__ void body3(const bf16_t* __restrict__ Qb, const bf16_t* __restrict__ Kh, const bf16_t* __restrict__ Vh, int seq, int koffB, char* lds, f32x16 (&o)[4], float (&rli)[16]) {
  int tid = threadIdx.x; asm volatile("" : "+v"(tid));
  const int wid = tid >> 6, lane = tid & 63, r32 = lane & 31, hi = lane >> 5;
  char* V_lds = lds; char* K_lds = lds + 3 * SHM_V;
  float* ws = (float*)(lds + 3 * SHM_V + 3 * SHM_K) + wid * 64; float* li_l = ws;
  float m_reg = -1e30f, l_reg = 0;
#pragma unroll
  for (int d = 0; d < 4; ++d) o[d] = f32x16{};
  bf16x8 qr[DQK / 16];
  const bf16_t* Qw = Qb + (long)(wid * QBLK + r32) * LDQ + hi * 8;
#pragma unroll
  for (int d0 = 0; d0 < DQK / 16; ++d0) qr[d0] = *reinterpret_cast<const bf16x8*>(Qw + d0 * 16);
  const int sr = tid >> 4, sc = (tid & 15) * 8, vst0 = v_st(sr, sc), vst1 = v_st(32 + sr, sc);
  const int vb0 = (int)(uintptr_t)V_lds + v_rd_base(lane);
  bf16x8 sv0a, sv1a, sk0a, sk1a, sv0b, sv1b, sk0b, sk1b;
#define SLOAD_A(k0) do { sv0a = *(const bf16x8*)&Vh[(long)((k0) + sr) * LDK + sc]; sv1a = *(const bf16x8*)&Vh[(long)((k0) + 32 + sr) * LDK + sc]; \
    sk0a = *(const bf16x8*)&Kh[(long)((k0) + sr) * LDK + sc]; sk1a = *(const bf16x8*)&Kh[(long)((k0) + 32 + sr) * LDK + sc]; } while (0)
#define SLOAD_B(k0) do { sv0b = *(const bf16x8*)&Vh[(long)((k0) + sr) * LDK + sc]; sv1b = *(const bf16x8*)&Vh[(long)((k0) + 32 + sr) * LDK + sc]; \
    sk0b = *(const bf16x8*)&Kh[(long)((k0) + sr) * LDK + sc]; sk1b = *(const bf16x8*)&Kh[(long)((k0) + 32 + sr) * LDK + sc]; } while (0)
#define SWRITE(bo, V0, V1, K0, K1) do { *(bf16x8*)(V_lds + (bo) + vst0) = V0; *(bf16x8*)(V_lds + (bo) + vst1) = V1; const int kc = sc * 2; \
    *(bf16x8*)(K_lds + (bo) + KSWZ(sr, kc)) = K0; *(bf16x8*)(K_lds + (bo) + KSWZ(32 + sr, kc)) = K1; } while (0)
#define SWAIT() asm volatile("s_waitcnt vmcnt(4)" ::: "memory")
#define RESC(a) do { (void)(a); } while (0)
#if PV_PIPE && PV_EXPN
#define PVSM(VB, P0, P1, MN, AL) do { pv_d0x<true>(o, VB, pa0, pa1, pa2, pa3, P0); MN = 0.f; AL = 1.f; } while (0)
#else
#define PVSM(VB, P0, P1, MN, AL) do { pv_d0(o, VB, pa0, pa1, pa2, pa3); partialSM<DQK>(P0, P1, m_reg, MN, AL); } while (0)
#endif
  f32x16 pA0, pA1, pB0, pB1; float mnA, mnB, alA, alB; bf16x8 pa0, pa1, pa2, pa3; const int NT = seq / KVBLK;
  SLOAD_A(0); asm volatile("s_waitcnt vmcnt(0)" ::: "memory"); SWRITE(0, sv0a, sv1a, sk0a, sk1a); __syncthreads();
  qkt<DQK>(pA0, pA1, K_lds, qr, r32, hi, koffB); partialSM<DQK>(pA0, pA1, m_reg, mnA, alA);
  SLOAD_B(KVBLK); if (2 < NT) SLOAD_A(2 * KVBLK);
  SWAIT(); SWRITE((int)SHM_V, sv0b, sv1b, sk0b, sk1b); __syncthreads();
  int oP = 0, oC = (int)SHM_V, oN = 2 * (int)SHM_V;
  for (int t = 1; t + 1 < NT; t += 2) {
    SBAR(); qkt<DQK>(pB0, pB1, K_lds + oC, qr, r32, hi, koffB);
    finishSM(pA0, pA1, alA, l_reg, pa0, pa1, pa2, pa3); SBAR();
    SLOAD_B((t + 2) * KVBLK); SBAR();
    PVSM(vb0 + oP, pB0, pB1, mnB, alB);
    SWAIT(); SWRITE(oN, sv0a, sv1a, sk0a, sk1a);
    __syncthreads();
    SBAR(); qkt<DQK>(pA0, pA1, K_lds + oN, qr, r32, hi, koffB);
    finishSM(pB0, pB1, alB, l_reg, pa0, pa1, pa2, pa3); SBAR();
    if (t + 3 < NT) SLOAD_A((t + 3) * KVBLK); SBAR();
    PVSM(vb0 + oC, pA0, pA1, mnA, alA);
    SWAIT(); SWRITE(oP, sv0b, sv1b, sk0b, sk1b);
    __syncthreads();
    { const int r_ = oP; oP = oN; oN = oC; oC = r_; }
  }
  SBAR(); qkt<DQK>(pB0, pB1, K_lds + oC, qr, r32, hi, koffB);
  finishSM(pA0, pA1, alA, l_reg, pa0, pa1, pa2, pa3); SBAR();
  PVSM(vb0 + oP, pB0, pB1, mnB, alB);
  finishSM(pB0, pB1, alB, l_reg, pa0, pa1, pa2, pa3); SBAR();
  pv_d0(o, vb0 + oC, pa0, pa1, pa2, pa3);
  if (hi == 0) li_l[r32] = l_reg; asm volatile("s_waitcnt lgkmcnt(0)" ::: "memory");
#pragma unroll
  for (int r = 0; r < 16; ++r) rli[r] = __builtin_amdgcn_rcpf(li_l[crow(r, hi)]);
  __syncthreads();
#undef PVSM
#undef SLOAD_A
#undef SLOAD_B
#undef SWRITE
#undef SWAIT
#undef RESC
}
#undef KSWZ
#undef SBAR
}
#define GAS __attribute__((address_space(1)))
#define LAS __attribute__((address_space(3)))
typedef GAS unsigned gu32;
#define RLX_AGENT __ATOMIC_RELAXED, __HIP_MEMORY_SCOPE_AGENT
#define XB_TMO      128
#define XB_XCNT(j)  (256  + 64 * (j))
#define XB_XSUB(j)  (1280 + 64 * (j))
#define XB_XGEN(j)  (2304 + 64 * (j))
#define XB_TOP      3328
#define XB_TOPGEN   3392
#define XCD_BAR_WORDS 3456
#define XB_SPIN_CAP (1u << 18)

__device__ __forceinline__ unsigned xb_ld(unsigned* p)              { return __hip_atomic_load(p, __ATOMIC_RELAXED, __HIP_MEMORY_SCOPE_AGENT); }
__device__ __forceinline__ unsigned xb_add(unsigned* p, unsigned v) { return __hip_atomic_fetch_add(p, v, __ATOMIC_RELAXED, __HIP_MEMORY_SCOPE_AGENT); }
__device__ __forceinline__ unsigned xb_xcc_id() { return (unsigned)__builtin_amdgcn_s_getreg((3 << 11) | 20) & 0xFu; }
#define XB_SPIN(cond, bar) do { unsigned _sp = 0; while (cond) { __builtin_amdgcn_s_sleep(1); \
    if ((++_sp & 255u) == 0u) { if (xb_ld(&(bar)[XB_TMO])) break; if (_sp > XB_SPIN_CAP) { atomicAdd(&(bar)[XB_TMO], 1u); break; } } } } while (0)

struct XcdBarrier {
    unsigned* bar; unsigned x;
    volatile LAS unsigned* st;
};

__device__ __forceinline__ XcdBarrier xcd_barrier_post(unsigned* bar, volatile LAS unsigned* st) {
    XcdBarrier b; b.bar = bar; b.x = xb_xcc_id(); b.st = st;
    if (threadIdx.x == 0) (void)xb_add(&bar[XB_XCNT(b.x)], 1u);
    return b;
}
__device__ __forceinline__ void xcd_barrier_complete(unsigned* bar, unsigned x, unsigned& nloc, unsigned& nx) {
    const unsigned G = gridDim.x * gridDim.y * gridDim.z;
    unsigned sum, cnt, mine, sp = 0u;
    for (;;) {
        sum = 0u; cnt = 0u; mine = 0u;
#pragma unroll
        for (unsigned j = 0; j < 16; ++j) { const unsigned c = xb_ld(&bar[XB_XCNT(j)]); sum += c; cnt += (c > 0u) ? 1u : 0u; mine = (j == x) ? c : mine; }
        if (sum == G) break;
        __builtin_amdgcn_s_sleep(1);
        if ((++sp & 255u) == 0u) { if (xb_ld(&bar[XB_TMO])) break; if (sp > XB_SPIN_CAP) { atomicAdd(&bar[XB_TMO], 1u); break; } }
    }
    nloc = mine > 0u ? mine : 1u; nx = cnt > 0u ? cnt : 1u;
}

__device__ __forceinline__ void xcd_barrier(const XcdBarrier& b) {
    asm volatile("s_waitcnt vmcnt(0)" ::: "memory");
    __syncthreads();
    if (threadIdx.x == 0) {
        unsigned* bar = b.bar;
        __builtin_amdgcn_s_waitcnt(0);
        unsigned nloc = b.st[0], nx = b.st[1];
        if (nloc == 0u) { xcd_barrier_complete(bar, b.x, nloc, nx); b.st[0] = nloc; b.st[1] = nx; }
        const unsigned old = xb_add(&bar[XB_XSUB(b.x)], 1u);
        const unsigned gen = old / nloc;
        if (old + 1u == (gen + 1u) * nloc) {
            __builtin_amdgcn_fence(__ATOMIC_RELEASE, "agent");
            asm volatile("s_waitcnt vmcnt(0)" ::: "memory");
            const unsigned og = xb_add(&bar[XB_TOP], 1u);
            const unsigned tg = og / nx;
            if (og + 1u == (tg + 1u) * nx) xb_add(&bar[XB_TOPGEN], 1u);
            else XB_SPIN(xb_ld(&bar[XB_TOPGEN]) == tg, bar);
            __builtin_amdgcn_fence(__ATOMIC_ACQUIRE, "agent");
            xb_add(&bar[XB_XGEN(b.x)], 1u);
            asm volatile("s_waitcnt vmcnt(0)" ::: "memory");
        } else {
            XB_SPIN(xb_ld(&bar[XB_XGEN(b.x)]) == gen, bar);
            __builtin_amdgcn_fence(__ATOMIC_ACQUIRE, "agent");
            asm volatile("s_waitcnt vmcnt(0)" ::: "memory");
        }
    }
    __syncthreads();
}

#ifndef DUP_MASK
#define DUP_MASK 0
#endif
#ifndef PROLOGUE_IN_KERNEL
#define PROLOGUE_IN_KERNEL 1
#endif
#ifndef MIX_PARTS
#define MIX_PARTS 7
#endif
#ifndef PH_MASK
#define PH_MASK 0x7f
#endif
constexpr int NWAVES = 8;
constexpr int RING_BYTES = 131072;
constexpr int PTAB_OFF = RING_BYTES;
constexpr int MISC_OFF = PTAB_OFF + 8192;
constexpr int LDS_BYTES = 159744;
static_assert(pg8::STAGE_BYTES == RING_BYTES && MISC_OFF + 128 <= pg8::EPIX_OFF && pg8::EPIX_END <= LDS_BYTES && (int)att::SHM_ATTN <= RING_BYTES, "LDS map");
constexpr int CW_YCNT = 1024;
constexpr int CW_TMO = 64;
constexpr int CW_FLAG = 16384;
constexpr int CW_BAR = 4096;
constexpr int N_PHASES = 3 + 5 * DEPTH;

struct MegaArgs { const float* in[26]; float* out; unsigned char* ws; int ph_lo, ph_hi, pad0, pad1; };

__device__ __forceinline__ void stage_o_bf16(const att::f32x16 (&o)[4], const float (&rli)[16], bf16_t* wst, int r32, int hi) {
#pragma unroll
    for (int r = 0; r < 16; ++r) { const int orow = att::crow(r, hi);
#pragma unroll
        for (int d0 = 0; d0 < 4; ++d0) wst[orow * 128 + d0 * 32 + r32] = (bf16_t)f2bf(o[d0][r] * rli[r]); }
}
#ifndef ATT_A3
#define ATT_A3 0
#endif
static_assert((int)att::SHM_ATTN3 <= RING_BYTES, "LDS map");
__device__ __forceinline__ void attn_a_unit(const Ptrs& P, size_t row0, const bf16_t* Kb, const bf16_t* Vb, int seq, int h, char* lds) {
    att::f32x16 o[4]; float rli[16];
#if ATT_A3
    att::body3<128, 1024, 256>(P.QA + row0 * 1024 + h * 128, Kb + (h >> 2) * 128, Vb + (h >> 2) * 128, seq, 0, lds, o, rli);
#else
    att::body<128, 1024, 256>(P.QA + row0 * 1024 + h * 128, Kb + (h >> 2) * 128, Vb + (h >> 2) * 128, seq, 0, lds, o, rli);
#endif
    int tid = threadIdx.x; asm volatile("" : "+v"(tid));
    const int wid = tid >> 6, lane = tid & 63, r32 = lane & 31, hi = lane >> 5;
    bf16_t* wst = (bf16_t*)(lds + wid * 8192);
    stage_o_bf16(o, rli, wst, r32, hi);
    bf16_t* ob = P.MIX + (row0 + wid * 32) * D + h * 128;
#pragma unroll
    for (int i = 0; i < 8; ++i) { const int id = lane + 64 * i, row = id >> 4, ch = id & 15; *(u32x4*)(ob + (size_t)row * D + ch * 8) = *(const u32x4*)(wst + row * 128 + ch * 8); }
    __syncthreads();
}
__device__ __forceinline__ void attn_b_unit(const Ptrs& P, size_t row0, const bf16_t* Kb, const bf16_t* Vb, int seq, int h, int l, char* lds) {
#pragma unroll 1
    for (int c = 0; c < 2; ++c) {
        att::f32x16 o[4]; float rli[16];
        att::body<64, 512, 512>(P.QB + row0 * 512 + h * 128 + c * 64, Kb + h * 128, Vb + h * 128, seq, c * 128, lds, o, rli);
        int tid = threadIdx.x; asm volatile("" : "+v"(tid));
        const int wid = tid >> 6, lane = tid & 63, r32 = lane & 31, hi = lane >> 5;
        stage_o_bf16(o, rli, (bf16_t*)(lds + (c == 0 ? (int)att::SHM_ATTN : 0) + wid * 8192), r32, hi);
    }
    {   int tid = threadIdx.x; asm volatile("" : "+v"(tid));
        const int wid = tid >> 6, lane = tid & 63, sub = lane >> 4, ch = lane & 15;
        const bf16_t* w1 = (const bf16_t*)(lds + att::SHM_ATTN + wid * 8192); const bf16_t* w2 = (const bf16_t*)(lds + wid * 8192);
        const float lam = P.LAM[l]; const float post = 1.0f - lambda_init_of(l);
        const f32x4 g0 = *(const f32x4*)(P.subln + l * 128 + ch * 8), g1 = *(const f32x4*)(P.subln + l * 128 + ch * 8 + 4);
        bf16_t* ob = P.MIX + (row0 + wid * 32) * D + 1024 + h * 128 + ch * 8;
#pragma unroll
        for (int i = 0; i < 8; ++i) { const int row = i * 4 + sub;
            const u32x4 a = *(const u32x4*)(w1 + row * 128 + ch * 8), b = *(const u32x4*)(w2 + row * 128 + ch * 8);
            f32x4 v0, v1;
            v0[0] = __builtin_bit_cast(float, a.x << 16) - lam * __builtin_bit_cast(float, b.x << 16); v0[1] = __builtin_bit_cast(float, a.x & 0xffff0000u) - lam * __builtin_bit_cast(float, b.x & 0xffff0000u);
            v0[2] = __builtin_bit_cast(float, a.y << 16) - lam * __builtin_bit_cast(float, b.y << 16); v0[3] = __builtin_bit_cast(float, a.y & 0xffff0000u) - lam * __builtin_bit_cast(float, b.y & 0xffff0000u);
            v1[0] = __builtin_bit_cast(float, a.z << 16) - lam * __builtin_bit_cast(float, b.z << 16); v1[1] = __builtin_bit_cast(float, a.z & 0xffff0000u) - lam * __builtin_bit_cast(float, b.z & 0xffff0000u);
            v1[2] = __builtin_bit_cast(float, a.w << 16) - lam * __builtin_bit_cast(float, b.w << 16); v1[3] = __builtin_bit_cast(float, a.w & 0xffff0000u) - lam * __builtin_bit_cast(float, b.w & 0xffff0000u);
            float s = (v0[0] * v0[0] + v0[1] * v0[1]) + (v0[2] * v0[2] + v0[3] * v0[3]) + (v1[0] * v1[0] + v1[1] * v1[1]) + (v1[2] * v1[2] + v1[3] * v1[3]);
            s += __shfl_xor(s, 1); s += __shfl_xor(s, 2); s += __shfl_xor(s, 4); s += __shfl_xor(s, 8);
            const float rinv = __builtin_amdgcn_rsqf(s * (1.0f / 128.0f) + EPS) * post;
            v0 = v0 * rinv * g0; v1 = v1 * rinv * g1;
            *(u32x4*)(ob + (size_t)row * D) = (u32x4){pk2(v0[0], v0[1]), pk2(v0[2], v0[3]), pk2(v1[0], v1[1]), pk2(v1[2], v1[3])}; }
    }
    __syncthreads();
}

__device__ __forceinline__ void x0_row(const float* __restrict__ xrow, const float* __restrict__ g, const float* __restrict__ scale, bf16_t* __restrict__ xa0, int row, float* __restrict__ ssrow, int lane) {
    f32x4 v[8]; float ss = 0.f;
#pragma unroll
    for (int j = 0; j < 8; ++j) { v[j] = *(const f32x4*)(xrow + lane * 4 + 256 * j); ss += (v[j][0] * v[j][0] + v[j][1] * v[j][1]) + (v[j][2] * v[j][2] + v[j][3] * v[j][3]); }
    ss = wave_sum(ss); if (lane < 8) ssrow[lane] = (lane == 0) ? ss : 0.f;
#pragma unroll
    for (int j = 0; j < 8; ++j) { const int c = lane * 4 + 256 * j; const f32x4 o = v[j] * (*(const f32x4*)(g + c)) * (*(const f32x4*)(scale + c) + 1.0f);
        *(u32x2*)(XA_BLOCKED ? xa0 + ((size_t)(c >> 6) * M_ALL + row) * 64 + (c & 63) : xa0 + (size_t)row * D + c) = (u32x2){pk2(o[0], o[1]), pk2(o[2], o[3])}; }
}
struct BiasRaw { u32x4 q[4]; };
__device__ __forceinline__ BiasRaw bias_row_load(const bf16_t* __restrict__ btrow, int lane) { BiasRaw r;
#pragma unroll
    for (int j = 0; j < 4; ++j) r.q[j] = *(const u32x4*)(btrow + lane * 8 + 512 * j);
    return r; }
__device__ __forceinline__ void bias_row_fin(const BiasRaw& raw, const float* sh, float* __restrict__ bias_r, int bias_stride, int lane) {
    f32x4 wl[4], wh[4];
#pragma unroll
    for (int j = 0; j < 4; ++j) { const u32x4 q = raw.q[j];
        wl[j] = (f32x4){__builtin_bit_cast(float, q.x << 16), __builtin_bit_cast(float, q.x & 0xffff0000u), __builtin_bit_cast(float, q.y << 16), __builtin_bit_cast(float, q.y & 0xffff0000u)};
        wh[j] = (f32x4){__builtin_bit_cast(float, q.z << 16), __builtin_bit_cast(float, q.z & 0xffff0000u), __builtin_bit_cast(float, q.w << 16), __builtin_bit_cast(float, q.w & 0xffff0000u)}; }
#pragma unroll 1
    for (int c = 0; c < NCOND; ++c) { f32x4 s4 = (f32x4){0.f, 0.f, 0.f, 0.f};
#pragma unroll
        for (int j = 0; j < 4; ++j) { const f32x4 a = *(const f32x4*)(sh + c * D + lane * 8 + 512 * j), b = *(const f32x4*)(sh + c * D + lane * 8 + 512 * j + 4); s4 = s4 + wl[j] * a + wh[j] * b; }
        float s = wave_sum((s4[0] + s4[1]) + (s4[2] + s4[3])); if (lane == 0) bias_r[(size_t)c * bias_stride] = s; }
}
__device__ __forceinline__ void bias_row(const bf16_t* __restrict__ btrow, const float* sh, float* __restrict__ bias_r, int bias_stride, int lane) { bias_row_fin(bias_row_load(btrow, lane), sh, bias_r, bias_stride, lane); }

__global__ void __launch_bounds__(NWAVES * 64, 2) mega(MegaArgs args) {
    extern __shared__ __attribute__((aligned(16))) unsigned char lds[];
    LAS unsigned char* L = (LAS unsigned char*)lds;
    volatile LAS unsigned* MISC = (volatile LAS unsigned*)(L + MISC_OFF);
    const int G = gridDim.x, bx = blockIdx.x;
    gu32* ctl = (gu32*)(args.ws + WS_CTL);
    for (int u = threadIdx.x; u < 32; u += NWAVES * 64) ((LAS unsigned*)(L + MISC_OFF))[u] = 0u;
    __syncthreads();
    XcdBarrier bar = xcd_barrier_post((unsigned*)(ctl + CW_BAR), MISC + 8);
    const int lo = args.ph_lo, hi = args.ph_hi;
#define IN(k) (lo <= (k) && (k) < hi)
#define PHASE_P int tid = threadIdx.x; asm volatile("" : "+v"(tid)); const int lane = tid & 63, wave = __builtin_amdgcn_readfirstlane(tid >> 6); (void)lane; (void)wave; unsigned char* wsp_ = args.ws; asm volatile("" : "+s"(wsp_)); wsp_ = as_global(wsp_); const Ptrs P = make_ptrs_hd(args.in, args.out, wsp_); const float* mod_l = P.MOD + (size_t)l * NCOND * NMOD; (void)mod_l; float* const SS = (float*)(wsp_ + WS_SS); (void)SS
#ifndef BAR_DUP
#define BAR_DUP 0
#endif
#ifndef SLACK_PROBE_TICKS
#define SLACK_PROBE_TICKS 0
#endif
#ifndef FOLD_HALF
#define FOLD_HALF 0
#endif
#ifndef TAIL_FIRST
#define TAIL_FIRST 1
#endif
#ifndef XBF16
#define XBF16 1
#endif
#ifndef MO_REV
#define MO_REV 0
#endif
#ifndef MO_BLOCKED
#define MO_BLOCKED 1
#endif
#ifndef HID_BLOCKED
#define HID_BLOCKED 1
#endif
#ifndef DUP_GRES
#define DUP_GRES 0
#endif
#ifndef DUP_GIN
#define DUP_GIN 0
#endif
#ifndef DUP_GMI
#define DUP_GMI 0
#endif
#ifndef DEFER_WCONV
#define DEFER_WCONV 1
#endif
#ifndef WGM_IN
#define WGM_IN 8
#endif
#ifndef WGM_MI
#define WGM_MI 8
#endif
#ifndef DFT_FIRST
#define DFT_FIRST 0
#endif
#ifndef OUT_SPLIT
#define OUT_SPLIT 0
#endif
#ifndef GEMM_SP2
#define GEMM_SP2 true
#endif
#ifndef MLPIN_ALIGN
#define MLPIN_ALIGN true
#endif
#ifndef IDLE_PROBE_TICKS
#define IDLE_PROBE_TICKS 0
#endif
#define SEAM(k) do { if (IN(k) && IN((k) + 1)) { xcd_barrier(bar); if (BAR_DUP) xcd_barrier(bar); if (SLACK_PROBE_TICKS && (k) >= 3 && ((k) - 3) % 5 == 0 && (blockIdx.x & 4)) { const unsigned long long t1_ = __builtin_amdgcn_s_memrealtime(); while (__builtin_amdgcn_s_memrealtime() - t1_ < (unsigned long long)SLACK_PROBE_TICKS) __builtin_amdgcn_s_sleep(32); } if (IDLE_PROBE_TICKS) { const unsigned long long t0_ = __builtin_amdgcn_s_memrealtime(); while (__builtin_amdgcn_s_memrealtime() - t0_ < (unsigned long long)IDLE_PROBE_TICKS) __builtin_amdgcn_s_sleep(32); } } } while (0)
#ifndef DUP_ADA
#define DUP_ADA 0
#endif
#ifndef DUP_P0
#define DUP_P0 0
#endif
#ifndef DUP_P12
#define DUP_P12 0
#endif
    _Pragma("unroll 1") for (int rep_ = 0; rep_ <= DUP_P0; ++rep_) if (IN(0)) {
        const int l = 0; PHASE_P;
        const int t = tid & 255, hf = __builtin_amdgcn_readfirstlane(tid >> 8), hw = bx * 2 + hf, NHW = 2 * G;
        float* sm = (float*)(lds + hf * 67584);
        _Pragma("unroll 1") for (int ar_ = 0; ar_ <= DUP_ADA; ++ar_)
        for (int v0 = 0; v0 < 512; v0 += NHW) { const int vb = v0 + hw; prep_ada96_vb(P.c, P.c_ctx, P.w_ada, P.b_ada, P.MOD, vb, t, sm, vb < 512); }
#define TR_LOOP(W, K, LDW, WST, BT, BST, MODE, NX, NY, NBLK) for (int v0 = 0; v0 < (NX) * (NY) * DEPTH; v0 += NHW) { const int vb = v0 + hw; \
            prep_transpose256_vb(W, K, LDW, WST, BT, BST, MODE, vb % (NX), (vb / (NX)) % (NY), vb / ((NX) * (NY)), t, (float(*)[257])sm, vb < (NX) * (NY) * DEPTH, NBLK); }
        TR_LOOP(P.w_in, D, N_INRAW, (size_t)D * N_INRAW, P.BT_IN, (size_t)N_IN * D, 1, D / 64, 3072 / 256, 0)
#define TR_LOOP1(W, K, LDW, WST, BT, BST, NX, NY, LAYER, HW, NH, NBLK) for (int v0 = 0; v0 < (NX) * (NY); v0 += (NH)) { const int vb = v0 + (HW); \
            prep_transpose256_vb(W, K, LDW, WST, BT, BST, 0, vb % (NX), vb / (NX), LAYER, t, (float(*)[257])sm, vb < (NX) * (NY), NBLK); }
        if (G == 256 && DEFER_WCONV) { TR_LOOP1(P.w_out, D, D, (size_t)D * D, P.BT_OUT, (size_t)D * D, D / 64, D / 256, 0, hw, NHW, 0) }
        else { TR_LOOP(P.w_out, D, D, (size_t)D * D, P.BT_OUT, (size_t)D * D, 0, D / 64, D / 256, 0) }
        TR_LOOP(P.w_mi, D, DFF, (size_t)D * DFF, P.BT_MI, (size_t)DFF * D, 0, D / 64, DFF / 256, 0)
        if (G == 256 && DEFER_WCONV) { TR_LOOP1(P.w_mo, DFF, D, (size_t)DFF * D, P.BT_MO, (size_t)D * DFF, DFF / 64, D / 256, 0, hw, NHW, MO_BLOCKED ? D : 0) }
        else { TR_LOOP(P.w_mo, DFF, D, (size_t)DFF * D, P.BT_MO, (size_t)D * DFF, 0, DFF / 64, D / 256, MO_BLOCKED ? D : 0) }
        {   float* ct = sm; float* st = sm + 128;
            if (t < 128) { float s, c; sincospif((float)t / 64.0f, &s, &c); ct[t] = c; st[t] = s; }
            __syncthreads();
            for (size_t idx = (size_t)hw * 256 + t; idx < (size_t)DEPTH * 4 * 2 * 128 * 128; idx += (size_t)NHW * 256) prep_G_idx(P.w_fourier, P.G, idx, ct, st);
            __syncthreads(); }
        prep_tables_gs(P.ROPE, P.DFT_L, P.DFT_C, P.LAM, P.lq1, P.lk1, P.lq2, P.lk2, (float*)(P.ws + WS_GAIN), P.qn_a, P.kn_a, P.qn_b, P.kn_b, (size_t)bx * 512 + tid, (size_t)G * 512);
        prep_cache_gs(P.cak, P.cav, P.cdk, P.cdv, P.KAL, P.VAL, P.KBL, P.VBL, (size_t)bx * 512 + tid, (size_t)G * 512, -1);
    }
    SEAM(0);
    _Pragma("unroll 1") for (int rep_ = 0; rep_ <= DUP_P12; ++rep_) if (IN(1)) {
        const int l = 0; PHASE_P;
        const int gw = bx * NWAVES + wave, NGW = G * NWAVES;
        for (int row = gw; row < M_ALL; row += NGW) {
            const float* xrow = row < M_CTX ? P.x_prompt + (size_t)row * D : P.x_sample + (size_t)(row - M_CTX) * D;
            x0_row(xrow, P.g_mix, mod_l + (size_t)cond_of_row(row) * NMOD + D, P.H, row, SS + (size_t)row * 8, lane);
        }
        const int t = tid & 255, hf = __builtin_amdgcn_readfirstlane(tid >> 8), hw = bx * 2 + hf, NHW = 2 * G;
        float* sm = (float*)(lds + hf * 40960);
        for (int v0 = 0; v0 < 32 * 4 * DEPTH; v0 += NHW) { const int vb = v0 + hw; prep_fold_vb(P.w_in, P.G, P.BT_IN, vb & 31, (vb >> 5) & 3, vb >> 7, t, (float(*)[132])sm, vb < 32 * 4 * DEPTH); }
    }
    SEAM(1);
    _Pragma("unroll 1") for (int rep_ = 0; rep_ <= DUP_P12; ++rep_) if (IN(2)) {
        const int l = 0; PHASE_P;
        float* sh = (float*)lds;
        for (int item = bx; item < 8 * 32; item += G) {
            const int combo = item & 7, sub = item >> 3, ll = combo >> 1, which = combo & 1;
            const float* shsrc = P.MOD + (size_t)ll * NCOND * NMOD + (size_t)(which ? 3 : 0) * D;
            for (int i = tid; i < NCOND * D / 4; i += NWAVES * 64) { const int c = i / (D / 4), k4 = i % (D / 4); *(f32x4*)(sh + c * D + k4 * 4) = *(const f32x4*)(shsrc + (size_t)c * NMOD + k4 * 4); }
            __syncthreads();
            const int nrows = which ? DFF : N_IN, rps = nrows / 32;
            const bf16_t* bt = which ? P.BT_MI + (size_t)ll * DFF * D : P.BT_IN + (size_t)ll * N_IN * D;
            float* bo = which ? (float*)(P.ws + WS_BIAS_MI) + (size_t)ll * NCOND * DFF : (float*)(P.ws + WS_BIAS_IN) + (size_t)ll * NCOND * N_IN;
            {
                int r = sub * rps + wave; const int rend = (sub + 1) * rps;
                BiasRaw cur = bias_row_load(bt + (size_t)(r < rend ? r : rend - 1) * D, lane);
                for (; r < rend; r += NWAVES) { const int rn = r + NWAVES < rend ? r + NWAVES : r; const BiasRaw nxt = bias_row_load(bt + (size_t)rn * D, lane);
                    bias_row_fin(cur, sh, bo + r, nrows, lane); cur = nxt; } }
            __syncthreads();
        }
    }
    SEAM(2);
#pragma unroll 1
    for (int l = 0; l < DEPTH; ++l) {
        const int pb = 3 + 5 * l;
        _Pragma("unroll 1") for (int rep_ = 0; rep_ <= DUP_GIN; ++rep_) if (IN(pb + 0)) { PHASE_P;
            pg8::Gemm g{P.H, P.BT_IN + (size_t)l * N_IN * D, M_ALL, N_IN, D, D, XA_BLOCKED ? 64 : 0, XA_BLOCKED ? (size_t)M_ALL * 128 : 0}; pg8::StaticOrder S; S.init(M_ALL, N_IN, G, bx); S.wgm = WGM_IN;
            pg8::EpiIn E{l, P.ws, P.out, SS + (size_t)(2 * l) * M_ALL * 8, (const float*)(P.ws + WS_BIAS_IN) + (size_t)l * NCOND * N_IN};
            pg8::gemm_phase<pg8::EpiIn, pg8::StaticOrder, true, GEMM_SP2>(L, g, S, E);
        }
        SEAM(pb + 0);
#ifndef DUP_MIX
#define DUP_MIX 0
#endif
        _Pragma("unroll 1") for (int rep_ = 0; rep_ <= DUP_MIX; ++rep_) if (IN(pb + 1)) { PHASE_P;
            char* al = (char*)lds;
            const int vx = (G % 8 == 0) ? (bx % 8) * (G / 8) + bx / 8 : bx;
            {
                const bf16_t* YR = P.YTL; bf16_t* tl = (bf16_t*)lds;
                const bool fhalf = FOLD_HALF && G == 256;
                for (int item = fhalf ? (vx >= 128 ? vx - 128 : 1 << 20) : bx; item < 1024 + 256; item += fhalf ? 128 : G) {
                    const bool latent = item < 1024; const int it = latent ? item : item - 1024;
                    const int T = latent ? T_LAT : T_CTX, njb = T / 128;
                    const int jb = it % njb, nb = (it / njb) & 7, b = it / (njb * 8);
                    const size_t tok0 = latent ? (size_t)M_CTX + (size_t)b * T_LAT : (size_t)b * T_CTX; const int j0 = jb * 64, n0 = nb * 64;
                    {   const int row = tid >> 3, ch = tid & 7; const int j = j0 + row; const int jm = j ? T - j : T / 2;
                        const bf16_t* src = YR + (tok0 + j) * 1024 + n0 + ch * 8; const bf16_t* srm = YR + (tok0 + jm) * 1024 + n0 + ch * 8;
                        *(u32x4*)(tl + 0 * 4608 + row * 72 + ch * 8) = *(const u32x4*)src; *(u32x4*)(tl + 1 * 4608 + row * 72 + ch * 8) = *(const u32x4*)srm;
                        *(u32x4*)(tl + 2 * 4608 + row * 72 + ch * 8) = *(const u32x4*)(src + 512); *(u32x4*)(tl + 3 * 4608 + row * 72 + ch * 8) = *(const u32x4*)(srm + 512); }
                    __syncthreads();
                    {   const int rl = tid & 63, jc = tid >> 6; const int col = (rl & 32) | (map8(rl & 31) & 31);
                        float cv[8], sv[8];
#pragma unroll
                        for (int q = 0; q < 8; ++q) { const int jj = jc * 8 + q; const bool first = (j0 + jj) == 0;
                            const float c0 = bf2f(tl[0 * 4608 + jj * 72 + col]), c1 = bf2f(tl[1 * 4608 + jj * 72 + col]), s0 = bf2f(tl[2 * 4608 + jj * 72 + col]), s1 = bf2f(tl[3 * 4608 + jj * 72 + col]);
                            cv[q] = first ? c0 : c0 + c1; sv[q] = first ? c1 : s0 - s1; }
                        bf16_t* dst = (latent ? (bf16_t*)(P.ws + WS_YPL) + ((size_t)b * 512 + n0 + rl) * 2048 : (bf16_t*)(P.ws + WS_YPC) + ((size_t)b * 512 + n0 + rl) * 256) + j0 + jc * 8;
                        *(u32x4*)dst = (u32x4){pk2(cv[0], cv[1]), pk2(cv[2], cv[3]), pk2(cv[4], cv[5]), pk2(cv[6], cv[7])};
                        *(u32x4*)(dst + T / 2) = (u32x4){pk2(sv[0], sv[1]), pk2(sv[2], sv[3]), pk2(sv[4], sv[5]), pk2(sv[6], sv[7])}; }
                    __syncthreads();
                }
                asm volatile("s_waitcnt vmcnt(0)" ::: "memory"); __syncthreads();
                if (tid == 0) { __builtin_amdgcn_fence(__ATOMIC_RELEASE, "agent"); asm volatile("s_waitcnt vmcnt(0)" ::: "memory"); __hip_atomic_fetch_add(ctl + CW_YCNT + l * 64, 1u, RLX_AGENT); }
            }
#if DFT_FIRST
            {
                if (wave == 0) { unsigned sp = 0; gu32* cw = ctl + CW_YCNT + l * 64;
                    while ((unsigned)__builtin_amdgcn_readfirstlane(__hip_atomic_load(cw, RLX_AGENT)) < (unsigned)G * (unsigned)(rep_ + 1)) { __builtin_amdgcn_s_sleep(2);
                        if ((++sp & 1023u) == 0u && sp > (1u << 22)) { if (tid == 0) __hip_atomic_store(ctl + CW_TMO, 1u, RLX_AGENT); break; } }
                    __builtin_amdgcn_fence(__ATOMIC_ACQUIRE, "agent"); asm volatile("s_waitcnt vmcnt(0)" ::: "memory"); }
                __syncthreads(); }
            {   pg8::Gemm g{P.DFT_L, (const bf16_t*)(P.ws + WS_YPL), T_LAT, 512, 2048, 2048}; pg8::DftOrder S{1, 0, (G == 256 ? 128 : G), G, vx}; pg8::EpiBf16Out E{P.MIX, D, 1536};
                pg8::gemm_phase<pg8::EpiBf16Out, pg8::DftOrder, true, GEMM_SP2>(L, g, S, E); }
            {   pg8::Gemm g{P.DFT_C, (const bf16_t*)(P.ws + WS_YPC), T_CTX, 512, 256, 256}; pg8::DftOrder S{0, (G == 256 ? 192 : 0), (G == 256 ? 32 : G), G, vx}; pg8::EpiBf16Out E{P.MIX, D, 1536};
                pg8::gemm_phase<pg8::EpiBf16Out, pg8::DftOrder, true, GEMM_SP2>(L, g, S, E); }
            for (int id = vx; id < 256; id += G) { const int b = id >> 5, h = (id >> 3) & 3, qb = id & 7; const size_t kvrow = (size_t)(l * NB_LAT + b) * S_LAT;
                attn_b_unit(P, (size_t)M_CTX + (size_t)b * T_LAT + qb * 256, P.KBL + kvrow * 512, P.VBL + kvrow * 512, S_LAT, h, l, al); }
            for (int id = (G == 256 ? vx - 128 : vx); id < 64; id += G) { if (id < 0) break; const int b = id >> 2, h = id & 3;
                attn_b_unit(P, (size_t)b * T_CTX, P.KBC + (size_t)b * T_CTX * 512, P.VBC + (size_t)b * T_CTX * 512, T_CTX, h, l, al); }
#else
            for (int id = vx; id < 256; id += G) { const int b = id >> 5, h = (id >> 3) & 3, qb = id & 7; const size_t kvrow = (size_t)(l * NB_LAT + b) * S_LAT;
                attn_b_unit(P, (size_t)M_CTX + (size_t)b * T_LAT + qb * 256, P.KBL + kvrow * 512, P.VBL + kvrow * 512, S_LAT, h, l, al); }
            for (int id = (G == 256 ? vx - 128 : vx); id < 64; id += G) { if (id < 0) break; const int b = id >> 2, h = id & 3;
                attn_b_unit(P, (size_t)b * T_CTX, P.KBC + (size_t)b * T_CTX * 512, P.VBC + (size_t)b * T_CTX * 512, T_CTX, h, l, al); }
            {
                if (wave == 0) { unsigned sp = 0; gu32* cw = ctl + CW_YCNT + l * 64;
                    while ((unsigned)__builtin_amdgcn_readfirstlane(__hip_atomic_load(cw, RLX_AGENT)) < (unsigned)G * (unsigned)(rep_ + 1)) { __builtin_amdgcn_s_sleep(2);
                        if ((++sp & 1023u) == 0u && sp > (1u << 22)) { if (tid == 0) __hip_atomic_store(ctl + CW_TMO, 1u, RLX_AGENT); break; } }
                    __builtin_amdgcn_fence(__ATOMIC_ACQUIRE, "agent"); asm volatile("s_waitcnt vmcnt(0)" ::: "memory"); }
                __syncthreads(); }
            {   pg8::Gemm g{P.DFT_L, (const bf16_t*)(P.ws + WS_YPL), T_LAT, 512, 2048, 2048}; pg8::DftOrder S{1, 0, (G == 256 ? 128 : G), G, vx}; pg8::EpiBf16Out E{P.MIX, D, 1536};
                pg8::gemm_phase<pg8::EpiBf16Out, pg8::DftOrder, true, GEMM_SP2>(L, g, S, E); }
            {   pg8::Gemm g{P.DFT_C, (const bf16_t*)(P.ws + WS_YPC), T_CTX, 512, 256, 256}; pg8::DftOrder S{0, (G == 256 ? 192 : 0), (G == 256 ? 32 : G), G, vx}; pg8::EpiBf16Out E{P.MIX, D, 1536};
                pg8::gemm_phase<pg8::EpiBf16Out, pg8::DftOrder, true, GEMM_SP2>(L, g, S, E); }
#endif
            {
                for (int id = (G == 256 ? 2 * vx : vx), k = 0; id < 512; id += (G == 256 ? 1 : G), ++k) { if (G == 256 && k == 2) break;
                    const int b = id >> 6, h = (id >> 3) & 7, qb = id & 7; const size_t kvrow = (size_t)(l * NB_LAT + b) * S_LAT;
                    attn_a_unit(P, (size_t)M_CTX + (size_t)b * T_LAT + qb * 256, P.KAL + kvrow * 256, P.VAL + kvrow * 256, S_LAT, h, al); } }
            for (int id = (G == 256 ? vx - 128 : vx); id < 128; id += G) { if (id < 0) break; const int b = id >> 3, h = id & 7;
                attn_a_unit(P, (size_t)b * T_CTX, P.KAC + (size_t)b * T_CTX * 256, P.VAC + (size_t)b * T_CTX * 256, T_CTX, h, al); }
        }
        SEAM(pb + 1);
        if (IN(pb + 2)) { PHASE_P;
            const pg8::ResNext nx{P.H, P.g_mlp + (size_t)l * D, mod_l + 4 * D, SS + (size_t)(2 * l + 1) * M_ALL * 8};
            pg8::Gemm g{P.MIX, P.BT_OUT + (size_t)l * D * D, M_ALL, D, D, D}; pg8::StaticOrder S; S.init(M_ALL, D, G, bx); if (G == 256 && OUT_SPLIT) S.rounds = 2;
            float* const xb = XBF16 ? (float*)(P.ws + WS_XB) : P.out;
            pg8::EpiRes E{xb, mod_l + 2 * D, nx, l == 0 ? P.x_prompt : xb, l == 0 ? P.x_sample - (size_t)M_CTX * D : xb, ((!XBF16 || l == 0) ? 1 : 0) | (XBF16 ? 0 : 2)};
            pg8::gemm_phase<pg8::EpiRes, pg8::StaticOrder, true, GEMM_SP2>(L, g, S, E);
            {   pg8::Gemm g2{P.MIX, P.BT_OUT + (size_t)l * D * D, M_ALL, D, D / 2, D}; pg8::SplitOrder S2; S2.init(M_ALL, D, G, bx); if (!OUT_SPLIT) S2.on = 0;
                pg8::EpiResSplit E2{E, P.OTMP, (unsigned*)(ctl + CW_FLAG) + (size_t)(l * 2 + 0) * 128 * 64, (unsigned*)(ctl + CW_TMO)};
                pg8::gemm_phase<pg8::EpiResSplit, pg8::SplitOrder, true, GEMM_SP2>(L, g2, S2, E2); }
            if (G == 256 && DEFER_WCONV && !OUT_SPLIT && l + 1 < DEPTH && bx >= 128) {
                const int t = tid & 255, hf = __builtin_amdgcn_readfirstlane(tid >> 8), hw2 = (bx - 128) * 2 + hf; float* sm = (float*)(lds + hf * 67584);
                TR_LOOP1(P.w_out, D, D, (size_t)D * D, P.BT_OUT, (size_t)D * D, D / 64, D / 256, l + 1, hw2, 256, 0)
                TR_LOOP1(P.w_mo, DFF, D, (size_t)DFF * D, P.BT_MO, (size_t)D * DFF, DFF / 64, D / 256, l + 1, hw2, 256, MO_BLOCKED ? D : 0)
            }
        }
        SEAM(pb + 2);
        _Pragma("unroll 1") for (int rep_ = 0; rep_ <= DUP_GMI; ++rep_) if (IN(pb + 3)) { PHASE_P;
            pg8::Gemm g{P.H, P.BT_MI + (size_t)l * DFF * D, M_ALL, DFF, D, D, XA_BLOCKED ? 64 : 0, XA_BLOCKED ? (size_t)M_ALL * 128 : 0}; pg8::StaticOrder S; S.init(M_ALL, DFF, G, bx); S.wgm = WGM_MI;
            pg8::EpiRelu2 E{P.HID, DFF, SS + (size_t)(2 * l + 1) * M_ALL * 8, (const float*)(P.ws + WS_BIAS_MI) + (size_t)l * NCOND * DFF, HID_BLOCKED ? M_ALL : 0};
            pg8::gemm_phase<pg8::EpiRelu2, pg8::StaticOrder, MLPIN_ALIGN, GEMM_SP2>(L, g, S, E);
        }
        SEAM(pb + 3);
        if (IN(pb + 4)) { PHASE_P;
            const bool more = l + 1 < DEPTH;
            const pg8::ResNext nx{more ? P.H : nullptr, P.g_mix + (size_t)(more ? l + 1 : l) * D, P.MOD + (size_t)(more ? l + 1 : l) * NCOND * NMOD + D, SS + (size_t)(more ? 2 * l + 2 : 0) * M_ALL * 8};
            pg8::Gemm g{P.HID, P.BT_MO + (size_t)l * D * DFF, M_ALL, D, DFF, DFF, HID_BLOCKED ? 64 : 0, HID_BLOCKED ? (size_t)M_ALL * 128 : 0, MO_BLOCKED ? 64 : 0, MO_BLOCKED ? (size_t)D * 128 : 0}; pg8::StaticOrder S; S.init(M_ALL, D, G, bx); if (G == 256) S.rounds = 2; S.rev = MO_REV;
            float* const xb = XBF16 ? (float*)(P.ws + WS_XB) : P.out; const bool wf = !XBF16 || l == DEPTH - 1;
            pg8::EpiRes E{wf ? P.out : xb, mod_l + 5 * D, nx, xb, xb, (XBF16 ? 0 : 1) | (wf ? 2 : 0)};
            const bool prod_first = TAIL_FIRST && G == 256 && pg8::SplitOrder::producer(bx);
            _Pragma("unroll 1") for (int st = 0; st < 3; ++st) {
                if (st == 1) pg8::gemm_phase<pg8::EpiRes, pg8::StaticOrder, true, GEMM_SP2>(L, g, S, E);
                else if ((st == 0) == prod_first) { pg8::Gemm g2{P.HID, P.BT_MO + (size_t)l * D * DFF, M_ALL, D, DFF / 2, DFF, HID_BLOCKED ? 64 : 0, HID_BLOCKED ? (size_t)M_ALL * 128 : 0, MO_BLOCKED ? 64 : 0, MO_BLOCKED ? (size_t)D * 128 : 0}; pg8::SplitOrder S2; S2.init(M_ALL, D, G, bx); S2.base.rev = MO_REV;
                    pg8::EpiResSplit E2{E, P.OTMP, (unsigned*)(ctl + CW_FLAG) + (size_t)(l * 2 + 1) * 128 * 64, (unsigned*)(ctl + CW_TMO)};
                    pg8::gemm_phase<pg8::EpiResSplit, pg8::SplitOrder, true, GEMM_SP2>(L, g2, S2, E2); }
            }
        }
        SEAM(pb + 4);
    }
#undef TR_LOOP
#undef TR_LOOP1
#undef IN
#undef PHASE_P
#undef SEAM
}
extern "C" void kernel_launch(void* const* d_in, const int* in_sizes, int n_in, void* d_out, int out_size, void* d_ws, size_t ws_size, hipStream_t stream) {
    if (n_in != 26 || (size_t)out_size != OUT_END || ws_size < WS_END) { fprintf(stderr, "kernel_launch: unexpected shapes (n_in %d out %d ws %zu)\n", n_in, out_size, ws_size); return; }
    static int grid = 0;
    if (grid == 0) {
        int dev = 0, cus = 0;
        if (hipGetDevice(&dev) != hipSuccess || hipDeviceGetAttribute(&cus, hipDeviceAttributeMultiprocessorCount, dev) != hipSuccess) { grid = -1; return; }
        if (hipFuncSetAttribute((const void*)mega, hipFuncAttributeMaxDynamicSharedMemorySize, LDS_BYTES) != hipSuccess) { grid = -1; return; }
        int per_cu = 0; (void)hipOccupancyMaxActiveBlocksPerMultiprocessor(&per_cu, (const void*)mega, NWAVES * 64, LDS_BYTES); (void)hipGetLastError();
        grid = cus;
#ifdef FORCE_GRID
        grid = FORCE_GRID;
#endif
    }
    if (grid < 0) return;
    (void)hipMemsetAsync((char*)d_ws + WS_CTL, 0, 1 * MiB, stream);
    MegaArgs a{}; for (int i = 0; i < 26; ++i) a.in[i] = (const float*)d_in[i]; a.out = (float*)d_out; a.ws = (unsigned char*)d_ws;
    a.ph_lo = 0; a.ph_hi = N_PHASES;
    hipLaunchKernelGGL(mega, dim3(grid), dim3(NWAVES * 64), LDS_BYTES, stream, a);
}
```
